# Optimizing an MI355X kernel written in HIP

```python
import math
import jax, jax.numpy as jnp
from jax import lax
import numpy as np

D_MODEL = 2048
BATCH = 2
SEQ = 16384
DEPTH = 1

CHUNK = 64
NORM_EPS = 1e-6

RWKV_HEADS = 16
RWKV_HEAD_DIM = 64
RWKV_WIDTH = RWKV_HEADS * RWKV_HEAD_DIM
DECAY_LORA = 96
AAA_LORA = 96
GATE_LORA = 256
RWKV_GN_EPS = 64e-5

DIFF_HEADS = 8
DIFF_QK_DIM = 64
DIFF_V_DIM = 2 * DIFF_QK_DIM
DIFF_QK_WIDTH = DIFF_HEADS * 2 * DIFF_QK_DIM
DIFF_V_WIDTH = DIFF_HEADS * DIFF_V_DIM
ROPE_THETA = 500000.0
ROPE_DIM = DIFF_QK_DIM // 4
Q_BLOCK = 128

N_EXPERTS = 32
TOP_K = 4
D_FF = D_MODEL
SWIGLU_LIMIT = 7.0
SWIGLU_ALPHA = 1.702
MOE_BLOCK = 128

SHIFT_SIZES = (RWKV_WIDTH, RWKV_WIDTH, RWKV_WIDTH, DECAY_LORA, AAA_LORA, GATE_LORA)
REST_SIZES = (DIFF_QK_WIDTH, DIFF_QK_WIDTH, DIFF_V_WIDTH, D_MODEL, D_MODEL)
SHIFT_WIDTH = 3 * RWKV_WIDTH + DECAY_LORA + AAA_LORA + GATE_LORA
IN_WIDTH = SHIFT_WIDTH + 2 * DIFF_QK_WIDTH + DIFF_V_WIDTH + 2 * D_MODEL

kernel_name = 'hybrid_rwkv7_diffattn_moe_block'


def _split(t, sizes):
    outs, start = [], 0
    for s in sizes:
        outs.append(t[..., start:start + s])
        start += s
    return outs


def rms_norm(x, gain, eps=NORM_EPS):
    xf = x.astype(jnp.float32)
    y = xf * lax.rsqrt(jnp.mean(xf * xf, axis=-1, keepdims=True) + eps)
    return (y * gain.astype(jnp.float32)).astype(x.dtype)


def token_shift(p, mu):
    prev = jnp.pad(p, ((0, 0), (1, 0), (0, 0)))[:, :-1]
    return p + (prev - p) * mu


def partial_rope(x, pos):
    half = ROPE_DIM // 2
    inv_freq = ROPE_THETA ** (-jnp.arange(half, dtype=jnp.float32) * 2.0 / ROPE_DIM)
    ang = pos.astype(jnp.float32)[:, None] * inv_freq[None, :]
    cos = jnp.cos(ang)[None, :, None, None, :]
    sin = jnp.sin(ang)[None, :, None, None, :]
    xr = x[..., :ROPE_DIM].astype(jnp.float32)
    x1, x2 = xr[..., :half], xr[..., half:]
    rot = jnp.concatenate([x1 * cos - x2 * sin, x2 * cos + x1 * sin], axis=-1)
    return jnp.concatenate([rot.astype(x.dtype), x[..., ROPE_DIM:]], axis=-1)


def rwkv7_branch(r, k, v, w_d, a_d, g_d, w0, w_decay_up, a0, w_aaa_up, w_gate_up,
                 k_k, k_a, r_k, gn_w, gn_b):
    B, S, _ = r.shape
    H, N = RWKV_HEADS, RWKV_HEAD_DIM
    f32 = jnp.float32
    w_log = -jax.nn.softplus(-(w0 + jnp.tanh(w_d) @ w_decay_up)) - 0.5
    a = jax.nn.sigmoid(a0 + a_d @ w_aaa_up)
    g = jax.nn.sigmoid(g_d) @ w_gate_up
    kk = (k * k_k).reshape(B, S, H, N).astype(f32)
    kk = kk / jnp.maximum(jnp.sqrt(jnp.sum(kk * kk, axis=-1, keepdims=True)), 1e-12)
    k = k * (1.0 + (a - 1.0) * k_a)

    def heads(t):
        return t.reshape(B, S, H, N).astype(f32)

    rh, kh, vh, ah = heads(r), heads(k), heads(v), heads(a)
    decay = jnp.exp(-jnp.exp(heads(w_log)))
    a_vec = -kk
    b_vec = kk * ah

    def step(state, inp):
        r_t, d_t, k_t, v_t, a_t, b_t = inp
        sa = jnp.einsum('bhvk,bhk->bhv', state, a_t)
        state = (state * d_t[:, :, None, :] + sa[..., None] * b_t[:, :, None, :]
                 + v_t[..., None] * k_t[:, :, None, :])
        y = jnp.einsum('bhvk,bhk->bhv', state, r_t)
        return state, y

    xs = tuple(jnp.moveaxis(t, 1, 0) for t in (rh, decay, kh, vh, a_vec, b_vec))
    _, ys = lax.scan(step, jnp.zeros((B, H, N, N), f32), xs)
    y = jnp.moveaxis(ys, 0, 1)
    mu = jnp.mean(y, axis=-1, keepdims=True)
    var = jnp.mean(jnp.square(y - mu), axis=-1, keepdims=True)
    yn = (y - mu) * lax.rsqrt(var + RWKV_GN_EPS)
    yn = yn * gn_w.reshape(H, N).astype(f32) + gn_b.reshape(H, N).astype(f32)
    bonus = jnp.sum(rh * kh * r_k.reshape(H, N).astype(f32), axis=-1, keepdims=True) * vh
    out = (yn + bonus).reshape(B, S, H * N).astype(r.dtype) * g
    return out


def diff_attention(q, k, v, q_gain, k_gain, lam_q1, lam_k1, lam_q2, lam_k2, subln_gain,
                   lambda_init):
    B, S, _ = q.shape
    H, Dh, Dv = DIFF_HEADS, DIFF_QK_DIM, DIFF_V_DIM
    f32 = jnp.float32
    q = rms_norm(q.reshape(B, S, H, 2, Dh), q_gain)
    k = rms_norm(k.reshape(B, S, H, 2, Dh), k_gain)
    v = v.reshape(B, S, H, Dv)
    pos = jnp.arange(S, dtype=jnp.int32)
    q = partial_rope(q, pos)
    k = partial_rope(k, pos)
    lam = (jnp.exp(jnp.sum(lam_q1.astype(f32) * lam_k1.astype(f32)))
           - jnp.exp(jnp.sum(lam_q2.astype(f32) * lam_k2.astype(f32))) + lambda_init)
    scale = Dh ** -0.5
    n_blocks = S // Q_BLOCK
    qb = q.reshape(B, n_blocks, Q_BLOCK, H, 2, Dh).transpose(1, 0, 2, 3, 4, 5)
    key_chunk = pos // CHUNK

    def attend(args):
        q_blk, blk = args
        q_chunk = (blk * Q_BLOCK + jnp.arange(Q_BLOCK, dtype=jnp.int32)) // CHUNK
        s = jnp.einsum('bqhmd,bkhmd->bhmqk', q_blk, k, preferred_element_type=f32) * scale
        mask = key_chunk[None, :] <= q_chunk[:, None]
        s = jnp.where(mask, s, -jnp.inf)
        p = jax.nn.softmax(s, axis=-1)
        attn = p[:, :, 0] - lam * p[:, :, 1]
        return jnp.einsum('bhqk,bkhd->bqhd', attn.astype(v.dtype), v)

    o = lax.map(attend, (qb, jnp.arange(n_blocks, dtype=jnp.int32)))
    o = o.transpose(1, 0, 2, 3, 4).reshape(B, S, H, Dv)
    o = rms_norm(o, subln_gain) * (1.0 - lambda_init)
    return o.reshape(B, S, H * Dv)


def moe_ffn(h, w_router, b_router, w_gate, b_gate, w_up, b_up, w_down, b_down):
    B, S, D = h.shape
    T = B * S
    M = T * TOP_K
    n_blocks = (M + N_EXPERTS * (MOE_BLOCK - 1) + MOE_BLOCK - 1) // MOE_BLOCK
    P = n_blocks * MOE_BLOCK
    hf = h.reshape(T, D)
    logits = (hf @ w_router + b_router).astype(jnp.float32)
    top_val, top_idx = lax.top_k(logits, TOP_K)
    top_w = jax.nn.softmax(top_val, axis=-1)

    flat_e = top_idx.reshape(M).astype(jnp.int32)
    order = jnp.argsort(flat_e)
    sorted_e = flat_e[order]
    counts = jnp.bincount(flat_e, length=N_EXPERTS)
    padded = (counts + MOE_BLOCK - 1) // MOE_BLOCK * MOE_BLOCK
    pad_end = jnp.cumsum(padded)
    pad_start = pad_end - padded
    sort_start = jnp.cumsum(counts) - counts
    dest = pad_start[sorted_e] + jnp.arange(M, dtype=jnp.int32) - sort_start[sorted_e]
    row_token = jnp.full((P,), T, jnp.int32).at[dest].set((order // TOP_K).astype(jnp.int32))
    row_gate = jnp.zeros((P,), jnp.float32).at[dest].set(top_w.reshape(M)[order])
    block_start = jnp.arange(n_blocks, dtype=jnp.int32) * MOE_BLOCK
    block_expert = jnp.minimum(jnp.searchsorted(pad_end, block_start, side='right'),
                               N_EXPERTS - 1).astype(jnp.int32)
    h_pad = jnp.concatenate([hf, jnp.zeros((1, D), hf.dtype)], axis=0)

    def expert_block(acc, args):
        tok, gw, e = args
        xb = h_pad[tok]
        gt = jnp.minimum(xb @ w_gate[e] + b_gate[e], SWIGLU_LIMIT)
        up = jnp.clip(xb @ w_up[e] + b_up[e], -SWIGLU_LIMIT, SWIGLU_LIMIT)
        y = ((up + 1.0) * gt * jax.nn.sigmoid(SWIGLU_ALPHA * gt)) @ w_down[e] + b_down[e]
        acc = acc.at[tok].add(y * gw[:, None].astype(y.dtype))
        return acc, None

    acc, _ = lax.scan(expert_block, jnp.zeros((T + 1, D), h.dtype),
                      (row_token.reshape(n_blocks, MOE_BLOCK),
                       row_gate.reshape(n_blocks, MOE_BLOCK), block_expert))
    return acc[:T].reshape(B, S, D)


def setup_inputs(seed: int = 0) -> dict:
    key = jax.random.key(seed)
    ks = iter(jax.random.split(key, 48))
    L, D, E, F = DEPTH, D_MODEL, N_EXPERTS, D_FF

    def nrm(shape, scale):
        return scale * jax.random.normal(next(ks), shape, jnp.float32)

    def gain(shape):
        return 1.0 + nrm(shape, 0.02)

    def unif(shape, lo, hi):
        return jax.random.uniform(next(ks), shape, jnp.float32, lo, hi)

    return {
        'x': nrm((BATCH, SEQ, D), 1.0),
        'c': nrm((BATCH, D), 1.0),
        'w_ada': nrm((L, D, 6 * D), 0.5 * D ** -0.5),
        'b_ada': nrm((L, 6 * D), 0.02),
        'norm1_gain': gain((L, D)),
        'norm2_gain': gain((L, D)),
        'w_in': nrm((L, D, IN_WIDTH), D ** -0.5),
        'shift_mu': unif((L, SHIFT_WIDTH), 0.0, 1.0),
        'w0': unif((L, RWKV_WIDTH), -5.0, 0.0),
        'w_decay_up': nrm((L, DECAY_LORA, RWKV_WIDTH), 0.1 * DECAY_LORA ** -0.5),
        'a0': nrm((L, RWKV_WIDTH), 0.1),
        'w_aaa_up': nrm((L, AAA_LORA, RWKV_WIDTH), 0.5 * AAA_LORA ** -0.5),
        'w_gate_up': nrm((L, GATE_LORA, RWKV_WIDTH), GATE_LORA ** -0.5),
        'k_k': 0.85 + nrm((L, RWKV_WIDTH), 0.02),
        'k_a': gain((L, RWKV_WIDTH)),
        'r_k': nrm((L, RWKV_WIDTH), 0.1),
        'gn_w': gain((L, RWKV_WIDTH)),
        'gn_b': nrm((L, RWKV_WIDTH), 0.02),
        'q_gain': gain((L, DIFF_QK_DIM)),
        'k_gain': gain((L, DIFF_QK_DIM)),
        'lam_q1': nrm((L, DIFF_QK_DIM), 0.1),
        'lam_k1': nrm((L, DIFF_QK_DIM), 0.1),
        'lam_q2': nrm((L, DIFF_QK_DIM), 0.1),
        'lam_k2': nrm((L, DIFF_QK_DIM), 0.1),
        'subln_gain': gain((L, DIFF_V_DIM)),
        'w_branch_a': nrm((L, RWKV_WIDTH, D), RWKV_WIDTH ** -0.5),
        'w_branch_b': nrm((L, DIFF_V_WIDTH, D), DIFF_V_WIDTH ** -0.5),
        'w_out': nrm((L, D, D), D ** -0.5),
        'w_router': nrm((L, D, E), D ** -0.5),
        'b_router': nrm((L, E), 0.01),
        'w_exp_gate': nrm((L, E, D, F), D ** -0.5),
        'b_exp_gate': nrm((L, E, F), 0.01),
        'w_exp_up': nrm((L, E, D, F), D ** -0.5),
        'b_exp_up': nrm((L, E, F), 0.01),
        'w_exp_down': nrm((L, E, F, D), F ** -0.5),
        'b_exp_down': nrm((L, E, D), 0.01),
    }


def reference(x, c, w_ada, b_ada, norm1_gain, norm2_gain, w_in, shift_mu, w0, w_decay_up,
              a0, w_aaa_up, w_gate_up, k_k, k_a, r_k, gn_w, gn_b, q_gain, k_gain,
              lam_q1, lam_k1, lam_q2, lam_k2, subln_gain, w_branch_a, w_branch_b, w_out,
              w_router, b_router, w_exp_gate, b_exp_gate, w_exp_up, b_exp_up,
              w_exp_down, b_exp_down):
    for l in range(DEPTH):
        mod = jax.nn.silu(c) @ w_ada[l] + b_ada[l]
        sh1, sc1, g1, sh2, sc2, g2 = jnp.split(mod[:, None, :], 6, axis=-1)

        h = rms_norm(x, norm1_gain[l]) * (1.0 + sc1) + sh1
        proj = h @ w_in[l]
        shifted = token_shift(proj[..., :SHIFT_WIDTH], shift_mu[l])
        r, k, v, w_d, a_d, g_d = _split(shifted, SHIFT_SIZES)
        qd, kd, vd, gate_a, gate_b = _split(proj[..., SHIFT_WIDTH:], REST_SIZES)

        o_a = rwkv7_branch(r, k, v, w_d, a_d, g_d, w0[l], w_decay_up[l], a0[l], w_aaa_up[l],
                           w_gate_up[l], k_k[l], k_a[l], r_k[l], gn_w[l], gn_b[l])
        lambda_init = 0.8 - 0.6 * math.exp(-0.3 * l)
        o_b = diff_attention(qd, kd, vd, q_gain[l], k_gain[l], lam_q1[l], lam_k1[l],
                             lam_q2[l], lam_k2[l], subln_gain[l], lambda_init)

        merged = (jax.nn.sigmoid(gate_a) * (o_a @ w_branch_a[l])
                  + jax.nn.sigmoid(gate_b) * (o_b @ w_branch_b[l]))
        x = x + g1 * (merged @ w_out[l])

        h2 = rms_norm(x, norm2_gain[l]) * (1.0 + sc2) + sh2
        x = x + g2 * moe_ffn(h2, w_router[l], b_router[l], w_exp_gate[l], b_exp_gate[l],
                             w_exp_up[l], b_exp_up[l], w_exp_down[l], b_exp_down[l])
    return x
```

```cpp
#include <hip/hip_runtime.h>
#include <cstdio>
#include <cstdint>
#include <cmath>

#define GAS __attribute__((address_space(1)))
#define LAS __attribute__((address_space(3)))
#define DI __device__ __forceinline__
typedef unsigned short bf16_t;
typedef short bf16x8 __attribute__((ext_vector_type(8)));
typedef short s16x4 __attribute__((ext_vector_type(4)));
typedef float f32x4 __attribute__((ext_vector_type(4)));
typedef float f32x2 __attribute__((ext_vector_type(2)));
typedef float f32x16 __attribute__((ext_vector_type(16)));
typedef unsigned u32x4 __attribute__((ext_vector_type(4)));
typedef unsigned u32x2 __attribute__((ext_vector_type(2)));

typedef float f32x2_t __attribute__((ext_vector_type(2))); typedef __bf16 bf16x2_t __attribute__((ext_vector_type(2)));
DI unsigned cvtpk(float lo, float hi) { f32x2_t v = {lo, hi}; bf16x2_t b = __builtin_convertvector(v, bf16x2_t); return __builtin_bit_cast(unsigned, b); }
DI unsigned f2bf(float f) { return cvtpk(f, f) & 0xffffu; }
DI unsigned pk2(float lo, float hi) { return cvtpk(lo, hi); }
DI float bf2f(unsigned b) { return __builtin_bit_cast(float, b << 16); }
DI float bflo(unsigned w) { return __builtin_bit_cast(float, w << 16); }
DI float bfhi(unsigned w) { return __builtin_bit_cast(float, w & 0xffff0000u); }
#define DPPF(v, ctrl) __builtin_bit_cast(float, __builtin_amdgcn_update_dpp(0, __builtin_bit_cast(int, (v)), (ctrl), 0xf, 0xf, true))
#define DPPF_ROWS(v, ctrl, rmask) __builtin_bit_cast(float, __builtin_amdgcn_update_dpp(0, __builtin_bit_cast(int, (v)), (ctrl), (rmask), 0xf, false))
DI float sum8_dpp(float v) {
    v += DPPF(v, 0xB1); v += DPPF(v, 0x4E); v += DPPF(v, 0x141); return v;
}
DI float wave_sum(float v) {
    v = sum8_dpp(v); v += DPPF(v, 0x140);
    v += DPPF_ROWS(v, 0x142, 0xa); v += DPPF_ROWS(v, 0x143, 0xc);
    return __builtin_bit_cast(float, __builtin_amdgcn_readlane(__builtin_bit_cast(int, v), 63));
}
DI float sum_x16(float v) {
    const auto p = __builtin_amdgcn_permlane16_swap(__float_as_uint(v), __float_as_uint(v), false, false); return __uint_as_float(p[0]) + __uint_as_float(p[1]); }
DI float sum_x32(float v) {
    const auto p = __builtin_amdgcn_permlane32_swap(__float_as_uint(v), __float_as_uint(v), false, false); return __uint_as_float(p[0]) + __uint_as_float(p[1]); }
DI float sum32_dpp(float v) {
    v = sum8_dpp(v); v += DPPF(v, 0x140); return sum_x16(v); }
DI float sigmoidf_(float x) { return __builtin_amdgcn_rcpf(1.f + __expf(-x)); }
#define LDS_BARRIER() asm volatile("s_waitcnt lgkmcnt(0)\n\ts_barrier" ::: "memory")
DI int crow(int r, int hi) { return (r & 3) + 8 * (r >> 2) + 4 * hi; }
#define MFMA32(a, b, c) __builtin_amdgcn_mfma_f32_32x32x16_bf16((a), (b), (c), 0, 0, 0)
#define MFMA16(a, b, c) __builtin_amdgcn_mfma_f32_16x16x32_bf16((a), (b), (c), 0, 0, 0)

namespace pg8 {
#define PG8_LAS __attribute__((address_space(3)))
constexpr int BM = 256, BK = 64, HALF = 128, HTB = HALF * BK * 2, STAGE_BYTES = 8 * HTB, NXCD = 8, WGM = 4;
__host__ __device__ __forceinline__ int lds_byte(int r, int c) { const int st = (r >> 4) * 2 + (c >> 5), rr = r & 15, cc = c & 31, ob = rr * 64 + cc * 2; return st * 1024 + (ob ^ (((ob >> 9) & 1) << 5)); }
__host__ __device__ __forceinline__ void stage_rc(int b, int& R, int& C) { const int st = b / 1024, sb = b % 1024, swz = sb ^ (((sb >> 9) & 1) << 5); R = (st >> 1) * 16 + swz / 64; C = (st & 1) * 32 + (swz % 64) / 2; }
__host__ __device__ __forceinline__ int perm32(int rho) { const int n = rho >> 4, i = rho & 15; return 8 * (i >> 2) + 4 * n + (i & 3); }
struct Unit { int pm, pn; };
struct Gemm { const bf16_t* A; const bf16_t* Bt; int M, N, K; int f8scale; };
struct StaticOrder {
    int nM, nN, nwg, G, c;
    __host__ __device__ void init(int M, int N, int G_, int c_) { nM = M / BM; nN = N / BM; nwg = nM * nN; G = G_; c = c_; }
    __host__ __device__ bool next(int i, Unit& u) const {
        const long L = (long)i * G + c; if (L >= nwg) return false;
        int wgid = (int)L; { const int q = nwg / NXCD, r = nwg % NXCD, xcd = wgid % NXCD, off = wgid / NXCD; wgid = (xcd < r ? xcd * (q + 1) : r * (q + 1) + (xcd - r) * q) + off; }
        const int nig = WGM * nN, gid = wgid / nig, fm = gid * WGM, gsz = (nM - fm) < WGM ? (nM - fm) : WGM;
        u.pm = fm + ((wgid % nig) % gsz); u.pn = (wgid % nig) / gsz; return true;
    }
    __device__ __forceinline__ void a_ready(const Unit&) const {}
    __device__ __forceinline__ void done(const Unit&) const {}
};
__device__ __forceinline__ unsigned cvt_pk_bf16(float lo, float hi) { unsigned r; asm volatile("v_cvt_pk_bf16_f32 %0, %1, %2" : "=v"(r) : "v"(lo), "v"(hi)); return r; }
typedef int v8i_t __attribute__((ext_vector_type(8))); typedef int v4i_t __attribute__((ext_vector_type(4)));
#define PG8_CAT(x0, x1) __builtin_shufflevector(__builtin_bit_cast(v4i_t, (x0)), __builtin_bit_cast(v4i_t, (x1)), 0, 1, 2, 3, 4, 5, 6, 7)
template <class Epi, class Sched, bool ALIGN_EPI = false, bool SP2 = false, bool F8 = false, bool GATHER = false>
__device__ __forceinline__ void gemm_phase(PG8_LAS unsigned char* lds, const Gemm g, const Sched& S, const Epi& E) {
    const int tid = threadIdx.x, wid = __builtin_amdgcn_readfirstlane(tid >> 6), lane = tid & 63, wr = wid >> 2, wc = wid & 3, fr = lane & 15, fq = lane >> 4;
    const int K = g.K, nt = K / BK; const int f8sc = g.f8scale, f8one = 0x7f7f7f7f; (void)f8sc; (void)f8one;
    unsigned voffA[2], voffB[2];
#pragma unroll
    for (int i = 0; i < 2; ++i) { int R, C; stage_rc(tid * 16 + i * 8192, R, C); const int Rb = Epi::PERM ? ((R & ~31) + perm32(R & 31)) : R;
        voffA[i] = (unsigned)(R * K + C) * 2u; voffB[i] = (unsigned)(Rb * K + C) * 2u; }
    const size_t kstep = (size_t)(BK * 2);
    const size_t hstep = (size_t)HALF * K * 2;
    const size_t tstep = 2 * hstep;
    const unsigned ldsw = (unsigned)wid * 1024u;
    const int aoff = lds_byte(wr * 64 + fr, fq * 8), boff = lds_byte(wc * 32 + fr, fq * 8);
#define PG8_SA(b, h) (((b) * 2 + (h)) * HTB)
#define PG8_SB(b, h) ((4 + (b) * 2 + (h)) * HTB)
#define PG8_STAGE(bufoff, gbase, voff) do { _Pragma("unroll") for (int _i = 0; _i < 2; ++_i) \
        __builtin_amdgcn_global_load_lds((const unsigned*)((const char*)(gbase) + (voff)[_i]), (PG8_LAS unsigned*)(lds + (bufoff) + ldsw + _i * 8192), 16, 0, 0); } while (0)
#define PG8_STAGE_A(bufoff, ptr, half, gset, kofs) do { if constexpr (GATHER) { _Pragma("unroll") for (int _i = 0; _i < 2; ++_i) \
        __builtin_amdgcn_global_load_lds((const unsigned*)((const char*)g.A + (size_t)gset[half][_i] + (size_t)(kofs)), (PG8_LAS unsigned*)(lds + (bufoff) + ldsw + _i * 8192), 16, 0, 0); } \
        else { PG8_STAGE(bufoff, (ptr) + (half) * hstep, voffA); } } while (0)
#define PG8_LDA(dst, b, h) do { _Pragma("unroll") for (int m = 0; m < 4; ++m) { if constexpr (F8) { dst##8[m] = PG8_CAT(*(const PG8_LAS bf16x8*)(lds + PG8_SA(b, h) + aoff + m * 2048), *(const PG8_LAS bf16x8*)(lds + PG8_SA(b, h) + aoff + m * 2048 + 1024)); } \
        else { _Pragma("unroll") for (int k = 0; k < 2; ++k) dst[m][k] = *(const PG8_LAS bf16x8*)(lds + PG8_SA(b, h) + aoff + m * 2048 + k * 1024); } } } while (0)
#define PG8_LDB(dst, b, h) do { _Pragma("unroll") for (int n = 0; n < 2; ++n) { if constexpr (F8) { dst##8[n] = PG8_CAT(*(const PG8_LAS bf16x8*)(lds + PG8_SB(b, h) + boff + n * 2048), *(const PG8_LAS bf16x8*)(lds + PG8_SB(b, h) + boff + n * 2048 + 1024)); } \
        else { _Pragma("unroll") for (int k = 0; k < 2; ++k) dst[n][k] = *(const PG8_LAS bf16x8*)(lds + PG8_SB(b, h) + boff + n * 2048 + k * 1024); } } } while (0)
#define PG8_MMA(ai, bj, At, Bt) do { __builtin_amdgcn_s_setprio(1); _Pragma("unroll") for (int m = 0; m < 4; ++m) _Pragma("unroll") for (int n = 0; n < 2; ++n) { \
        if constexpr (F8) { asm volatile("v_mfma_scale_f32_16x16x128_f8f6f4 %0, %1, %2, %0, %3, %4 op_sel_hi:[0,0,0]" : "+v"(acc[ai][bj][m][n]) : "v"(Bt##8[n]), "v"(At##8[m]), "v"(f8sc), "v"(f8one)); } \
        else { _Pragma("unroll") for (int k = 0; k < 2; ++k) acc[ai][bj][m][n] = __builtin_amdgcn_mfma_f32_16x16x32_bf16(Bt[n][k], At[m][k], acc[ai][bj][m][n], 0, 0, 0); } } __builtin_amdgcn_s_setprio(0); } while (0)
#define PG8_WAIT_V(n) asm volatile("s_waitcnt vmcnt(" #n ")" ::: "memory")
#define PG8_WAIT_L(n) asm volatile("s_waitcnt lgkmcnt(" #n ")" ::: "memory")
#define PG8_BAR __builtin_amdgcn_s_barrier()
#define PG8_SCHED __builtin_amdgcn_sched_barrier(0)
    Unit cur, nxt; int ui = 0;
    if (!S.next(0, cur)) return;
    f32x4 acc[2][2][4][2];
#pragma unroll
    for (int a = 0; a < 2; ++a)
#pragma unroll
        for (int b = 0; b < 2; ++b)
#pragma unroll
            for (int m = 0; m < 4; ++m)
#pragma unroll
                for (int n = 0; n < 2; ++n) acc[a][b][m][n] = (f32x4){0.f, 0.f, 0.f, 0.f};
    bf16x8 At[4][2], B0[2][2], B1[2][2]; v8i_t At8[4], B08[2], B18[2];
    const char* cA = (const char*)g.A + (size_t)cur.pm * tstep; const char* cB = (const char*)g.Bt + (size_t)cur.pn * tstep;
    unsigned gc[2][2] = {{0u, 0u}, {0u, 0u}}, gn[2][2] = {{0u, 0u}, {0u, 0u}}; (void)gc; (void)gn;
#define PG8_GOFF(dst, u) do { if constexpr (GATHER) { _Pragma("unroll") for (int _h = 0; _h < 2; ++_h) _Pragma("unroll") for (int _i = 0; _i < 2; ++_i) { int R_, C_; stage_rc(tid * 16 + _i * 8192, R_, C_); \
        int tok_ = S.rowtok[(u).pm * BM + _h * HALF + R_]; tok_ = tok_ < 0 ? 0 : tok_; dst[_h][_i] = (unsigned)tok_ * (unsigned)(K * 2) + (unsigned)(C_ * 2); } } } while (0)
    PG8_GOFF(gc, cur);
    S.a_ready(cur);
    if constexpr (SP2) {
        PG8_STAGE(PG8_SB(0, 0), cB, voffB); PG8_STAGE(PG8_SB(0, 1), cB + hstep, voffB); PG8_STAGE_A(PG8_SA(0, 0), cA, 0, gc, 0); PG8_STAGE_A(PG8_SA(0, 1), cA, 1, gc, 0);
        if (wr == 1) PG8_BAR;
        PG8_WAIT_V(2); PG8_BAR;
        PG8_STAGE(PG8_SB(1, 0), cB + kstep, voffB); PG8_STAGE_A(PG8_SA(1, 0), cA + kstep, 0, gc, kstep); PG8_STAGE(PG8_SB(1, 1), cB + hstep + kstep, voffB);
        PG8_WAIT_V(6); PG8_BAR;
    } else {
        PG8_STAGE(PG8_SB(0, 0), cB, voffB); PG8_STAGE_A(PG8_SA(0, 0), cA, 0, gc, 0); PG8_STAGE(PG8_SB(0, 1), cB + hstep, voffB); PG8_STAGE_A(PG8_SA(0, 1), cA, 1, gc, 0);
        if (wr == 1) PG8_BAR;
        PG8_WAIT_V(4); PG8_BAR;
        PG8_STAGE(PG8_SB(1, 0), cB + kstep, voffB); PG8_STAGE_A(PG8_SA(1, 0), cA + kstep, 0, gc, kstep); PG8_STAGE(PG8_SB(1, 1), cB + hstep + kstep, voffB);
        PG8_WAIT_V(6); PG8_BAR;
    }
    for (;;) {
        const bool has_next = S.next(ui + 1, nxt);
        const char* nA = has_next ? (const char*)g.A + (size_t)nxt.pm * tstep : cA; const char* nB = has_next ? (const char*)g.Bt + (size_t)nxt.pn * tstep : cB;
        if constexpr (GATHER) { if (has_next) { PG8_GOFF(gn, nxt); } else { gn[0][0] = gc[0][0]; gn[0][1] = gc[0][1]; gn[1][0] = gc[1][0]; gn[1][1] = gc[1][1]; } }
        for (int t = 0; t < nt; t += 2) {
            const bool last = (t == nt - 2);
            const char* a1 = cA + (size_t)(t + 1) * kstep;
            const char* a2 = last ? nA : cA + (size_t)(t + 2) * kstep; const char* b2 = last ? nB : cB + (size_t)(t + 2) * kstep;
            const char* a3 = a2 + kstep; const char* b3 = b2 + kstep;
            const size_t kA1 = (size_t)(t + 1) * kstep, kA2 = last ? (size_t)0 : (size_t)(t + 2) * kstep, kA3 = kA2 + kstep; (void)kA1; (void)kA2; (void)kA3;
            unsigned g2[2][2]; _Pragma("unroll") for (int _h = 0; _h < 2; ++_h) _Pragma("unroll") for (int _i = 0; _i < 2; ++_i) g2[_h][_i] = last ? gn[_h][_i] : gc[_h][_i]; (void)g2;
            if (last && has_next) S.a_ready(nxt);
            if constexpr (SP2) {
            PG8_LDB(B0, 0, 0); PG8_LDB(B1, 0, 1); PG8_SCHED; PG8_LDA(At, 0, 0); PG8_STAGE_A(PG8_SA(1, 1), a1, 1, gc, kA1);
            PG8_WAIT_V(8); PG8_WAIT_L(0); PG8_BAR; PG8_MMA(0, 0, At, B0); PG8_MMA(0, 1, At, B1); PG8_BAR; PG8_SCHED;
            PG8_LDA(At, 0, 1); PG8_STAGE(PG8_SB(0, 0), b2, voffB); PG8_STAGE(PG8_SB(0, 1), b2 + hstep, voffB); PG8_STAGE_A(PG8_SA(0, 0), a2, 0, g2, kA2);
            PG8_WAIT_V(8); PG8_WAIT_L(0); PG8_BAR; PG8_MMA(1, 0, At, B0); PG8_MMA(1, 1, At, B1); PG8_BAR; PG8_SCHED;
            PG8_LDB(B0, 1, 0); PG8_LDB(B1, 1, 1); PG8_SCHED; PG8_LDA(At, 1, 0); PG8_STAGE_A(PG8_SA(0, 1), a2, 1, g2, kA2);
            PG8_WAIT_V(8); PG8_WAIT_L(0); PG8_BAR; PG8_MMA(0, 0, At, B0); PG8_MMA(0, 1, At, B1); PG8_BAR; PG8_SCHED;
            PG8_LDA(At, 1, 1); PG8_STAGE(PG8_SB(1, 0), b3, voffB); PG8_STAGE(PG8_SB(1, 1), b3 + hstep, voffB); PG8_STAGE_A(PG8_SA(1, 0), a3, 0, g2, kA3);
            PG8_WAIT_V(8); PG8_WAIT_L(0); PG8_BAR; PG8_MMA(1, 0, At, B0); PG8_MMA(1, 1, At, B1); PG8_BAR; PG8_SCHED;
            } else {
            PG8_LDB(B0, 0, 0); PG8_SCHED; PG8_LDA(At, 0, 0); PG8_STAGE_A(PG8_SA(1, 1), a1, 1, gc, kA1);
            PG8_WAIT_L(8); PG8_BAR; PG8_WAIT_L(0); PG8_MMA(0, 0, At, B0); PG8_BAR; PG8_SCHED;
            PG8_LDB(B1, 0, 1); PG8_STAGE(PG8_SB(0, 0), b2, voffB);
            PG8_BAR; PG8_WAIT_L(0); PG8_MMA(0, 1, At, B1); PG8_BAR;
            PG8_LDA(At, 0, 1); PG8_STAGE_A(PG8_SA(0, 0), a2, 0, g2, kA2);
            PG8_BAR; PG8_WAIT_L(0); PG8_MMA(1, 0, At, B0); PG8_BAR; PG8_SCHED;
            PG8_STAGE(PG8_SB(0, 1), b2 + hstep, voffB);
            PG8_WAIT_V(6); PG8_BAR; PG8_MMA(1, 1, At, B1); PG8_BAR;
            PG8_LDB(B0, 1, 0); PG8_SCHED; PG8_LDA(At, 1, 0); PG8_STAGE_A(PG8_SA(0, 1), a2, 1, g2, kA2);
            PG8_WAIT_L(8); PG8_BAR; PG8_WAIT_L(0); PG8_MMA(0, 0, At, B0); PG8_BAR; PG8_SCHED;
            PG8_LDB(B1, 1, 1); PG8_STAGE(PG8_SB(1, 0), b3, voffB);
            PG8_BAR; PG8_WAIT_L(0); PG8_MMA(0, 1, At, B1); PG8_BAR;
            PG8_LDA(At, 1, 1); PG8_STAGE_A(PG8_SA(1, 0), a3, 0, g2, kA3);
            PG8_BAR; PG8_WAIT_L(0); PG8_MMA(1, 0, At, B0); PG8_BAR; PG8_SCHED;
            PG8_STAGE(PG8_SB(1, 1), b3 + hstep, voffB);
            PG8_WAIT_V(6); PG8_BAR; PG8_MMA(1, 1, At, B1); PG8_BAR;
            }
        }
        if constexpr (F8) { asm volatile("s_nop 15\n\ts_nop 15" ::: "memory"); }
        if constexpr (ALIGN_EPI) { if (wr == 0) PG8_BAR; }
        bool partial_ = false;
        if constexpr (Epi::HAS_MID) partial_ = S.partial(cur);
        if constexpr (!Epi::AFTER_DRAIN) { if constexpr (Epi::HAS_MID) { if (partial_) E.mid(acc, cur, wr, wc, fr, fq); else E(acc, cur, wr, wc, fr, fq); } else { E(acc, cur, wr, wc, fr, fq); } S.done(cur); }
        if (!has_next) break;
        if (!partial_)
#pragma unroll
        for (int a = 0; a < 2; ++a)
#pragma unroll
            for (int b = 0; b < 2; ++b)
#pragma unroll
                for (int m = 0; m < 4; ++m)
#pragma unroll
                    for (int n = 0; n < 2; ++n) acc[a][b][m][n] = (f32x4){0.f, 0.f, 0.f, 0.f};
        cur = nxt; cA = nA; cB = nB; ++ui; gc[0][0] = gn[0][0]; gc[0][1] = gn[0][1]; gc[1][0] = gn[1][0]; gc[1][1] = gn[1][1];
        if constexpr (ALIGN_EPI) { if (wr == 1) PG8_BAR; }
    }
    PG8_WAIT_V(0);
    if constexpr (!ALIGN_EPI) { if (wr == 0) PG8_BAR; }
    PG8_BAR;
    if constexpr (Epi::AFTER_DRAIN) { E.fused(acc, cur, wr, wc, fr, fq, lds, wid, lane); S.done(cur); }
#undef PG8_SA
#undef PG8_SB
#undef PG8_STAGE
#undef PG8_STAGE_A
#undef PG8_GOFF
#undef PG8_LDA
#undef PG8_LDB
#undef PG8_MMA
#undef PG8_WAIT_V
#undef PG8_WAIT_L
#undef PG8_BAR
#undef PG8_SCHED
}
}

#define XB_TMO      128
#define XB_XCNT(j)  (256  + 64 * (j))
#define XB_XSUB(j)  (1280 + 64 * (j))
#define XB_XGEN(j)  (2304 + 64 * (j))
#define XB_TOP      3328
#define XB_TOPGEN   3392
#define XCD_BAR_WORDS 3456
#define XB_SPIN_CAP (1u << 23)
__device__ __forceinline__ unsigned xb_ld(unsigned* p)              { return __hip_atomic_load(p, __ATOMIC_RELAXED, __HIP_MEMORY_SCOPE_AGENT); }
__device__ __forceinline__ unsigned xb_add(unsigned* p, unsigned v) { return __hip_atomic_fetch_add(p, v, __ATOMIC_RELAXED, __HIP_MEMORY_SCOPE_AGENT); }
__device__ __forceinline__ unsigned xb_xcc_id() { return (unsigned)__builtin_amdgcn_s_getreg((3 << 11) | 20) & 0xFu; }
#define XB_SPIN(cond, bar) do { unsigned _sp = 0; while (cond) { __builtin_amdgcn_s_sleep(1); \
    if ((++_sp & 255u) == 0u) { if (xb_ld(&(bar)[XB_TMO])) break; if (_sp > XB_SPIN_CAP) { atomicAdd(&(bar)[XB_TMO], 1u); break; } } } } while (0)
struct XcdBarrier { unsigned* bar; unsigned x; volatile LAS unsigned* st; };
__device__ __forceinline__ XcdBarrier xcd_barrier_post(unsigned* bar, volatile LAS unsigned* st) {
    XcdBarrier b; b.bar = bar; b.x = xb_xcc_id(); b.st = st;
    if (threadIdx.x == 0) (void)xb_add(&bar[XB_XCNT(b.x)], 1u);
    return b;
}
__device__ __forceinline__ void xcd_barrier_complete(unsigned* bar, unsigned x, unsigned& nloc, unsigned& nx) {
    const unsigned G = gridDim.x * gridDim.y * gridDim.z;
    unsigned sum, cnt, mine, sp = 0u;
    for (;;) {
        sum = 0u; cnt = 0u; mine = 0u;
#pragma unroll
        for (unsigned j = 0; j < 16; ++j) { const unsigned c = xb_ld(&bar[XB_XCNT(j)]); sum += c; cnt += (c > 0u) ? 1u : 0u; mine = (j == x) ? c : mine; }
        if (sum == G) break;
        __builtin_amdgcn_s_sleep(1);
        if ((++sp & 255u) == 0u) { if (xb_ld(&bar[XB_TMO])) break; if (sp > XB_SPIN_CAP) { atomicAdd(&bar[XB_TMO], 1u); break; } }
    }
    nloc = mine > 0u ? mine : 1u; nx = cnt > 0u ? cnt : 1u;
}
__device__ __forceinline__ void xcd_barrier(const XcdBarrier& b) {
    asm volatile("s_waitcnt vmcnt(0)" ::: "memory");
    __syncthreads();
    if (threadIdx.x == 0) {
        unsigned* bar = b.bar;
        __builtin_amdgcn_s_waitcnt(0);
        unsigned nloc = b.st[0], nx = b.st[1];
        if (nloc == 0u) { xcd_barrier_complete(bar, b.x, nloc, nx); b.st[0] = nloc; b.st[1] = nx; }
        const unsigned old = xb_add(&bar[XB_XSUB(b.x)], 1u);
        const unsigned gen = old / nloc;
        if (old + 1u == (gen + 1u) * nloc) {
            __builtin_amdgcn_fence(__ATOMIC_RELEASE, "agent");
            asm volatile("s_waitcnt vmcnt(0)" ::: "memory");
            const unsigned og = xb_add(&bar[XB_TOP], 1u);
            const unsigned tg = og / nx;
            if (og + 1u == (tg + 1u) * nx) xb_add(&bar[XB_TOPGEN], 1u);
            else XB_SPIN(xb_ld(&bar[XB_TOPGEN]) == tg, bar);
            __builtin_amdgcn_fence(__ATOMIC_ACQUIRE, "agent");
            xb_add(&bar[XB_XGEN(b.x)], 1u);
            asm volatile("s_waitcnt vmcnt(0)" ::: "memory");
        } else {
            XB_SPIN(xb_ld(&bar[XB_XGEN(b.x)]) == gen, bar);
            __builtin_amdgcn_fence(__ATOMIC_ACQUIRE, "agent");
            asm volatile("s_waitcnt vmcnt(0)" ::: "memory");
        }
    }
    __syncthreads();
}

constexpr int NWAVES = 8, NTHR = 512;
constexpr int T = 32768, SEQ = 16384, D = 2048, NPROJ = 10752, NEXP = 32, TOPK = 4;
constexpr int C_R = 0, C_K = 1024, C_V = 2048, C_WD = 3072, C_AD = 3168, C_GD = 3264, C_QD = 3584, C_KD = 4608, C_VD = 5632, C_GA = 6656, C_GB = 8704;
constexpr int P_MAX = 131072 + 32 * 256;
constexpr int MAX_TILES = P_MAX / 256;
constexpr float ATT_C2 = 0.125f * 1.4426950408889634f;
constexpr float LAMBDA_INIT = 0.2f;

constexpr size_t MiB = 1u << 20;
constexpr size_t WS_CTL = 0, CTL_ZERO_BYTES = 64 * 1024;
constexpr size_t WS_MOD = 1 * MiB;
constexpr size_t WS_GS2 = WS_MOD + 128 * 1024;
constexpr size_t WS_WRT = WS_GS2 + 32 * 1024;
constexpr size_t WS_WGCNT = WS_WRT + 256 * 1024;
constexpr size_t WS_TILEEXP = WS_WGCNT + 32 * 1024;
constexpr size_t WS_ROPE = 2 * MiB;
constexpr size_t WS_TOPIDX = 3 * MiB;
constexpr size_t WS_TOPW = WS_TOPIDX + 512 * 1024;
constexpr size_t WS_SLOTPOS = 4 * MiB;
constexpr size_t WS_ROWTOK = WS_SLOTPOS + 512 * 1024;
constexpr size_t WS_ROWGATE = WS_ROWTOK + 576 * 1024;
constexpr size_t WS_BONUS = 6 * MiB;
constexpr size_t WS_BTLORA = 8 * MiB;
constexpr size_t WS_ROWSS = 12 * MiB;
constexpr size_t WS_WTIN = 16 * MiB;
constexpr size_t WS_WTBA = 58 * MiB, WS_WTBB = 60 * MiB, WS_WTOUT = 66 * MiB;
constexpr size_t WS_H = 74 * MiB;
constexpr size_t WS_PROJ = 202 * MiB;
constexpr size_t WS_MFRAG = 874 * MiB, WS_NFRAG = 938 * MiB, WS_PBUF = 1002 * MiB, WS_Y0 = 1066 * MiB, WS_SBUF = 1130 * MiB;
constexpr size_t WS_OB = 1194 * MiB, WS_OA = 1258 * MiB;
constexpr size_t WS_MERGED = 1322 * MiB;
constexpr size_t WS_OA8 = WS_MERGED, WS_OB8 = WS_MERGED + 32 * MiB, WS_MERGED8 = WS_MERGED + 64 * MiB;
constexpr size_t WS_VSC = 1194 * MiB;
constexpr size_t WS_MA = 1194 * MiB;
constexpr size_t WS_WTGU = 1450 * MiB;
constexpr size_t WS_WTDN = 1706 * MiB;
constexpr size_t WS_VT = 1834 * MiB;
constexpr size_t WS_QK8 = 1866 * MiB;
constexpr size_t WS_END = 1962 * MiB;
constexpr size_t WS_XS = WS_PROJ;
constexpr size_t WS_YR = WS_PROJ;
constexpr size_t WS_ACT = WS_MFRAG;
constexpr int F8_SW = 7, F8_SH = 4, F8_SA = 2, F8_SV = 4, F8_SQ = 6, F8_SK = 4;
constexpr int F8_SC_GU = (127 - F8_SW - F8_SH) * 0x01010101, F8_SC_DN = (127 - F8_SW - F8_SA) * 0x01010101;
static_assert((size_t)T * NPROJ * 2 <= WS_MFRAG - WS_PROJ && WS_YR + (size_t)P_MAX * 2048 * 2 <= WS_MFRAG && (size_t)P_MAX * 2048 <= WS_WTGU - WS_ACT, "ws map");
constexpr int CW_QUEUE = 4608;
constexpr int CW_BAR = 1024;

constexpr int RING_BYTES = 131072, MISC_OFF = RING_BYTES + 320, LDS_BYTES = 147456;

struct Args { const float* in[36]; float* out; unsigned char* ws; int ph_lo, ph_hi; };
struct Ctx {
    const Args& a;
    LAS unsigned char* lds;
    int tid, lane, wave, G, bid;
    float* out;
    unsigned char* ws;
    DI const float* x() const { return a.in[0]; }
    DI const float* c() const { return a.in[1]; }
    DI const float* w_ada() const { return a.in[2]; }
    DI const float* b_ada() const { return a.in[3]; }
    DI const float* norm1_gain() const { return a.in[4]; }
    DI const float* norm2_gain() const { return a.in[5]; }
    DI const float* w_in() const { return a.in[6]; }
    DI const float* shift_mu() const { return a.in[7]; }
    DI const float* w0() const { return a.in[8]; }
    DI const float* w_decay_up() const { return a.in[9]; }
    DI const float* a0() const { return a.in[10]; }
    DI const float* w_aaa_up() const { return a.in[11]; }
    DI const float* w_gate_up() const { return a.in[12]; }
    DI const float* k_k() const { return a.in[13]; }
    DI const float* k_a() const { return a.in[14]; }
    DI const float* r_k() const { return a.in[15]; }
    DI const float* gn_w() const { return a.in[16]; }
    DI const float* gn_b() const { return a.in[17]; }
    DI const float* q_gain() const { return a.in[18]; }
    DI const float* k_gain() const { return a.in[19]; }
    DI const float* lam_q1() const { return a.in[20]; }
    DI const float* lam_k1() const { return a.in[21]; }
    DI const float* lam_q2() const { return a.in[22]; }
    DI const float* lam_k2() const { return a.in[23]; }
    DI const float* subln_gain() const { return a.in[24]; }
    DI const float* w_branch_a() const { return a.in[25]; }
    DI const float* w_branch_b() const { return a.in[26]; }
    DI const float* w_out() const { return a.in[27]; }
    DI const float* w_router() const { return a.in[28]; }
    DI const float* b_router() const { return a.in[29]; }
    DI const float* w_exp_gate() const { return a.in[30]; }
    DI const float* b_exp_gate() const { return a.in[31]; }
    DI const float* w_exp_up() const { return a.in[32]; }
    DI const float* b_exp_up() const { return a.in[33]; }
    DI const float* w_exp_down() const { return a.in[34]; }
    DI const float* b_exp_down() const { return a.in[35]; }
};
#define WSP(type, off) ((type*)(C.ws + (off)))

DI unsigned pk4_fp8(float a, float b, float c, float d) {
    a = __builtin_amdgcn_fmed3f(a, -448.f, 448.f); b = __builtin_amdgcn_fmed3f(b, -448.f, 448.f); c = __builtin_amdgcn_fmed3f(c, -448.f, 448.f); d = __builtin_amdgcn_fmed3f(d, -448.f, 448.f);
    int p = __builtin_amdgcn_cvt_pk_fp8_f32(a, b, 0, false); p = __builtin_amdgcn_cvt_pk_fp8_f32(c, d, p, true); return (unsigned)p; }
struct EpiPlainBf16 {
    static constexpr bool PERM = true, AFTER_DRAIN = false, HAS_MID = false;
    bf16_t* O; int ldc;
    DI void operator()(const f32x4 (&acc)[2][2][4][2], const pg8::Unit& u, int wr, int wc, int fr, int fq) const {
        const int row0 = u.pm * 256 + wr * 64 + fr, col0 = u.pn * 256 + wc * 32 + 8 * fq;
#pragma unroll
        for (int ai = 0; ai < 2; ++ai)
#pragma unroll
            for (int m = 0; m < 4; ++m) { bf16_t* rowp = O + (size_t)(row0 + ai * 128 + m * 16) * ldc + col0;
#pragma unroll
                for (int bj = 0; bj < 2; ++bj) { const f32x4 v0 = acc[ai][bj][m][0], v1 = acc[ai][bj][m][1];
                    u32x4 w; w.x = pg8::cvt_pk_bf16(v0[0], v0[1]); w.y = pg8::cvt_pk_bf16(v0[2], v0[3]); w.z = pg8::cvt_pk_bf16(v1[0], v1[1]); w.w = pg8::cvt_pk_bf16(v1[2], v1[3]);
                    *(u32x4*)(rowp + bj * 128) = w; } }
    }
};
struct LoraOrder : pg8::StaticOrder {
    DI bool next(int i, pg8::Unit& u) const { if (!pg8::StaticOrder::next(i, u)) return false; if (u.pn >= 8) u.pm += T / 256; return true; }
};
struct EpiLora {
    static constexpr bool PERM = true, AFTER_DRAIN = false, HAS_MID = false;
    bf16_t* G0; const float *w0, *a0;
    DI void operator()(const f32x4 (&acc)[2][2][4][2], const pg8::Unit& u, int wr, int wc, int fr, int fq) const {
        const int sec = u.pn >> 2;
        bf16_t* base = G0 + (size_t)(sec == 2 ? 0 : sec + 1) * ((size_t)T * 1024);
        const int row0 = (u.pm & (T / 256 - 1)) * 256 + wr * 64 + fr, col0 = (u.pn & 3) * 256 + wc * 32 + 8 * fq;
        const float* bias = sec == 0 ? w0 : a0;
#pragma unroll
        for (int bj = 0; bj < 2; ++bj) {
            f32x4 b0 = (f32x4){0.f, 0.f, 0.f, 0.f}, b1 = b0;
            if (sec < 2) { b0 = *(const f32x4*)(bias + col0 + bj * 128); b1 = *(const f32x4*)(bias + col0 + bj * 128 + 4); }
#pragma unroll
            for (int ai = 0; ai < 2; ++ai)
#pragma unroll
                for (int m = 0; m < 4; ++m) {
                    f32x4 v0 = acc[ai][bj][m][0] + b0, v1 = acc[ai][bj][m][1] + b1;
                    if (sec == 0) {
#pragma unroll
                        for (int e = 0; e < 4; ++e) {
                            float z = -v0[e]; float sp = fmaxf(z, 0.f) + __logf(1.f + __expf(-fabsf(z))); v0[e] = -__expf(-sp - 0.5f);
                            z = -v1[e]; sp = fmaxf(z, 0.f) + __logf(1.f + __expf(-fabsf(z))); v1[e] = -__expf(-sp - 0.5f); }
                    } else if (sec == 1) {
#pragma unroll
                        for (int e = 0; e < 4; ++e) { v0[e] = sigmoidf_(v0[e]); v1[e] = sigmoidf_(v1[e]); }
                    }
                    u32x4 w; w.x = pg8::cvt_pk_bf16(v0[0], v0[1]); w.y = pg8::cvt_pk_bf16(v0[2], v0[3]); w.z = pg8::cvt_pk_bf16(v1[0], v1[1]); w.w = pg8::cvt_pk_bf16(v1[2], v1[3]);
                    *(u32x4*)(base + (size_t)(row0 + ai * 128 + m * 16) * 1024 + col0 + bj * 128) = w;
                }
        }
    }
};
struct BranchOrder : pg8::StaticOrder {
    DI bool next(int i, pg8::Unit& u) const { if (!pg8::StaticOrder::next(i >> 1, u)) return false; if (i & 1) { u.pm += T / 256; u.pn += D / 256; } return true; }
    DI bool partial(const pg8::Unit& u) const { return u.pm < T / 256; }
};
struct EpiBranchFused {
    static constexpr bool PERM = true, AFTER_DRAIN = false, HAS_MID = true;
    unsigned char* O8; const bf16_t* proj;
    DI void mid(f32x4 (&acc)[2][2][4][2], const pg8::Unit& u, int wr, int wc, int fr, int fq) const {
        const int row0 = u.pm * 256 + wr * 64 + fr, col0 = u.pn * 256 + wc * 32 + 8 * fq;
#pragma unroll
        for (int ai = 0; ai < 2; ++ai)
#pragma unroll
            for (int m = 0; m < 4; ++m) { const size_t row = (size_t)(row0 + ai * 128 + m * 16);
#pragma unroll
                for (int bj = 0; bj < 2; ++bj) {
                    const u32x4 ga = *(const u32x4*)(proj + row * NPROJ + C_GA + col0 + bj * 128), gb = *(const u32x4*)(proj + row * NPROJ + C_GB + col0 + bj * 128);
                    const unsigned gaw[4] = {ga.x, ga.y, ga.z, ga.w}, gbw[4] = {gb.x, gb.y, gb.z, gb.w};
#pragma unroll
                    for (int q = 0; q < 4; ++q) {
                        const float r0 = (1.f + __expf(-bflo(gbw[q]))) * __builtin_amdgcn_rcpf(1.f + __expf(-bflo(gaw[q]))), r1 = (1.f + __expf(-bfhi(gbw[q]))) * __builtin_amdgcn_rcpf(1.f + __expf(-bfhi(gaw[q])));
                        acc[ai][bj][m][q >> 1][2 * (q & 1)] *= r0; acc[ai][bj][m][q >> 1][2 * (q & 1) + 1] *= r1; } } }
    }
    DI void operator()(const f32x4 (&acc)[2][2][4][2], const pg8::Unit& u, int wr, int wc, int fr, int fq) const {
        const int row0 = (u.pm - T / 256) * 256 + wr * 64 + fr, col0 = (u.pn - D / 256) * 256 + wc * 32 + 8 * fq; const float s_ = (float)(1 << F8_SH);
#pragma unroll
        for (int ai = 0; ai < 2; ++ai) {
            u32x4 gbv[4][2];
#pragma unroll
            for (int m = 0; m < 4; ++m)
#pragma unroll
                for (int bj = 0; bj < 2; ++bj) gbv[m][bj] = *(const u32x4*)(proj + (size_t)(row0 + ai * 128 + m * 16) * NPROJ + C_GB + col0 + bj * 128);
#pragma unroll
            for (int m = 0; m < 4; ++m) { const size_t row = (size_t)(row0 + ai * 128 + m * 16);
#pragma unroll
                for (int bj = 0; bj < 2; ++bj) {
                    const u32x4 gb = gbv[m][bj];
                    f32x4 v0 = acc[ai][bj][m][0], v1 = acc[ai][bj][m][1];
                    v0[0] *= sigmoidf_(bflo(gb.x)) * s_; v0[1] *= sigmoidf_(bfhi(gb.x)) * s_; v0[2] *= sigmoidf_(bflo(gb.y)) * s_; v0[3] *= sigmoidf_(bfhi(gb.y)) * s_;
                    v1[0] *= sigmoidf_(bflo(gb.z)) * s_; v1[1] *= sigmoidf_(bfhi(gb.z)) * s_; v1[2] *= sigmoidf_(bflo(gb.w)) * s_; v1[3] *= sigmoidf_(bfhi(gb.w)) * s_;
                    *(u32x2*)(O8 + row * 2048 + col0 + bj * 128) = (u32x2){pk4_fp8(v0[0], v0[1], v0[2], v0[3]), pk4_fp8(v1[0], v1[1], v1[2], v1[3])}; } }
        }
    }
};
template <bool ADD> struct EpiBranch {
    static constexpr bool PERM = true, AFTER_DRAIN = false, HAS_MID = false;
    bf16_t* MA; unsigned char* O8; const bf16_t* proj; int gcol0;
    DI void operator()(const f32x4 (&acc)[2][2][4][2], const pg8::Unit& u, int wr, int wc, int fr, int fq) const {
        const int row0 = u.pm * 256 + wr * 64 + fr, col0 = u.pn * 256 + wc * 32 + 8 * fq;
#pragma unroll
        for (int ai = 0; ai < 2; ++ai) {
            u32x4 gwv[4][2], pwv[4][2];
#pragma unroll
            for (int m = 0; m < 4; ++m)
#pragma unroll
                for (int bj = 0; bj < 2; ++bj) { const size_t row = (size_t)(row0 + ai * 128 + m * 16);
                    gwv[m][bj] = *(const u32x4*)(proj + row * NPROJ + gcol0 + col0 + bj * 128);
                    if (ADD) pwv[m][bj] = *(const u32x4*)(MA + row * 2048 + col0 + bj * 128); }
#pragma unroll
            for (int m = 0; m < 4; ++m) { const size_t row = (size_t)(row0 + ai * 128 + m * 16);
#pragma unroll
                for (int bj = 0; bj < 2; ++bj) {
                    const u32x4 gw = gwv[m][bj];
                    f32x4 v0 = acc[ai][bj][m][0], v1 = acc[ai][bj][m][1];
                    v0[0] *= sigmoidf_(bflo(gw.x)); v0[1] *= sigmoidf_(bfhi(gw.x)); v0[2] *= sigmoidf_(bflo(gw.y)); v0[3] *= sigmoidf_(bfhi(gw.y));
                    v1[0] *= sigmoidf_(bflo(gw.z)); v1[1] *= sigmoidf_(bfhi(gw.z)); v1[2] *= sigmoidf_(bflo(gw.w)); v1[3] *= sigmoidf_(bfhi(gw.w));
                    if (ADD) { const u32x4 pw = pwv[m][bj]; const float s_ = (float)(1 << F8_SH);
                        v0[0] += bflo(pw.x); v0[1] += bfhi(pw.x); v0[2] += bflo(pw.y); v0[3] += bfhi(pw.y);
                        v1[0] += bflo(pw.z); v1[1] += bfhi(pw.z); v1[2] += bflo(pw.w); v1[3] += bfhi(pw.w);
                        *(u32x2*)(O8 + row * 2048 + col0 + bj * 128) = (u32x2){pk4_fp8(v0[0] * s_, v0[1] * s_, v0[2] * s_, v0[3] * s_), pk4_fp8(v1[0] * s_, v1[1] * s_, v1[2] * s_, v1[3] * s_)};
                    } else {
                        u32x4 w; w.x = pg8::cvt_pk_bf16(v0[0], v0[1]); w.y = pg8::cvt_pk_bf16(v0[2], v0[3]); w.z = pg8::cvt_pk_bf16(v1[0], v1[1]); w.w = pg8::cvt_pk_bf16(v1[2], v1[3]);
                        *(u32x4*)(MA + row * 2048 + col0 + bj * 128) = w; } } }
        }
    }
};
struct EpiOut {
    static constexpr bool PERM = false, AFTER_DRAIN = false, HAS_MID = false;
    float* O; const float* X; const float* mod; float* rowss;
    DI void operator()(const f32x4 (&acc)[2][2][4][2], const pg8::Unit& u, int wr, int wc, int fr, int fq) const {
        const int row0 = u.pm * 256 + wr * 64 + fr, col0 = u.pn * 256 + wc * 32 + 4 * fq;
        const float* g1 = mod + (size_t)((u.pm * 256) / SEQ) * 12288 + 4096;
        f32x4 gv[2][2];
#pragma unroll
        for (int bj = 0; bj < 2; ++bj)
#pragma unroll
            for (int n = 0; n < 2; ++n) gv[bj][n] = *(const f32x4*)(g1 + col0 + bj * 128 + n * 16);
#pragma unroll
        for (int ai = 0; ai < 2; ++ai) {
            f32x4 xv[4][2][2];
#pragma unroll
            for (int m = 0; m < 4; ++m)
#pragma unroll
                for (int bj = 0; bj < 2; ++bj)
#pragma unroll
                    for (int n = 0; n < 2; ++n) xv[m][bj][n] = *(const f32x4*)(X + (size_t)(row0 + ai * 128 + m * 16) * 2048 + col0 + bj * 128 + n * 16);
#pragma unroll
            for (int m = 0; m < 4; ++m) { const size_t ro = (size_t)(row0 + ai * 128 + m * 16) * 2048 + col0; float ss = 0.f;
#pragma unroll
                for (int bj = 0; bj < 2; ++bj)
#pragma unroll
                    for (int n = 0; n < 2; ++n) {
                        const f32x4 ov = xv[m][bj][n] + gv[bj][n] * acc[ai][bj][m][n]; ss += (ov[0] * ov[0] + ov[1] * ov[1]) + (ov[2] * ov[2] + ov[3] * ov[3]);
                        *(f32x4*)(O + ro + bj * 128 + n * 16) = ov; }
                ss = sum_x32(sum_x16(ss));
                if (fq == 0) rowss[(size_t)(row0 + ai * 128 + m * 16) * 32 + u.pn * 4 + wc] = ss; }
        }
    }
};
struct EpiGateUp {
    static constexpr bool PERM = true, AFTER_DRAIN = false, HAS_MID = false;
    unsigned char* ACT; const float *bg, *bu;
    DI void operator()(const f32x4 (&acc)[2][2][4][2], const pg8::Unit& u, int wr, int wc, int fr, int fq) const {
        const int e = u.pn >> 4, ct = u.pn & 15;
        const int row0 = u.pm * 256 + wr * 64 + fr, col0 = ct * 128 + wc * 32 + 8 * fq;
        const f32x4 g0 = *(const f32x4*)(bg + e * 2048 + col0), g1 = *(const f32x4*)(bg + e * 2048 + col0 + 4);
        const f32x4 u0 = *(const f32x4*)(bu + e * 2048 + col0), u1 = *(const f32x4*)(bu + e * 2048 + col0 + 4);
#pragma unroll
        for (int ai = 0; ai < 2; ++ai)
#pragma unroll
            for (int m = 0; m < 4; ++m) {
                f32x4 gt0 = acc[ai][0][m][0] + g0, gt1 = acc[ai][0][m][1] + g1, up0 = acc[ai][1][m][0] + u0, up1 = acc[ai][1][m][1] + u1, r0, r1;
#pragma unroll
                for (int k = 0; k < 4; ++k) {
                    float g = fminf(gt0[k], 7.f), p = __builtin_amdgcn_fmed3f(up0[k], -7.f, 7.f); r0[k] = (p + 1.f) * g * __builtin_amdgcn_rcpf(1.f + __builtin_amdgcn_exp2f(g * (-1.702f * 1.4426950408889634f)));
                    g = fminf(gt1[k], 7.f); p = __builtin_amdgcn_fmed3f(up1[k], -7.f, 7.f); r1[k] = (p + 1.f) * g * __builtin_amdgcn_rcpf(1.f + __builtin_amdgcn_exp2f(g * (-1.702f * 1.4426950408889634f))); }
                const float sa = (float)(1 << F8_SA);
                *(u32x2*)(ACT + (size_t)(row0 + ai * 128 + m * 16) * 2048 + col0) = (u32x2){pk4_fp8(r0[0] * sa, r0[1] * sa, r0[2] * sa, r0[3] * sa), pk4_fp8(r1[0] * sa, r1[1] * sa, r1[2] * sa, r1[3] * sa)};
            }
    }
};
struct EpiDown {
    static constexpr bool PERM = true, AFTER_DRAIN = false, HAS_MID = false;
    bf16_t* Y; const float* bd; const float* row_gate;
    DI void operator()(const f32x4 (&acc)[2][2][4][2], const pg8::Unit& u, int wr, int wc, int fr, int fq) const {
        const int e = u.pn >> 3, ct = u.pn & 7;
        const int row0 = u.pm * 256 + wr * 64 + fr, col0 = ct * 256 + wc * 32 + 8 * fq;
        f32x4 bv[2][2]; float gwv[2][4];
#pragma unroll
        for (int bj = 0; bj < 2; ++bj) { bv[bj][0] = *(const f32x4*)(bd + e * 2048 + col0 + bj * 128); bv[bj][1] = *(const f32x4*)(bd + e * 2048 + col0 + bj * 128 + 4); }
#pragma unroll
        for (int ai = 0; ai < 2; ++ai)
#pragma unroll
            for (int m = 0; m < 4; ++m) gwv[ai][m] = row_gate[row0 + ai * 128 + m * 16];
#pragma unroll
        for (int ai = 0; ai < 2; ++ai)
#pragma unroll
            for (int m = 0; m < 4; ++m) { const int row = row0 + ai * 128 + m * 16; const float gw = gwv[ai][m];
#pragma unroll
                for (int bj = 0; bj < 2; ++bj) {
                    const f32x4 b0 = bv[bj][0], b1 = bv[bj][1];
                    const f32x4 v0 = (acc[ai][bj][m][0] + b0) * gw, v1 = (acc[ai][bj][m][1] + b1) * gw;
                    u32x4 w; w.x = pg8::cvt_pk_bf16(v0[0], v0[1]); w.y = pg8::cvt_pk_bf16(v0[2], v0[3]); w.z = pg8::cvt_pk_bf16(v1[0], v1[1]); w.w = pg8::cvt_pk_bf16(v1[2], v1[3]);
                    *(u32x4*)(Y + (size_t)row * 2048 + col0 + bj * 128) = w; } }
    }
};
struct MoeOrder {
    const int* tile_tab; int NCT, G, c; const int* rowtok;
    DI bool next(int i, pg8::Unit& u) const {
        const int n_tiles = tile_tab[0]; const long L = (long)i * G + c;
        const int RB = 256 / NCT;
        const int blk = (int)(L >> 8), l = (int)(L & 255), x = l >> 5, s = l & 31;
        int rt, ct;
        if (NCT == 16) { rt = blk * RB + 4 * (x >> 1) + (s >> 3); ct = 8 * (x & 1) + (s & 7); }
        else { rt = blk * RB + 4 * x + (s >> 3); ct = s & 7; }
        if (G != 256 || NCT * RB != 256) { if (L >= (long)n_tiles * NCT) return false; rt = (int)(L / NCT); ct = (int)(L % NCT); }
        else if (blk * RB >= n_tiles) return false;
        if (rt >= n_tiles) return false;
        u.pm = rt; u.pn = tile_tab[16 + rt] * NCT + ct; return true;
    }
    DI void a_ready(const pg8::Unit&) const {}
    DI void done(const pg8::Unit&) const {}
};
DI void transpose_item(const float* src, int ld_src, int k0, int n0, bf16_t* dst, int ld_dst, size_t drow0, int dcol0, LAS float* scr, int lane) {
#pragma unroll 8
    for (int i = 0; i < 32; ++i) { const int kk = 2 * i + (lane >> 5); scr[kk * 33 + (lane & 31)] = src[(size_t)(k0 + kk) * ld_src + n0 + (lane & 31)]; }
    asm volatile("s_waitcnt lgkmcnt(0)" ::: "memory");
    const int c = lane & 7;
#pragma unroll
    for (int j = 0; j < 4; ++j) { const int n = (lane >> 3) + 8 * j; const LAS float* s = scr + (8 * c) * 33 + n;
        u32x4 o; o.x = pk2(s[0 * 33], s[1 * 33]); o.y = pk2(s[2 * 33], s[3 * 33]); o.z = pk2(s[4 * 33], s[5 * 33]); o.w = pk2(s[6 * 33], s[7 * 33]);
        *(u32x4*)(dst + (drow0 + n) * (size_t)ld_dst + dcol0 + 8 * c) = o; }
    asm volatile("s_waitcnt lgkmcnt(0)" ::: "memory");
}
DI void transpose_item_f8(const float* src, int ld_src, int k0, int n0, unsigned char* dst, int ld_dst, size_t drow0, int dcol0, LAS float* scr, int lane) {
#pragma unroll 8
    for (int i = 0; i < 32; ++i) { const int kk = 2 * i + (lane >> 5); scr[kk * 33 + (lane & 31)] = src[(size_t)(k0 + kk) * ld_src + n0 + (lane & 31)]; }
    asm volatile("s_waitcnt lgkmcnt(0)" ::: "memory");
    const int c = lane & 7; const float sw = (float)(1 << F8_SW);
#pragma unroll
    for (int j = 0; j < 4; ++j) { const int n = (lane >> 3) + 8 * j; const LAS float* s = scr + (8 * c) * 33 + n;
        const u32x2 o = {pk4_fp8(s[0 * 33] * sw, s[1 * 33] * sw, s[2 * 33] * sw, s[3 * 33] * sw), pk4_fp8(s[4 * 33] * sw, s[5 * 33] * sw, s[6 * 33] * sw, s[7 * 33] * sw)};
        *(u32x2*)(dst + (drow0 + n) * (size_t)ld_dst + dcol0 + 8 * c) = o; }
    asm volatile("s_waitcnt lgkmcnt(0)" ::: "memory");
}
DI void transpose64_f8(const float* src, int ld_src, int k0, int n0, unsigned char* dst, int ld_dst, size_t drow0, int dcol0, int lane) {
    const float* s = src + (size_t)k0 * ld_src + n0 + lane; const float sw = (float)(1 << F8_SW);
    float v[64];
#pragma unroll
    for (int k = 0; k < 64; ++k) v[k] = s[(size_t)k * ld_src];
    unsigned char* d = dst + (drow0 + lane) * (size_t)ld_dst + dcol0;
#pragma unroll
    for (int q = 0; q < 4; ++q) { u32x4 o;
        o.x = pk4_fp8(v[16 * q + 0] * sw, v[16 * q + 1] * sw, v[16 * q + 2] * sw, v[16 * q + 3] * sw); o.y = pk4_fp8(v[16 * q + 4] * sw, v[16 * q + 5] * sw, v[16 * q + 6] * sw, v[16 * q + 7] * sw);
        o.z = pk4_fp8(v[16 * q + 8] * sw, v[16 * q + 9] * sw, v[16 * q + 10] * sw, v[16 * q + 11] * sw); o.w = pk4_fp8(v[16 * q + 12] * sw, v[16 * q + 13] * sw, v[16 * q + 14] * sw, v[16 * q + 15] * sw);
        *(u32x4*)(d + 16 * q) = o; }
}
DI void zero_item_f8(unsigned char* dst, int ld_dst, size_t drow0, int dcol0, int lane) {
    const int c = lane & 7;
#pragma unroll
    for (int j = 0; j < 4; ++j) { const int n = (lane >> 3) + 8 * j; *(u32x2*)(dst + (drow0 + n) * (size_t)ld_dst + dcol0 + 8 * c) = (u32x2){0u, 0u}; }
}
DI void zero_item(bf16_t* dst, int ld_dst, size_t drow0, int dcol0, int lane) {
    const int c = lane & 7;
#pragma unroll
    for (int j = 0; j < 4; ++j) { const int n = (lane >> 3) + 8 * j; *(u32x4*)(dst + (drow0 + n) * (size_t)ld_dst + dcol0 + 8 * c) = (u32x4){0u, 0u, 0u, 0u}; }
}
DI void sincos_d(double x, float& s, float& c) {
    const double n = __builtin_rint(x * 0.63661977236758134308);
    const double r = (x - n * 1.5707963267948966192) - n * 6.123233995736766e-17;
    const double r2 = r * r;
    double sp = -7.647163731819816e-13; sp = sp * r2 + 1.605904383682161e-10; sp = sp * r2 - 2.505210838544172e-08; sp = sp * r2 + 2.755731922398589e-06;
    sp = sp * r2 - 1.984126984126984e-04; sp = sp * r2 + 8.333333333333333e-03; sp = sp * r2 - 1.666666666666667e-01; sp = r + r * r2 * sp;
    double cp = 4.779477332387385e-14; cp = cp * r2 - 1.147074559772972e-11; cp = cp * r2 + 2.087675698786810e-09; cp = cp * r2 - 2.755731922398589e-07;
    cp = cp * r2 + 2.480158730158730e-05; cp = cp * r2 - 1.388888888888889e-03; cp = cp * r2 + 4.166666666666666e-02; cp = cp * r2 - 0.5; cp = 1.0 + r2 * cp;
    const int q = ((int)n) & 3;
    const double ss = (q == 0) ? sp : (q == 1) ? cp : (q == 2) ? -sp : -cp;
    const double cc = (q == 0) ? cp : (q == 1) ? -sp : (q == 2) ? -cp : sp;
    s = (float)ss; c = (float)cc;
}
DI void phase_prologue(Ctx& C) {
    const int gw = C.bid * NWAVES + C.wave, NGW = C.G * NWAVES;
    const int gt = C.bid * NTHR + C.tid, NGT = C.G * NTHR;
    {
        LAS float* sc = (LAS float*)(C.lds + 70000);
        LAS float* red = (LAS float*)(C.lds + 90000);
        for (int i = C.tid; i < 4096; i += NTHR) { const float v = C.c()[i]; sc[i] = v / (1.f + __expf(-v)); }
        __syncthreads();
        float* mod = WSP(float, WS_MOD);
        for (int cb = C.bid; cb < 256; cb += C.G) {
            const int j0 = cb * 48;
            if (C.tid < 504) {
                const int cq = C.tid % 12, kg = C.tid / 12;
                f32x4 a0 = (f32x4){0.f, 0.f, 0.f, 0.f}, a1 = a0;
#pragma clang loop unroll(disable)
                for (int kb = 0; kb < 52; kb += 13) {
                    f32x4 wv[13];
#pragma unroll
                    for (int u = 0; u < 13; ++u) { const int kk = kg + 42 * (kb + u), kc = kk < 2048 ? kk : 2047; wv[u] = *(const f32x4*)(C.w_ada() + (size_t)kc * 12288 + j0 + 4 * cq); }
#pragma unroll
                    for (int u = 0; u < 13; ++u) { const int kk = kg + 42 * (kb + u); const bool ok = kk < 2048; const int kc = ok ? kk : 2047; const float c0 = ok ? sc[kc] : 0.f, c1 = ok ? sc[2048 + kc] : 0.f; a0 += wv[u] * c0; a1 += wv[u] * c1; }
                }
                LAS float* r = red + (kg * 12 + cq) * 8;
                r[0] = a0[0]; r[1] = a0[1]; r[2] = a0[2]; r[3] = a0[3]; r[4] = a1[0]; r[5] = a1[1]; r[6] = a1[2]; r[7] = a1[3];
            }
            __syncthreads();
            if (C.tid < 96) { const int b = C.tid / 48, j = C.tid % 48, cq = j >> 2, e = j & 3; float s = 0.f;
                for (int kg = 0; kg < 42; ++kg) s += red[(kg * 12 + cq) * 8 + b * 4 + e];
                mod[b * 12288 + j0 + j] = s + C.b_ada()[j0 + j]; }
            __syncthreads();
        }
    }
    {
        f32x2* rope = WSP(f32x2, WS_ROPE);
        for (int i = gt; i < SEQ * 8; i += NGT) { const int pos = i >> 3, fi = i & 7;
            const float invf = fi == 0 ? 1.0f : fi == 1 ? 0.1939227432012558f : fi == 2 ? 0.03760603070259094f : fi == 3 ? 0.007292664609849453f :
                               fi == 4 ? 0.0014142135623842478f : fi == 5 ? 0.00027424818836152554f : fi == 6 ? 5.3182957344688475e-05f : 1.0313385246263351e-05f;
            const float ang = (float)pos * invf; float s, c; sincos_d((double)ang, s, c); rope[i] = (f32x2){c, s}; }
    }
    {
        bf16_t* bl = WSP(bf16_t, WS_BTLORA);
        for (int i = gt; i < 3072 * 256; i += NGT) { const int n = i >> 8, k = i & 255; float v = 0.f;
            if (n < 1024) { if (k < 96) v = C.w_decay_up()[k * 1024 + n]; }
            else if (n < 2048) { if (k >= 128 && k < 224) v = C.w_aaa_up()[(k - 128) * 1024 + (n - 1024)]; }
            else v = C.w_gate_up()[k * 1024 + (n - 2048)];
            bl[i] = (bf16_t)f2bf(v); }
        bf16_t* wr = WSP(bf16_t, WS_WRT);
        for (int i = gt; i < 32 * 2048; i += NGT) { const int e = i >> 11, k = i & 2047; const float v = C.w_router()[k * 32 + e];
            const unsigned h = f2bf(v); wr[i] = (bf16_t)h; wr[65536 + i] = (bf16_t)f2bf(v - bf2f(h)); }
    }
    {
        LAS float* scr = (LAS float*)(C.lds + C.wave * 8448);
        constexpr int I_IN = 32 * 336, I_GU = 32 * 32 * 32  , I_BR = 16 * 64, I_OUT = 32 * 64;
        constexpr int NITEMS = I_IN + 3 * I_GU + 2 * I_BR + I_OUT;
        unsigned char* wtin = WSP(unsigned char, WS_WTIN); unsigned char* wtgu = WSP(unsigned char, WS_WTGU); unsigned char* wtdn = WSP(unsigned char, WS_WTDN);
        for (int it = gw; it < NITEMS; it += NGW) {
            int r = it;
            if (r < I_IN) { const int kb = r / 336, nb = r % 336;
                if (nb == 110 || nb == 111) zero_item_f8(wtin, 2048, (size_t)nb * 32, kb * 64, C.lane);
                else transpose_item_f8(C.w_in(), 10688, kb * 64, (nb < 110 ? nb : nb - 2) * 32, wtin, 2048, (size_t)nb * 32, kb * 64, scr, C.lane);
                continue; } r -= I_IN;
            if (r < 3 * I_GU) { const int which = r / I_GU; r %= I_GU; const int e = r >> 10, kb = (r >> 5) & 31, nb = r & 31, n0 = nb * 64;
                if (which < 2) transpose64_f8((which ? C.w_exp_up() : C.w_exp_gate()) + (size_t)e * 2048 * 2048, 2048, kb * 64, n0, wtgu, 2048, (size_t)e * 4096 + (n0 >> 7) * 256 + which * 128 + (n0 & 127), kb * 64, C.lane);
                else transpose64_f8(C.w_exp_down() + (size_t)e * 2048 * 2048, 2048, kb * 64, n0, wtdn, 2048, (size_t)e * 2048 + n0, kb * 64, C.lane);
                continue; } r -= 3 * I_GU;
            if (r < I_BR) { transpose_item_f8(C.w_branch_a(), 2048, (r >> 6) * 64, (r & 63) * 32, WSP(unsigned char, WS_WTBA), 1024, (size_t)(r & 63) * 32, (r >> 6) * 64, scr, C.lane); continue; } r -= I_BR;
            if (r < I_BR) { transpose_item_f8(C.w_branch_b(), 2048, (r >> 6) * 64, (r & 63) * 32, WSP(unsigned char, WS_WTBB), 1024, (size_t)(r & 63) * 32, (r >> 6) * 64, scr, C.lane); continue; } r -= I_BR;
            transpose_item_f8(C.w_out(), 2048, (r >> 6) * 64, (r & 63) * 32, WSP(unsigned char, WS_WTOUT), 2048, (size_t)(r & 63) * 32, (r >> 6) * 64, scr, C.lane);
        }
    }
}
DI void phase_norm1(Ctx& C) {
    const int gw = C.bid * NWAVES + C.wave, NGW = C.G * NWAVES;
    const float* mod = WSP(float, WS_MOD);
    if (C.bid == 0) {
        float* gs2 = WSP(float, WS_GS2);
        for (int i = C.tid; i < 4096; i += NTHR) { const int b = i >> 11, k = i & 2047; gs2[i] = C.norm2_gain()[k] * (1.f + mod[b * 12288 + 4 * 2048 + k]); }
    }
    unsigned char* H = WSP(unsigned char, WS_H);
    for (int rb = gw; rb < T / 16; rb += NGW) {
        const int b = (rb * 16) / SEQ;
        f32x4 gs[8], sh[8];
#pragma unroll
        for (int j = 0; j < 8; ++j) { const int k = 4 * C.lane + 256 * j;
            const f32x4 g = *(const f32x4*)(C.norm1_gain() + k), s = *(const f32x4*)(mod + b * 12288 + 2048 + k);
            gs[j] = g * (s + 1.f); sh[j] = *(const f32x4*)(mod + b * 12288 + k); }
        f32x4 nv[8];
        { const f32x4* xr0 = (const f32x4*)(C.x() + (size_t)rb * 16 * D) + C.lane;
#pragma unroll
          for (int j = 0; j < 8; ++j) nv[j] = xr0[64 * j]; }
        for (int i = 0; i < 16; ++i) {
            const size_t row = (size_t)rb * 16 + i;
            f32x4 v[8]; float s = 0.f;
#pragma unroll
            for (int j = 0; j < 8; ++j) v[j] = nv[j];
            if (i + 1 < 16) { const f32x4* xn = (const f32x4*)(C.x() + (row + 1) * D) + C.lane;
#pragma unroll
                for (int j = 0; j < 8; ++j) nv[j] = xn[64 * j]; }
#pragma unroll
            for (int j = 0; j < 8; ++j) s += (v[j][0] * v[j][0] + v[j][1] * v[j][1]) + (v[j][2] * v[j][2] + v[j][3] * v[j][3]);
            const float rstd = 1.f / sqrtf(wave_sum(s) * (1.f / D) + 1e-6f);
            unsigned* o4 = (unsigned*)(H + row * D) + C.lane; const float sc_ = (float)(1 << F8_SH);
#pragma unroll
            for (int j = 0; j < 8; ++j) { const f32x4 y = (v[j] * rstd * gs[j] + sh[j]) * sc_; o4[64 * j] = pk4_fp8(y[0], y[1], y[2], y[3]); }
        }
    }
}


DI bf16x8 pack_step(const f32x16& x, int s) {
    u32x4 p; p.x = cvtpk(x[8 * s], x[8 * s + 1]); p.y = cvtpk(x[8 * s + 2], x[8 * s + 3]); p.z = cvtpk(x[8 * s + 4], x[8 * s + 5]); p.w = cvtpk(x[8 * s + 6], x[8 * s + 7]);
    return __builtin_bit_cast(bf16x8, p);
}

DI void phase_prep(Ctx& C) {
    const int gw = C.bid * NWAVES + C.wave, NGW = C.G * NWAVES;
    bf16_t* proj = WSP(bf16_t, WS_PROJ); bf16_t* lin = WSP(bf16_t, WS_OB);
    const f32x2* rope = WSP(f32x2, WS_ROPE);
    {   unsigned char* vt = WSP(unsigned char, WS_VT); const float sv = (float)(1 << F8_SV);
        for (int task = gw; task < 16 * 256; task += NGW) {
            const int bh = task >> 8, kt = task & 255; const size_t row0 = (size_t)(bh >> 3) * SEQ + (size_t)kt * 64;
            const bf16_t* vp = proj + row0 * NPROJ + C_VD + (bh & 7) * 128 + 2 * C.lane;
            unsigned kv[64];
#pragma unroll
            for (int k = 0; k < 64; ++k) kv[k] = *(const unsigned*)(vp + (size_t)k * NPROJ);
            u32x4 o0[4], o1[4];
#pragma unroll
            for (int i = 0; i < 16; ++i) { const int k0 = 8 * (i & 3) + 4 * (i >> 3) + 32 * ((i >> 2) & 1);
                const unsigned a = pk4_fp8(bflo(kv[k0]) * sv, bflo(kv[k0 + 1]) * sv, bflo(kv[k0 + 2]) * sv, bflo(kv[k0 + 3]) * sv), b = pk4_fp8(bfhi(kv[k0]) * sv, bfhi(kv[k0 + 1]) * sv, bfhi(kv[k0 + 2]) * sv, bfhi(kv[k0 + 3]) * sv);
                o0[i >> 2][i & 3] = a; o1[i >> 2][i & 3] = b; }
            unsigned char* dst = vt + ((size_t)task * 128 + 2 * C.lane) * 64;
#pragma unroll
            for (int q = 0; q < 4; ++q) { *(u32x4*)(dst + 16 * q) = o0[q]; *(u32x4*)(dst + 64 + 16 * q) = o1[q]; }
        }
    }
    for (int t = gw; t < T; t += NGW) {
        const int pos = t % SEQ;
        const bf16_t* pr = proj + (size_t)t * NPROJ; const bf16_t* pp = pr - NPROJ;
        {
            const int l = C.lane; u32x4 o = {0u, 0u, 0u, 0u}; int j0;
            if (l < 56) {
                const int col = C_WD + 8 * l; const int kind = l < 12 ? 1 : (l < 24 ? 2 : 3);
                j0 = l < 12 ? 8 * l : (l < 24 ? 128 + 8 * (l - 12) : 256 + 8 * (l - 24));
                const u32x4 cw = *(const u32x4*)(pr + col); u32x4 pw = {0u, 0u, 0u, 0u}; if (pos > 0) pw = *(const u32x4*)(pp + col);
                const f32x4 m0 = *(const f32x4*)(C.shift_mu() + col), m1 = *(const f32x4*)(C.shift_mu() + col + 4);
                const float cv[8] = {bflo(cw.x), bfhi(cw.x), bflo(cw.y), bfhi(cw.y), bflo(cw.z), bfhi(cw.z), bflo(cw.w), bfhi(cw.w)};
                const float pv[8] = {bflo(pw.x), bfhi(pw.x), bflo(pw.y), bfhi(pw.y), bflo(pw.z), bfhi(pw.z), bflo(pw.w), bfhi(pw.w)};
                const float mu[8] = {m0[0], m0[1], m0[2], m0[3], m1[0], m1[1], m1[2], m1[3]};
                float r[8];
#pragma unroll
                for (int e = 0; e < 8; ++e) { const float sft = cv[e] + (pv[e] - cv[e]) * mu[e];
                    r[e] = kind == 1 ? (1.f - 2.f * __builtin_amdgcn_rcpf(__expf(2.f * sft) + 1.f)) : (kind == 2 ? sft : sigmoidf_(sft)); }
                o = (u32x4){cvtpk(r[0], r[1]), cvtpk(r[2], r[3]), cvtpk(r[4], r[5]), cvtpk(r[6], r[7])};
            } else { j0 = l < 60 ? 96 + 8 * (l - 56) : 224 + 8 * (l - 60); }
            *(u32x4*)(lin + (j0 < 256 ? (size_t)t * 256 + j0 : (size_t)T * 256 + (size_t)t * 256 + (j0 - 256))) = o;
        }
        {
            const int g = C.lane >> 1, half = C.lane & 1;
            bf16_t* gp = proj + (size_t)t * NPROJ + C_QD + g * 64 + half * 32;
            u32x4 w[4]; float v[32];
#pragma unroll
            for (int i = 0; i < 4; ++i) w[i] = *(const u32x4*)(gp + 8 * i);
            float ss = 0.f;
#pragma unroll
            for (int i = 0; i < 4; ++i) { v[8 * i + 0] = bflo(w[i].x); v[8 * i + 1] = bfhi(w[i].x); v[8 * i + 2] = bflo(w[i].y); v[8 * i + 3] = bfhi(w[i].y);
                v[8 * i + 4] = bflo(w[i].z); v[8 * i + 5] = bfhi(w[i].z); v[8 * i + 6] = bflo(w[i].w); v[8 * i + 7] = bfhi(w[i].w); }
#pragma unroll
            for (int d = 0; d < 32; ++d) ss += v[d] * v[d];
            ss += DPPF(ss, 0xB1);
            const float rstd = 1.f / sqrtf(ss * (1.f / 64.f) + 1e-6f);
            const float* gain = (g < 16 ? C.q_gain() : C.k_gain()) + half * 32;
#pragma unroll
            for (int d = 0; d < 32; ++d) v[d] = v[d] * rstd * gain[d];
            if (half == 0) {
#pragma unroll
                for (int i = 0; i < 8; ++i) { const f32x2 cs = rope[pos * 8 + i]; const float x1 = v[i], x2 = v[i + 8]; v[i] = x1 * cs[0] - x2 * cs[1]; v[i + 8] = x2 * cs[0] + x1 * cs[1]; }
            }
            const float sc = g < 16 ? ATT_C2 * (float)(1 << F8_SQ) : (float)(1 << F8_SK);
            unsigned char* q8 = WSP(unsigned char, WS_QK8) + (size_t)t * 2048 + g * 64 + half * 32;
#pragma unroll
            for (int i = 0; i < 2; ++i) { u32x4 o;
                o.x = pk4_fp8(v[16 * i] * sc, v[16 * i + 1] * sc, v[16 * i + 2] * sc, v[16 * i + 3] * sc); o.y = pk4_fp8(v[16 * i + 4] * sc, v[16 * i + 5] * sc, v[16 * i + 6] * sc, v[16 * i + 7] * sc);
                o.z = pk4_fp8(v[16 * i + 8] * sc, v[16 * i + 9] * sc, v[16 * i + 10] * sc, v[16 * i + 11] * sc); o.w = pk4_fp8(v[16 * i + 12] * sc, v[16 * i + 13] * sc, v[16 * i + 14] * sc, v[16 * i + 15] * sc);
                *(u32x4*)(q8 + 16 * i) = o; }
        }
    }
}

constexpr int RS = 72, MATB = 64 * RS * 2;
constexpr int L_TCA = 0, L_TCR = MATB, L_TCB = 2 * MATB, L_TCK = 3 * MATB, L_CTA = 4 * MATB, L_CTV = 5 * MATB, L_CTBH = 6 * MATB, L_CTKH = 7 * MATB,
              L_AK = 8 * MATB, L_RB = 9 * MATB, L_RK = 10 * MATB, L_T = 11 * MATB, L_F = 12 * MATB, L_GT = L_F + 64 * 68 * 4, L_GL = L_GT + 2048;
constexpr int L_XCT = L_TCA, L_U0CT = L_TCB, L_WCT = L_TCK;
constexpr int L_RAW = L_AK;
constexpr int RAW_RKV = 65 * 128, RAW_LW = 3 * RAW_RKV, RAW_A = RAW_LW + 64 * 128;
static_assert(L_RAW + RAW_A + 64 * 128 <= L_GT, "R1 raw buffer");
static_assert(L_GL + 256 <= RING_BYTES, "R1 LDS map");
DI f32x16 mm_tile(const LAS bf16_t* A, const LAS bf16_t* B, int arow0, int brow0, int r32, int hi, f32x16 acc) {
#pragma unroll
    for (int s = 0; s < 4; ++s) {
        const bf16x8 a = *(const LAS bf16x8*)(A + (arow0 + r32) * RS + 16 * s + 8 * hi);
        const bf16x8 b = *(const LAS bf16x8*)(B + (brow0 + r32) * RS + 16 * s + 8 * hi);
        acc = MFMA32(a, b, acc);
    }
    return acc;
}
DI void store_tile_T(LAS bf16_t* M, const f32x16& c, int row0, int col, int hi) {
#pragma unroll
    for (int g = 0; g < 4; ++g) { const int r = row0 + 8 * g + 4 * hi;
        *(LAS u32x2*)(M + col * RS + r) = (u32x2){cvtpk(c[4 * g], c[4 * g + 1]), cvtpk(c[4 * g + 2], c[4 * g + 3])}; }
}
DI void phase_r1(Ctx& C) {
    const bf16_t* proj = WSP(bf16_t, WS_PROJ);
    const bf16_t* LW = WSP(bf16_t, WS_MERGED); const bf16_t* AA = LW + (size_t)T * 1024;
    float* bonus = WSP(float, WS_BONUS);
    u32x4* mfrag = WSP(u32x4, WS_MFRAG); u32x4* nfrag = WSP(u32x4, WS_NFRAG);
    bf16_t* pbuf = WSP(bf16_t, WS_PBUF); bf16_t* y0buf = WSP(bf16_t, WS_Y0);
    LAS unsigned char* L = C.lds;
    const int lane = C.lane, w = C.wave, r32 = lane & 31, hi = lane >> 5;
    u32x4 raw[6];
#define R1_LOAD(item_) do { const int cg_ = (item_) >> 4, h_ = (item_) & 15; const size_t tk_ = (size_t)cg_ * 64 + (C.tid >> 3); const int cc_ = (C.tid & 7) * 8; \
        const bf16_t* pr_ = proj + tk_ * NPROJ + h_ * 64 + cc_; \
        raw[0] = *(const u32x4*)(pr_ + C_R); raw[1] = *(const u32x4*)(pr_ + C_K); raw[2] = *(const u32x4*)(pr_ + C_V); \
        raw[3] = *(const u32x4*)(LW + tk_ * 1024 + h_ * 64 + cc_); raw[4] = *(const u32x4*)(AA + tk_ * 1024 + h_ * 64 + cc_); \
        raw[5] = (u32x4){0u, 0u, 0u, 0u}; \
        if (C.tid < 24 && (cg_ & 255) != 0) raw[5] = *(const u32x4*)(proj + ((size_t)cg_ * 64 - 1) * NPROJ + (C.tid >> 3) * 1024 + h_ * 64 + cc_); } while (0)
    if (C.bid < 8192) R1_LOAD(C.bid);
    for (int item = C.bid; item < 8192; item += C.G) {
        const int cg = item >> 4, h = item & 15, b = cg >> 8, cidx = cg & 255;
        const int ch = (b * 16 + h) * 256 + cidx; const size_t tok0 = (size_t)cg * 64;
        {
            const int t_ = C.tid >> 3, cb_ = (C.tid & 7) * 16;
            *(LAS u32x4*)(L + L_RAW + 0 * RAW_RKV + (t_ + 1) * 128 + cb_) = raw[0]; *(LAS u32x4*)(L + L_RAW + 1 * RAW_RKV + (t_ + 1) * 128 + cb_) = raw[1];
            *(LAS u32x4*)(L + L_RAW + 2 * RAW_RKV + (t_ + 1) * 128 + cb_) = raw[2];
            *(LAS u32x4*)(L + L_RAW + RAW_LW + t_ * 128 + cb_) = raw[3]; *(LAS u32x4*)(L + L_RAW + RAW_A + t_ * 128 + cb_) = raw[4];
            if (C.tid < 24) *(LAS u32x4*)(L + L_RAW + (C.tid >> 3) * RAW_RKV + cb_) = raw[5];
            LDS_BARRIER();
            if (item + C.G < 8192) R1_LOAD(item + C.G);
        }
        {
            const int c = lane, hc = h * 64 + c;
            const float mur = C.shift_mu()[C_R + hc], muk = C.shift_mu()[C_K + hc], muv = C.shift_mu()[C_V + hc];
            const float kkc = C.k_k()[hc], kac = C.k_a()[hc], rkc = C.r_k()[hc];
            const size_t t0 = tok0 + 8 * w;
            const LAS bf16_t* RW = (const LAS bf16_t*)(L + L_RAW);
            float rp = bf2f(RW[(0 * RAW_RKV) / 2 + (8 * w) * 64 + c]), kp = bf2f(RW[(1 * RAW_RKV) / 2 + (8 * w) * 64 + c]), vp = bf2f(RW[(2 * RAW_RKV) / 2 + (8 * w) * 64 + c]);
            float rs[8], km[8], vs[8], kk[8], av[8], cum[8], lwv[8];
            float run = 0.f;
#pragma unroll
            for (int i = 0; i < 8; ++i) {
                const int tr_ = (8 * w + i + 1) * 64 + c;
                const float r = bf2f(RW[(0 * RAW_RKV) / 2 + tr_]), k = bf2f(RW[(1 * RAW_RKV) / 2 + tr_]), v = bf2f(RW[(2 * RAW_RKV) / 2 + tr_]);
                rs[i] = r + (rp - r) * mur; const float ks = k + (kp - k) * muk; vs[i] = v + (vp - v) * muv; rp = r; kp = k; vp = v;
                lwv[i] = bf2f(RW[RAW_LW / 2 + (8 * w + i) * 64 + c]); av[i] = bf2f(RW[RAW_A / 2 + (8 * w + i) * 64 + c]);
                float q = ks * kkc; const float ss = wave_sum(q * q); q = q * __builtin_amdgcn_rsqf(fmaxf(ss, 1e-24f)); kk[i] = q;
                km[i] = ks * (1.f + (av[i] - 1.f) * kac);
                const float bs = wave_sum(rs[i] * km[i] * rkc);
                if (lane == 0) bonus[(t0 + i) * 16 + h] = bs;
                run += lwv[i]; cum[i] = run;
            }
            LAS float* GT = (LAS float*)(L + L_GT); LAS float* GL = (LAS float*)(L + L_GL);
            GT[w * 64 + c] = run;
            LDS_BARRIER();
            float off = 0.f, tot = 0.f;
#pragma unroll
            for (int g = 0; g < 8; ++g) { const float x = GT[g * 64 + c]; tot += x; off += (g < w) ? x : 0.f; }
            if (w == 0) GL[c] = __expf(tot);
            u32x4 cta, ctv, ctbh, ctkh; unsigned* pa = (unsigned*)&cta; unsigned* pv = (unsigned*)&ctv; unsigned* pb = (unsigned*)&ctbh; unsigned* pk = (unsigned*)&ctkh;
            float at[8], bh[8], kh[8];
            LAS bf16_t* TCA = (LAS bf16_t*)(L + L_TCA); LAS bf16_t* TCR = (LAS bf16_t*)(L + L_TCR); LAS bf16_t* TCB = (LAS bf16_t*)(L + L_TCB); LAS bf16_t* TCK = (LAS bf16_t*)(L + L_TCK);
#pragma unroll
            for (int i = 0; i < 8; ++i) {
                const float cm = off + cum[i];
                const float epos = __expf(cm), eneg = __expf(-cm), eprev = __expf(cm - lwv[i]), ratio = __expf(tot - cm);
                const float ka = kk[i] * av[i];
                at[i] = -kk[i] * eprev; bh[i] = ka * ratio; kh[i] = km[i] * ratio;
                const int t = 8 * w + i;
                TCA[t * RS + c] = (bf16_t)f2bf(at[i]); TCR[t * RS + c] = (bf16_t)f2bf(rs[i] * epos); TCB[t * RS + c] = (bf16_t)f2bf(ka * eneg); TCK[t * RS + c] = (bf16_t)f2bf(km[i] * eneg);
            }
#pragma unroll
            for (int i = 0; i < 4; ++i) { pa[i] = pk2(at[2 * i], at[2 * i + 1]); pv[i] = pk2(vs[2 * i], vs[2 * i + 1]); pb[i] = pk2(bh[2 * i], bh[2 * i + 1]); pk[i] = pk2(kh[2 * i], kh[2 * i + 1]); }
            *(LAS u32x4*)(L + L_CTA + (c * RS + 8 * w) * 2) = cta; *(LAS u32x4*)(L + L_CTV + (c * RS + 8 * w) * 2) = ctv;
            *(LAS u32x4*)(L + L_CTBH + (c * RS + 8 * w) * 2) = ctbh; *(LAS u32x4*)(L + L_CTKH + (c * RS + 8 * w) * 2) = ctkh;
        }
        LDS_BARRIER();
        {
            const int p = w >> 1, it = w & 1;
            const LAS bf16_t* Y = (const LAS bf16_t*)(L + ((p & 1) ? L_TCK : L_TCB));
            const LAS bf16_t* X = (const LAS bf16_t*)(L + ((p & 2) ? L_TCR : L_TCA));
            const int t = 32 * it + r32;
#pragma unroll
            for (int jt = 0; jt < 2; ++jt) {
                f32x16 c = {};
                c = mm_tile(Y, X, 32 * jt, 32 * it, r32, hi, c);
#pragma unroll
                for (int r = 0; r < 16; ++r) { const int j = 32 * jt + crow(r, hi); const bool keep = (p < 2) ? (j < t) : (j <= t); c[r] = keep ? c[r] : 0.f; }
                if (p == 0) {
                    LAS float* F = (LAS float*)(L + L_F);
#pragma unroll
                    for (int g = 0; g < 4; ++g) *(LAS f32x4*)(F + t * 68 + 32 * jt + 8 * g + 4 * hi) = (f32x4){c[4 * g], c[4 * g + 1], c[4 * g + 2], c[4 * g + 3]};
                } else {
                    LAS bf16_t* Mo = (LAS bf16_t*)(L + (p == 1 ? L_AK : (p == 2 ? L_RB : L_RK)));
                    store_tile_T(Mo, c, 32 * jt, t, hi);
                }
            }
        }
        LDS_BARRIER();
        {
            const int blk = C.tid >> 8, j = (C.tid >> 3) & 31, p = C.tid & 7, o = 32 * blk;
            const LAS float* F = (const LAS float*)(L + L_F);
            float Tr[4];
#pragma unroll
            for (int q = 0; q < 4; ++q) Tr[q] = 0.f;
#pragma unroll
            for (int tq = 0; tq < 4; ++tq) {
#pragma unroll
                for (int tp = 0; tp < 8; ++tp) {
                    const int t = 8 * tq + tp; float part = 0.f;
#pragma unroll
                    for (int q = 0; q <= tq; ++q) part += F[(o + t) * 68 + o + 8 * q + p] * Tr[q];
                    part = sum8_dpp(part);
                    const float val = part + ((t == j) ? 1.f : 0.f);
                    if (p == tp) Tr[tq] = val;
                }
            }
            LAS bf16_t* Tm = (LAS bf16_t*)(L + L_T); LAS bf16_t* TT = (LAS bf16_t*)(L + L_TCA); LAS bf16_t* Abf = (LAS bf16_t*)(L + L_TCB);
#pragma unroll
            for (int q = 0; q < 4; ++q) { const bf16_t tv = (bf16_t)f2bf(Tr[q]);
                Tm[(o + 8 * q + p) * RS + o + j] = tv; TT[(o + j) * RS + o + 8 * q + p] = tv;
                if (blk == 0) Tm[(8 * q + p) * RS + 32 + j] = 0; }
            { const int t = 32 + (C.tid >> 4), k = 2 * (C.tid & 15);
              *(LAS unsigned*)(Abf + t * RS + k) = cvtpk(F[t * 68 + k], F[t * 68 + k + 1]); }
        }
        LDS_BARRIER();
        if (w == 0) {
            LAS bf16_t* Tm = (LAS bf16_t*)(L + L_T); const LAS bf16_t* TT = (const LAS bf16_t*)(L + L_TCA); const LAS bf16_t* Abf = (const LAS bf16_t*)(L + L_TCB); LAS bf16_t* XT = (LAS bf16_t*)(L + L_TCK);
            f32x16 c = {};
#pragma unroll
            for (int s = 0; s < 2; ++s) c = MFMA32(*(const LAS bf16x8*)(Abf + (32 + r32) * RS + 16 * s + 8 * hi), *(const LAS bf16x8*)(TT + r32 * RS + 16 * s + 8 * hi), c);
            store_tile_T(XT, c, 32, r32, hi);
            asm volatile("s_waitcnt lgkmcnt(0)" ::: "memory");
            f32x16 d = {};
#pragma unroll
            for (int s = 2; s < 4; ++s) d = MFMA32(*(const LAS bf16x8*)(Tm + (32 + r32) * RS + 16 * s + 8 * hi), *(const LAS bf16x8*)(XT + r32 * RS + 16 * s + 8 * hi), d);
#pragma unroll
            for (int r = 0; r < 16; ++r) Tm[(32 + crow(r, hi)) * RS + r32] = (bf16_t)f2bf(d[r]);
        }
        LDS_BARRIER();
        {
            const int prod = w >> 2, tt = (w >> 1) & 1, ct = w & 1;
            const LAS bf16_t* A = (const LAS bf16_t*)(L + (prod ? L_AK : L_T));
            const LAS bf16_t* B = (const LAS bf16_t*)(L + (prod ? L_CTV : L_CTA));
            f32x16 c = {}; c = mm_tile(A, B, 32 * tt, 32 * ct, r32, hi, c);
            store_tile_T((LAS bf16_t*)(L + (prod ? L_XCT : L_WCT)), c, 32 * tt, 32 * ct + r32, hi);
        }
        LDS_BARRIER();
        if (w < 4) {
            const int tt = w >> 1, vt = w & 1;
            f32x16 c = {}; c = mm_tile((const LAS bf16_t*)(L + L_T), (const LAS bf16_t*)(L + L_XCT), 32 * tt, 32 * vt, r32, hi, c);
            store_tile_T((LAS bf16_t*)(L + L_U0CT), c, 32 * tt, 32 * vt + r32, hi);
        } else {
            const int kt = (w >> 1) & 1, it = w & 1;
            f32x16 c = {}; c = mm_tile((const LAS bf16_t*)(L + L_WCT), (const LAS bf16_t*)(L + L_CTBH), 32 * kt, 32 * it, r32, hi, c);
            const float gl = ((const LAS float*)(L + L_GL))[32 * it + r32];
#pragma unroll
            for (int r = 0; r < 16; ++r) if (32 * kt + crow(r, hi) == 32 * it + r32) c[r] += gl;
            u32x4* dst = mfrag + ((size_t)(ch * 4 + kt * 2 + it) * 2) * 64 + lane;
            dst[0] = __builtin_bit_cast(u32x4, pack_step(c, 0)); dst[64] = __builtin_bit_cast(u32x4, pack_step(c, 1));
        }
        LDS_BARRIER();
        if (w < 4) {
            {   const int it = w >> 1, vt = w & 1;
                f32x16 c = {};
                c = mm_tile((const LAS bf16_t*)(L + L_CTBH), (const LAS bf16_t*)(L + L_U0CT), 32 * it, 32 * vt, r32, hi, c);
                c = mm_tile((const LAS bf16_t*)(L + L_CTKH), (const LAS bf16_t*)(L + L_CTV), 32 * it, 32 * vt, r32, hi, c);
                u32x4* dst = nfrag + ((size_t)(ch * 4 + it * 2 + vt) * 2) * 64 + lane;
                dst[0] = __builtin_bit_cast(u32x4, pack_step(c, 0)); dst[64] = __builtin_bit_cast(u32x4, pack_step(c, 1)); }
            {   const int kt = w >> 1, tt = w & 1, t = 32 * tt + r32;
                f32x16 c = {};
                c = mm_tile((const LAS bf16_t*)(L + L_WCT), (const LAS bf16_t*)(L + L_RB), 32 * kt, 32 * tt, r32, hi, c);
                const LAS bf16_t* TCR = (const LAS bf16_t*)(L + L_TCR);
#pragma unroll
                for (int g = 0; g < 4; ++g) { const int k0 = 32 * kt + 8 * g + 4 * hi; const u32x2 rr = *(const LAS u32x2*)(TCR + t * RS + k0);
                    const u32x2 o = {cvtpk(c[4 * g] + bflo(rr.x), c[4 * g + 1] + bfhi(rr.x)), cvtpk(c[4 * g + 2] + bflo(rr.y), c[4 * g + 3] + bfhi(rr.y))};
                    *(u32x2*)(pbuf + (size_t)ch * 4096 + ((tt * 4 + 2 * kt + (g >> 1)) * 64 + r32 + 32 * (g & 1)) * 8 + 4 * hi) = o; } }
        } else {
            const int vt = (w >> 1) & 1, tt = w & 1, t = 32 * tt + r32;
            f32x16 c = {};
            c = mm_tile((const LAS bf16_t*)(L + L_U0CT), (const LAS bf16_t*)(L + L_RB), 32 * vt, 32 * tt, r32, hi, c);
            c = mm_tile((const LAS bf16_t*)(L + L_CTV), (const LAS bf16_t*)(L + L_RK), 32 * vt, 32 * tt, r32, hi, c);
            const LAS bf16_t* CTV = (const LAS bf16_t*)(L + L_CTV); bf16_t* vsc = WSP(bf16_t, WS_VSC);
#pragma unroll
            for (int g = 0; g < 4; ++g) { const int v0 = 32 * vt + 8 * g + 4 * hi; const size_t di = (size_t)ch * 4096 + ((((tt * 2 + vt) * 4 + g) * 64) + lane) * 4;
                *(u32x2*)(y0buf + di) = (u32x2){cvtpk(c[4 * g], c[4 * g + 1]), cvtpk(c[4 * g + 2], c[4 * g + 3])};
                *(u32x2*)(vsc + di) = (u32x2){(unsigned)CTV[(v0 + 0) * RS + t] | ((unsigned)CTV[(v0 + 1) * RS + t] << 16), (unsigned)CTV[(v0 + 2) * RS + t] | ((unsigned)CTV[(v0 + 3) * RS + t] << 16)}; }
        }
        LDS_BARRIER();
    }
}

DI void r2_wave(Ctx& C, int wi) {
    const int bh = wi >> 1, vt = wi & 1, lane = C.lane, r32 = lane & 31, hi = lane >> 5;
    const u32x4* mfrag = WSP(u32x4, WS_MFRAG); const u32x4* nfrag = WSP(u32x4, WS_NFRAG);
    bf16_t* sbuf = WSP(bf16_t, WS_SBUF);
    f32x16 X[2]; X[0] = f32x16{}; X[1] = f32x16{};
    u32x4 mA[8], nA[4], mB[8], nB[4], mC[8], nC[4];
#define R2_LOAD(M_, N_, cidx) do { const size_t ch_ = (size_t)bh * 256 + (cidx); \
        _Pragma("unroll") for (int q_ = 0; q_ < 8; ++q_) M_[q_] = mfrag[((ch_ * 4 + (q_ >> 1)) * 2 + (q_ & 1)) * 64 + lane];            \
        _Pragma("unroll") for (int q_ = 0; q_ < 4; ++q_) N_[q_] = nfrag[((ch_ * 4 + (q_ >> 1) * 2 + vt) * 2 + (q_ & 1)) * 64 + lane]; } while (0)
#define R2_STEP(M_, N_, cidx) do { const size_t ch_ = (size_t)bh * 256 + (cidx); \
          \
        _Pragma("unroll") for (int kt = 0; kt < 2; ++kt) _Pragma("unroll") for (int g = 0; g < 4; ++g) \
            *(u32x2*)(sbuf + ch_ * 4096 + ((vt * 4 + 2 * kt + (g >> 1)) * 64 + r32 + 32 * (g & 1)) * 8 + 4 * hi) = (u32x2){cvtpk(X[kt][4 * g], X[kt][4 * g + 1]), cvtpk(X[kt][4 * g + 2], X[kt][4 * g + 3])}; \
        f32x16 acc[2]; \
        _Pragma("unroll") for (int it = 0; it < 2; ++it) _Pragma("unroll") for (int s = 0; s < 2; ++s) { const u32x4 q = N_[it * 2 + s]; \
            acc[it][8 * s + 0] = bflo(q.x); acc[it][8 * s + 1] = bfhi(q.x); acc[it][8 * s + 2] = bflo(q.y); acc[it][8 * s + 3] = bfhi(q.y); \
            acc[it][8 * s + 4] = bflo(q.z); acc[it][8 * s + 5] = bfhi(q.z); acc[it][8 * s + 6] = bflo(q.w); acc[it][8 * s + 7] = bfhi(q.w); } \
        _Pragma("unroll") for (int kt = 0; kt < 2; ++kt) _Pragma("unroll") for (int s = 0; s < 2; ++s) { const bf16x8 xb = pack_step(X[kt], s); \
            _Pragma("unroll") for (int it = 0; it < 2; ++it) acc[it] = MFMA32(__builtin_bit_cast(bf16x8, M_[(kt * 2 + it) * 2 + s]), xb, acc[it]); } \
        X[0] = acc[0]; X[1] = acc[1]; \
        if ((cidx) + 3 < 256) R2_LOAD(M_, N_, (cidx) + 3); } while (0)
    R2_LOAD(mA, nA, 0); R2_LOAD(mB, nB, 1); R2_LOAD(mC, nC, 2);
    for (int cidx = 0; cidx < 255; cidx += 3) { R2_STEP(mA, nA, cidx); R2_STEP(mB, nB, cidx + 1); R2_STEP(mC, nC, cidx + 2); }
    R2_STEP(mA, nA, 255);
#undef R2_LOAD
#undef R2_STEP
}

constexpr int A_STG = 16384, A_NSTG = 8;
constexpr int A_WS = RING_BYTES + 4096;
constexpr int A_O2 = 0;
constexpr int A_IDX = A_WS + 8 * 256;
constexpr int A_ONES = A_IDX + 64;
static_assert(A_NSTG * A_STG <= RING_BYTES && A_ONES + 32 <= LDS_BYTES && A_WS >= RING_BYTES + 1024, "attention LDS map");
typedef short v4i16_t __attribute__((ext_vector_type(4)));
DI s16x4 vtr(const LAS unsigned char* p) { return __builtin_bit_cast(s16x4, __builtin_amdgcn_ds_read_tr16_b64_v4i16((LAS v4i16_t*)p)); }
DI void attn_unit(Ctx& C, int b, int h, int u, float lam) {
    int lane_ = C.lane; asm volatile("" : "+v"(lane_));
    const int lane = lane_, w = C.wave, tid = w * 64 + lane, r32 = lane & 31, hi = lane >> 5, rg = w & 3, mp = w >> 2; (void)tid;
    LAS unsigned char* L = C.lds;
    const bf16_t* proj = WSP(bf16_t, WS_PROJ);
    const size_t rowbase = (size_t)b * SEQ;
    const int q0 = u * 128 + rg * 32;
    const int my_chunk = q0 >> 6, NT = 2 * u + 2;
    const unsigned char* qk8 = WSP(unsigned char, WS_QK8);
    pg8::v8i_t qf;
    {   const unsigned char* qp = qk8 + (rowbase + q0 + r32) * 2048 + h * 128 + mp * 64 + 32 * hi;
        qf = __builtin_shufflevector(*(const pg8::v4i_t*)(qp), *(const pg8::v4i_t*)(qp + 16), 0, 1, 2, 3, 4, 5, 6, 7); }
    const unsigned lds0 = (unsigned)(size_t)L;
    const unsigned char* ktb = qk8 + rowbase * 2048 + 1024 + h * 128;
    const unsigned koff = (unsigned)((8 * w + (lane >> 3)) * 2048 + (((lane & 7) ^ (((8 * w + (lane >> 3)) >> 1) & 7)) << 4));
    const unsigned char* vtb = WSP(unsigned char, WS_VT) + (size_t)((b * 8 + h) * 256) * 8192;
    const unsigned voff = (unsigned)((16 * w + (lane >> 2)) * 64 + (((lane & 3) ^ (((16 * w + (lane >> 2)) >> 2) & 3)) << 4));
#define A_GLDS(gsrc, ldsdst) do { unsigned keep_; asm volatile("s_mov_b32 %0, m0\n\ts_mov_b32 m0, %2\n\ts_nop 0\n\tglobal_load_lds_dwordx4 %1, off\n\ts_mov_b32 m0, %0" : "=&s"(keep_) : "v"(gsrc), "s"(ldsdst) : "memory"); } while (0)
#define A_DMA(kt, st) do { const unsigned lb_ = (unsigned)__builtin_amdgcn_readfirstlane((int)(lds0 + (st) * A_STG + w * 1024)); \
        A_GLDS(ktb + (size_t)(kt) * 64 * 2048 + koff, lb_); A_GLDS(vtb + (size_t)(kt) * 8192 + voff, lb_ + 8192); } while (0)
#define A_WAITBAR() asm volatile("s_waitcnt vmcnt(0) lgkmcnt(0)\n\ts_barrier" ::: "memory")
#define A_WAITBAR_N(n) asm volatile("s_waitcnt vmcnt(" #n ") lgkmcnt(0)\n\ts_barrier" ::: "memory")
    const int ksw = (r32 >> 1) & 7, kofa = r32 * 128 + (((mp * 4 + 2 * hi) ^ ksw) << 4);
    const int vsw = (r32 >> 2) & 3, vofa = 8192 + r32 * 64 + (((2 * hi) ^ vsw) << 4);
    f32x16 o[4]; o[0] = f32x16{}; o[1] = f32x16{}; o[2] = f32x16{}; o[3] = f32x16{};
    f32x16 negm = f32x16{};
    f32x16 osum = f32x16{};
    LAS float* wsf = (LAS float*)(L + A_WS) + w * 64;
    A_DMA(0, 0); A_DMA(1, 1); if (NT > 2) A_DMA(2, 2); if (NT > 3) A_DMA(3, 3); if (NT > 4) A_DMA(4, 4);
    A_WAITBAR();
    f32x16 pA0, pA1, pB0, pB1; float rmc;
#define A_ROWMAX2(dst, P0, P1) do { float rm_ = P0[0]; _Pragma("unroll") for (int r = 0; r < 16; ++r) { rm_ = fmaxf(rm_, P0[r]); rm_ = fmaxf(rm_, P1[r]); } \
        auto rr_ = __builtin_amdgcn_permlane32_swap(__float_as_uint(rm_), __float_as_uint(rm_), false, false); dst = fmaxf(__uint_as_float(rr_[0]), __uint_as_float(rr_[1])); } while (0)
#define A_QK8(DST, st, kb) do { const LAS unsigned char* kp_ = L + (st) * A_STG + (kb) * 4096; \
        const pg8::v8i_t kf_ = __builtin_shufflevector(__builtin_bit_cast(pg8::v4i_t, *(const LAS bf16x8*)(kp_ + kofa)), __builtin_bit_cast(pg8::v4i_t, *(const LAS bf16x8*)(kp_ + (kofa ^ 16))), 0, 1, 2, 3, 4, 5, 6, 7); \
        asm volatile("v_mfma_scale_f32_32x32x64_f8f6f4 %0, %1, %2, %5, %3, %4 op_sel_hi:[0,0,0]" : "=&v"(DST) : "v"(kf_), "v"(qf), "v"((127 - F8_SK) * 0x01010101), "v"((127 - F8_SQ) * 0x01010101), "v"(negm)); } while (0)
#define A_KF(st, kb) __builtin_shufflevector(__builtin_bit_cast(pg8::v4i_t, *(const LAS bf16x8*)(L + (st) * A_STG + (kb) * 4096 + kofa)), __builtin_bit_cast(pg8::v4i_t, *(const LAS bf16x8*)(L + (st) * A_STG + (kb) * 4096 + (kofa ^ 16))), 0, 1, 2, 3, 4, 5, 6, 7)
#define A_QKM(DST, KF) asm volatile("v_mfma_scale_f32_32x32x64_f8f6f4 %0, %1, %2, %5, %3, %4 op_sel_hi:[0,0,0]" : "=&v"(DST) : "v"(KF), "v"(qf), "v"((127 - F8_SK) * 0x01010101), "v"((127 - F8_SQ) * 0x01010101), "v"(negm))
    A_QK8(pA0, 0, 0); A_QK8(pA1, 0, 1);
    asm volatile("s_nop 15\n\ts_nop 15\n\ts_nop 15\n\ts_nop 15" : "+v"(pA0), "+v"(pA1));
    A_ROWMAX2(rmc, pA0, pA1);
    pB0 = f32x16{}; pB1 = f32x16{};
#define A_SM4(g, C0, C1, PW) do { const int r0 = 4 * ((g) & 3); float e0, e1, e2, e3; \
        if ((g) < 4) { e0 = C0[r0]; e1 = C0[r0 + 1]; e2 = C0[r0 + 2]; e3 = C0[r0 + 3]; } else { e0 = C1[r0]; e1 = C1[r0 + 1]; e2 = C1[r0 + 2]; e3 = C1[r0 + 3]; } \
        e0 = __builtin_amdgcn_exp2f(e0); e1 = __builtin_amdgcn_exp2f(e1); e2 = __builtin_amdgcn_exp2f(e2); e3 = __builtin_amdgcn_exp2f(e3); \
        { int q_ = PW[g]; q_ = __builtin_amdgcn_cvt_pk_fp8_f32(e0, e1, q_, false); q_ = __builtin_amdgcn_cvt_pk_fp8_f32(e2, e3, q_, true);     asm volatile("" : "+v"(q_)); PW[g] = q_; } } while (0)
#define A_VF(stv, d0) __builtin_shufflevector(__builtin_bit_cast(pg8::v4i_t, *(const LAS bf16x8*)(L + (stv) * A_STG + vofa + (d0) * 2048)), __builtin_bit_cast(pg8::v4i_t, *(const LAS bf16x8*)(L + (stv) * A_STG + (vofa ^ 16) + (d0) * 2048)), 0, 1, 2, 3, 4, 5, 6, 7)
#define A_PVM(d0, PA, VB) asm volatile("v_mfma_scale_f32_32x32x64_f8f6f4 %0, %1, %2, %0, %3, %4 op_sel_hi:[0,0,0]" : "+v"(o[d0]) : "v"(PA), "v"(VB), "v"(0x7f7f7f7f), "v"((127 - F8_SV) * 0x01010101))
#define A_ONESF() __builtin_shufflevector(__builtin_bit_cast(pg8::v4i_t, *(const LAS bf16x8*)(L + A_ONES)), __builtin_bit_cast(pg8::v4i_t, *(const LAS bf16x8*)(L + A_ONES + 16)), 0, 1, 2, 3, 4, 5, 6, 7)
#define A_OSM(PA, ON) asm volatile("v_mfma_scale_f32_32x32x64_f8f6f4 %0, %1, %2, %0, %3, %3 op_sel_hi:[0,0,0]" : "+v"(osum) : "v"(PA), "v"(ON), "v"(0x7f7f7f7f))
#define A_SB() __builtin_amdgcn_sched_barrier(0)
#define A_STEP(kt, C0, C1, N0, N1, PWC, PWP, SVP_, KF0, KF1, PRE_, SKP_, NKF0, NKF1) do { const int svp_ = (SVP_); \
        bool resc = false; \
        if ((kt) <= my_chunk && ((kt) == 0 || __any(rmc > 8.f))) {      \
            const float dl = (kt) == 0 ? rmc : fmaxf(rmc, 0.f); resc = true; \
            _Pragma("unroll") for (int r = 0; r < 16; ++r) { C0[r] -= dl; C1[r] -= dl; negm[r] -= dl; } \
            if (hi == 0) wsf[r32] = __builtin_amdgcn_exp2f(-dl); } \
          \
        { pg8::v8i_t vb0, vb1; \
            A_QKM(N0, KF0); vb0 = A_VF(svp_, 0); A_SM4(0, C0, C1, PWC); A_SB(); \
            A_QKM(N1, KF1); vb1 = A_VF(svp_, 1); A_SM4(1, C0, C1, PWC); A_SB(); \
            A_PVM(0, PWP, vb0);  A_SM4(2, C0, C1, PWC); A_SB(); vb0 = A_VF(svp_, 2); \
            A_PVM(1, PWP, vb1);  A_SM4(3, C0, C1, PWC); A_SB(); vb1 = A_VF(svp_, 3); \
            A_PVM(2, PWP, vb0);  A_SM4(4, C0, C1, PWC); A_SB(); vb0 = A_ONESF(); \
            A_PVM(3, PWP, vb1);  A_SM4(5, C0, C1, PWC); A_SB(); \
            A_OSM(PWP, vb0);     A_SM4(6, C0, C1, PWC); A_SB(); if (PRE_) { NKF0 = A_KF(SKP_, 0); NKF1 = A_KF(SKP_, 1); } \
            A_SM4(7, C0, C1, PWC); A_SB(); } \
        if (resc) {                                           \
            asm volatile("s_waitcnt lgkmcnt(0)\n\ts_nop 15\n\ts_nop 15\n\ts_nop 15\n\ts_nop 15" ::: "memory");     \
            _Pragma("unroll") for (int r = 0; r < 16; ++r) { const float fr_ = wsf[crow(r, hi)]; osum[r] *= fr_; \
                _Pragma("unroll") for (int d0 = 0; d0 < 4; ++d0) o[d0][r] *= fr_; } } \
        A_ROWMAX2(rmc, N0, N1); \
        } while (0)
    pg8::v8i_t pwX = {0, 0, 0, 0, 0, 0, 0, 0}, pwY = {0, 0, 0, 0, 0, 0, 0, 0};
    int sb = 0;
#define A_SG(d) ((sb + (d)) >= A_NSTG ? (sb + (d)) - A_NSTG : (sb + (d)))
    for (int kt = 0; kt < NT; kt += 2) {
        if (kt > 0) { if (kt + 4 < NT) A_WAITBAR_N(4); else if (kt + 3 < NT) A_WAITBAR_N(2); else A_WAITBAR(); }
        if (kt + 5 < NT) A_DMA(kt + 5, A_SG(5));
        if (kt + 6 < NT) A_DMA(kt + 6, A_SG(6));
        { const int s0 = A_SG(0), sm1 = kt == 0 ? s0 : A_SG(7), s1 = A_SG(1), s2 = A_SG(2);
          pg8::v8i_t ka0 = A_KF(s1, 0), ka1 = A_KF(s1, 1), kb0, kb1;
          A_STEP(kt, pA0, pA1, pB0, pB1, pwX, pwY, sm1, ka0, ka1, true, s2, kb0, kb1);
          A_STEP(kt + 1, pB0, pB1, pA0, pA1, pwY, pwX, s0, kb0, kb1, false, s2, ka0, ka1); }
        sb = A_SG(2);
    }
    if (my_chunk == NT - 1) {
        const int svp_ = A_SG(7);
        const pg8::v8i_t vb0 = A_VF(svp_, 0), vb1 = A_VF(svp_, 1), vb2 = A_VF(svp_, 2), vb3 = A_VF(svp_, 3);
        const pg8::v8i_t on_ = A_ONESF();
        A_PVM(0, pwY, vb0); A_PVM(1, pwY, vb1); A_PVM(2, pwY, vb2); A_PVM(3, pwY, vb3); A_OSM(pwY, on_);
    }
#undef A_SG
#undef A_SM4
#undef A_VF
#undef A_PVM
#undef A_ONESF
#undef A_OSM
#undef A_SB
    asm volatile("s_nop 15\n\ts_nop 15\n\ts_nop 15\n\ts_nop 15" ::: "memory");
#undef A_STEP
#undef A_QK8
#undef A_KF
#undef A_QKM
#undef A_ROWMAX2
#undef A_DMA
#undef A_GLDS
#undef A_WAITBAR
#undef A_WAITBAR_N
#pragma unroll
    for (int r = 0; r < 16; ++r) { const float il = __builtin_amdgcn_rcpf(fmaxf(osum[r], 1e-30f));
#pragma unroll
        for (int d0 = 0; d0 < 4; ++d0) o[d0][r] *= il; }
    LDS_BARRIER();
    LAS float* O2 = (LAS float*)(L + A_O2) + rg * 4096;
    if (mp == 1) {
#pragma unroll
        for (int d0 = 0; d0 < 4; ++d0)
#pragma unroll
            for (int r = 0; r < 16; ++r) O2[(d0 * 16 + r) * 64 + lane] = o[d0][r];
    }
    LDS_BARRIER();
    if (mp == 0) {
        unsigned char* ob = WSP(unsigned char, WS_OB8);
        float sg[4];
#pragma unroll
        for (int d0 = 0; d0 < 4; ++d0) sg[d0] = C.subln_gain()[32 * d0 + r32] * (1.f - LAMBDA_INIT);
#pragma unroll
        for (int r = 0; r < 16; ++r) {
            float dv[4], ss = 0.f;
#pragma unroll
            for (int d0 = 0; d0 < 4; ++d0) { dv[d0] = o[d0][r] - lam * O2[(d0 * 16 + r) * 64 + lane]; ss += dv[d0] * dv[d0]; }
            ss = sum32_dpp(ss);
            const float rstd = __builtin_amdgcn_rsqf(ss * (1.f / 128.f) + 1e-6f);
            unsigned char* orow = ob + (rowbase + q0 + crow(r, hi)) * 1024 + h * 128 + r32;
#pragma unroll
            for (int d0 = 0; d0 < 4; ++d0) orow[32 * d0] = (unsigned char)(pk4_fp8(dv[d0] * rstd * sg[d0] * (float)(1 << F8_SH), 0.f, 0.f, 0.f) & 0xffu);
        }
    }
    LDS_BARRIER();
}
DI void phase_r2_attn(Ctx& C, int qword) {
    unsigned* ctl = WSP(unsigned, WS_CTL);
#ifndef R2_PROBE
#define R2_PROBE 0
#endif
    if (C.bid < 8) { r2_wave(C, C.bid * 8 + C.wave); if (R2_PROBE) r2_wave(C, C.bid * 8 + C.wave); }
    float s1 = C.lam_q1()[C.lane] * C.lam_k1()[C.lane], s2 = C.lam_q2()[C.lane] * C.lam_k2()[C.lane];
    s1 = wave_sum(s1); s2 = wave_sum(s2);
    const float lam = __expf(s1) - __expf(s2) + LAMBDA_INIT;
    LAS int* idxp = (LAS int*)(C.lds + A_IDX);
    if (C.tid < 8) ((LAS unsigned*)(C.lds + A_ONES))[C.tid] = 0x38383838u;
    __syncthreads();
    const int myq = (int)(xb_xcc_id() & 7u);
    for (int qo = 0; qo < 8; ++qo) {
        const int j = (myq + qo) & 7;
        for (;;) {
            if (C.tid == 0) *idxp = (int)__hip_atomic_fetch_add(ctl + qword + 64 * j, 1u, __ATOMIC_RELAXED, __HIP_MEMORY_SCOPE_AGENT);
            LDS_BARRIER();
            const int q = *idxp;
            LDS_BARRIER();
            if (q >= 256) break;
            const int pair = 2 * j + (q & 1);
            attn_unit(C, pair >> 3, pair & 7, 127 - (q >> 1), lam);
        }
    }
}

DI void phase_r3(Ctx& C) {
    const int lane = C.lane, w = C.wave, r32 = lane & 31, hi = lane >> 5, tt = w & 1, chi = w >> 1;
    const bf16_t* proj = WSP(bf16_t, WS_PROJ); const bf16_t* sbuf = WSP(bf16_t, WS_SBUF); const bf16_t* pbuf = WSP(bf16_t, WS_PBUF); const bf16_t* y0buf = WSP(bf16_t, WS_Y0);
    const float* bonus = WSP(float, WS_BONUS); const bf16_t* vsc = WSP(bf16_t, WS_VSC); const bf16_t* oa = WSP(bf16_t, WS_OA); unsigned char* oa8 = WSP(unsigned char, WS_OA8);
    for (int item = C.bid; item < 2048; item += C.G) {
        const int cg = item >> 2, h = (item & 3) * 4 + chi, b = cg >> 8, cidx = cg & 255;
        const size_t ch = (size_t)(b * 16 + h) * 256 + cidx, tok = (size_t)cg * 64 + 32 * tt + r32;
        f32x16 acc[2]; acc[0] = f32x16{}; acc[1] = f32x16{};
#pragma unroll
        for (int s = 0; s < 4; ++s) {
            const bf16x8 pb = *(const bf16x8*)(pbuf + ch * 4096 + ((tt * 4 + s) * 64 + lane) * 8);
#pragma unroll
            for (int vt = 0; vt < 2; ++vt) { const bf16x8 sa = *(const bf16x8*)(sbuf + ch * 4096 + ((vt * 4 + s) * 64 + lane) * 8); acc[vt] = MFMA32(sa, pb, acc[vt]); }
        }
        u32x2 yy[8], vc[8], gg[8]; f32x4 gw[8], gb[8];
        const float bs = bonus[tok * 16 + h];
#pragma unroll
        for (int q = 0; q < 8; ++q) { const int vt = q >> 2, g = q & 3, v0 = h * 64 + 32 * vt + 8 * g + 4 * hi; const size_t fi = ch * 4096 + ((((tt * 2 + vt) * 4 + g) * 64) + lane) * 4;
            yy[q] = *(const u32x2*)(y0buf + fi); vc[q] = *(const u32x2*)(vsc + fi); gg[q] = *(const u32x2*)(oa + tok * 1024 + v0);
            gw[q] = *(const f32x4*)(C.gn_w() + v0); gb[q] = *(const f32x4*)(C.gn_b() + v0); }
        float y[32]; float sum = 0.f;
#pragma unroll
        for (int q = 0; q < 8; ++q) { const int vt = q >> 2, g = q & 3;
            y[4 * q + 0] = acc[vt][4 * g + 0] + bflo(yy[q].x); y[4 * q + 1] = acc[vt][4 * g + 1] + bfhi(yy[q].x); y[4 * q + 2] = acc[vt][4 * g + 2] + bflo(yy[q].y); y[4 * q + 3] = acc[vt][4 * g + 3] + bfhi(yy[q].y); }
#pragma unroll
        for (int i = 0; i < 32; ++i) sum += y[i];
        sum = sum_x32(sum);
        const float mean = sum * (1.f / 64.f); float vs = 0.f;
#pragma unroll
        for (int i = 0; i < 32; ++i) { const float d = y[i] - mean; vs += d * d; }
        vs = sum_x32(vs);
        const float rstd = __builtin_amdgcn_rsqf(vs * (1.f / 64.f) + 64e-5f);
        unsigned ow[8];
#pragma unroll
        for (int q = 0; q < 8; ++q) {
            const f32x4 vcur = {bflo(vc[q].x), bfhi(vc[q].x), bflo(vc[q].y), bfhi(vc[q].y)}, gv = {bflo(gg[q].x), bfhi(gg[q].x), bflo(gg[q].y), bfhi(gg[q].y)};
            f32x4 ov;
#pragma unroll
            for (int e = 0; e < 4; ++e) { const float yn = (y[4 * q + e] - mean) * rstd * gw[q][e] + gb[q][e]; ov[e] = (yn + bs * vcur[e]) * gv[e] * (float)(1 << F8_SH); }
            ow[q] = pk4_fp8(ov[0], ov[1], ov[2], ov[3]);
        }
#pragma unroll
        for (int q = 0; q < 8; ++q) { const int vt = q >> 2, g = q & 3, v0 = h * 64 + 32 * vt + 8 * g + 4 * hi; *(unsigned*)(oa8 + tok * 1024 + v0) = ow[q]; }
    }
}
DI void phase_norm2_router(Ctx& C) {
    const int lane = C.lane, w = C.wave, fr = lane & 15, fq = lane >> 4;
    const float* mod = WSP(float, WS_MOD); const float* gs2 = WSP(float, WS_GS2);
    const bf16_t* wr = WSP(bf16_t, WS_WRT);
    unsigned char* H2 = WSP(unsigned char, WS_H);
    int* topidx = WSP(int, WS_TOPIDX); float* topw = WSP(float, WS_TOPW); int* wgcnt = WSP(int, WS_WGCNT);
    LAS float* lgp = (LAS float*)(C.lds);
    LAS float* rst = (LAS float*)(C.lds + RING_BYTES);
    for (int tb = C.bid; tb < 256; tb += C.G) {
        const size_t rowb = (size_t)tb * 128; const int b = (int)(rowb / SEQ);
        LAS float* rstd_l = (LAS float*)(C.lds + RING_BYTES + 1024);
        LAS int* hist = (LAS int*)(C.lds + RING_BYTES + 1536);
        (void)rst;
        if (C.tid < 32) hist[C.tid] = 0;
        {
            const float* rs = WSP(float, WS_ROWSS) + (rowb + 16 * w) * 32; float pv[16];
#pragma unroll
            for (int i = 0; i < 16; ++i) pv[i] = (lane < 32) ? rs[i * 32 + lane] : 0.f;
#pragma unroll
            for (int i = 0; i < 16; ++i) { const float r = __builtin_amdgcn_rsqf(wave_sum(pv[i]) * (1.f / D) + 1e-6f); if (lane == 0) rstd_l[16 * w + i] = r; } }
        __syncthreads();
        const int k0 = 256 * w + 8 * fq;
        const float* gsb = gs2 + b * 2048 + k0; const float* shb = mod + b * 12288 + 3 * 2048 + k0;
        const bf16_t* wb = wr + fr * 2048 + k0;
        const float* xb = C.out + (rowb + fr) * D + k0; unsigned char* hb = H2 + (rowb + fr) * D + k0;
        float rs8[8];
#pragma unroll
        for (int gi = 0; gi < 8; ++gi) rs8[gi] = rstd_l[16 * gi + fr];
        f32x4 acc[8][2];
#pragma unroll
        for (int gi = 0; gi < 8; ++gi) { acc[gi][0] = (f32x4){0.f, 0.f, 0.f, 0.f}; acc[gi][1] = acc[gi][0]; }
        for (int ks = 0; ks < 8; ++ks) {
            f32x4 xv[8][2];
#pragma unroll
            for (int gi = 0; gi < 8; ++gi) { xv[gi][0] = *(const f32x4*)(xb + (size_t)gi * 16 * D + 32 * ks); xv[gi][1] = *(const f32x4*)(xb + (size_t)gi * 16 * D + 32 * ks + 4); }
            const f32x4 g0 = *(const f32x4*)(gsb + 32 * ks), g1 = *(const f32x4*)(gsb + 32 * ks + 4), s0 = *(const f32x4*)(shb + 32 * ks), s1 = *(const f32x4*)(shb + 32 * ks + 4);
            const bf16x8 bh0 = *(const bf16x8*)(wb + 32 * ks), bl0 = *(const bf16x8*)(wb + 65536 + 32 * ks), bh1 = *(const bf16x8*)(wb + 16 * 2048 + 32 * ks), bl1 = *(const bf16x8*)(wb + 65536 + 16 * 2048 + 32 * ks);
#pragma unroll
            for (int gi = 0; gi < 8; ++gi) {
                const f32x4 y0 = xv[gi][0] * rs8[gi] * g0 + s0, y1 = xv[gi][1] * rs8[gi] * g1 + s1;
                u32x4 ah, al;
                { const unsigned h0 = f2bf(y0[0]), h1 = f2bf(y0[1]), h2 = f2bf(y0[2]), h3 = f2bf(y0[3]), h4 = f2bf(y1[0]), h5 = f2bf(y1[1]), h6 = f2bf(y1[2]), h7 = f2bf(y1[3]);
                  ah = (u32x4){h0 | (h1 << 16), h2 | (h3 << 16), h4 | (h5 << 16), h6 | (h7 << 16)};
                  al = (u32x4){pk2(y0[0] - bf2f(h0), y0[1] - bf2f(h1)), pk2(y0[2] - bf2f(h2), y0[3] - bf2f(h3)), pk2(y1[0] - bf2f(h4), y1[1] - bf2f(h5)), pk2(y1[2] - bf2f(h6), y1[3] - bf2f(h7))}; }
                { const float sh_ = (float)(1 << F8_SH); *(u32x2*)(hb + (size_t)gi * 16 * D + 32 * ks) = (u32x2){pk4_fp8(y0[0] * sh_, y0[1] * sh_, y0[2] * sh_, y0[3] * sh_), pk4_fp8(y1[0] * sh_, y1[1] * sh_, y1[2] * sh_, y1[3] * sh_)}; }
                const bf16x8 A_h = __builtin_bit_cast(bf16x8, ah), A_l = __builtin_bit_cast(bf16x8, al);
                acc[gi][0] = MFMA16(A_h, bh0, acc[gi][0]); acc[gi][0] = MFMA16(A_h, bl0, acc[gi][0]); acc[gi][0] = MFMA16(A_l, bh0, acc[gi][0]);
                acc[gi][1] = MFMA16(A_h, bh1, acc[gi][1]); acc[gi][1] = MFMA16(A_h, bl1, acc[gi][1]); acc[gi][1] = MFMA16(A_l, bh1, acc[gi][1]);
            }
        }
#pragma unroll
        for (int gi = 0; gi < 8; ++gi)
#pragma unroll
            for (int nt = 0; nt < 2; ++nt)
#pragma unroll
                for (int i = 0; i < 4; ++i) lgp[(w * 128 + 16 * gi + 4 * fq + i) * 32 + 16 * nt + fr] = acc[gi][nt][i];
        LDS_BARRIER();
        {   const int row = C.tid >> 2, e0 = 8 * (C.tid & 3); float s[8];
#pragma unroll
            for (int e = 0; e < 8; ++e) s[e] = C.b_router()[e0 + e];
#pragma unroll
            for (int ww = 0; ww < 8; ++ww) { const f32x4 a = *(const LAS f32x4*)(lgp + (ww * 128 + row) * 32 + e0), c = *(const LAS f32x4*)(lgp + (ww * 128 + row) * 32 + e0 + 4);
                s[0] += a[0]; s[1] += a[1]; s[2] += a[2]; s[3] += a[3]; s[4] += c[0]; s[5] += c[1]; s[6] += c[2]; s[7] += c[3]; }
            LDS_BARRIER();
            *(LAS f32x4*)(lgp + row * 32 + e0) = (f32x4){s[0], s[1], s[2], s[3]}; *(LAS f32x4*)(lgp + row * 32 + e0 + 4) = (f32x4){s[4], s[5], s[6], s[7]}; }
        LDS_BARRIER();
        if (C.tid < 128) {
            float v0 = -INFINITY, v1 = -INFINITY, v2 = -INFINITY, v3 = -INFINITY; int i0 = 0, i1 = 0, i2 = 0, i3 = 0;
            for (int e = 0; e < 32; ++e) { const float v = lgp[C.tid * 32 + ((e + C.tid) & 31) * 0 + e];
                if (v > v0) { v3 = v2; i3 = i2; v2 = v1; i2 = i1; v1 = v0; i1 = i0; v0 = v; i0 = e; }
                else if (v > v1) { v3 = v2; i3 = i2; v2 = v1; i2 = i1; v1 = v; i1 = e; }
                else if (v > v2) { v3 = v2; i3 = i2; v2 = v; i2 = e; }
                else if (v > v3) { v3 = v; i3 = e; } }
            const float e1 = __expf(v1 - v0), e2 = __expf(v2 - v0), e3 = __expf(v3 - v0), inv = 1.f / (1.f + e1 + e2 + e3);
            const size_t tkn = rowb + C.tid;
            *(int4*)(topidx + tkn * 4) = make_int4(i0, i1, i2, i3);
            *(f32x4*)(topw + tkn * 4) = (f32x4){inv, e1 * inv, e2 * inv, e3 * inv};
            atomicAdd((int*)&hist[i0], 1); atomicAdd((int*)&hist[i1], 1); atomicAdd((int*)&hist[i2], 1); atomicAdd((int*)&hist[i3], 1);
        }
        __syncthreads();
        if (C.tid < 32) wgcnt[tb * 32 + C.tid] = hist[C.tid];
        __syncthreads();
    }
}

DI void phase_route(Ctx& C) {
    const int lane = C.lane, w = C.wave, tid = C.tid;
    const int* wgcnt = WSP(int, WS_WGCNT); const int* topidx = WSP(int, WS_TOPIDX); const float* topw = WSP(float, WS_TOPW);
    int* slotpos = WSP(int, WS_SLOTPOS); int* rowtok = WSP(int, WS_ROWTOK); float* rowgate = WSP(float, WS_ROWGATE); int* tiletab = WSP(int, WS_TILEEXP);
    LAS int* part = (LAS int*)(C.lds);
    LAS int* tot = part + 512;
    LAS int* pstart = tot + 32;
    LAS int* pre = pstart + 40;
    LAS int* wcnt = pre + 32;
    LAS int* spos = wcnt + 256;
    { const int e = tid & 31, j = tid >> 5; int s = 0; for (int i = 0; i < 16; ++i) s += wgcnt[(16 * j + i) * 32 + e]; part[j * 32 + e] = s; }
    __syncthreads();
    if (tid < 32) { int s = 0; for (int j = 0; j < 16; ++j) s += part[j * 32 + tid]; tot[tid] = s; }
    __syncthreads();
    if (tid == 0) { int run = 0; for (int e = 0; e < 32; ++e) { pstart[e] = run; run += ((tot[e] + 255) >> 8) << 8; } pstart[32] = run; }
    __syncthreads();
    if (C.bid == 0) {
        if (tid == 0) tiletab[0] = pstart[32] >> 8;
        for (int e = 0; e < 32; ++e) { const int t0 = pstart[e] >> 8, t1 = pstart[e + 1] >> 8; for (int t = t0 + tid; t < t1; t += NTHR) tiletab[16 + t] = e; }
    }
    for (int e = C.bid; e < 32; e += C.G) {
        const int p0 = pstart[e] + tot[e], p1 = pstart[e + 1];
        for (int p = p0 + tid; p < p1; p += NTHR) { rowtok[p] = -1; rowgate[p] = 0.f; }
    }
    for (int tb = C.bid; tb < 256; tb += C.G) {
        if (tid < 32) { int s = 0; for (int j = 0; j < (tb >> 4); ++j) s += part[j * 32 + tid]; for (int t2 = (tb >> 4) << 4; t2 < tb; ++t2) s += wgcnt[t2 * 32 + tid]; pre[tid] = s; }
        const int slot = tb * 512 + tid;
        const int my_e = topidx[slot]; int my_rank = 0;
        for (int e = 0; e < 32; ++e) { const unsigned long long m = __ballot(my_e == e);
            if (my_e == e) my_rank = __popcll(m & ((1ull << lane) - 1ull));
            if (lane == 0) wcnt[w * 32 + e] = __popcll(m); }
        __syncthreads();
        int base = pstart[my_e] + pre[my_e];
        for (int w2 = 0; w2 < w; ++w2) base += wcnt[w2 * 32 + my_e];
        const int pos = base + my_rank;
        slotpos[slot] = pos; rowtok[pos] = slot >> 2; rowgate[pos] = topw[slot]; spos[tid] = pos;
        __syncthreads();
        __syncthreads();
    }
}

DI void phase_combine(Ctx& C) {
    const int gw = C.bid * NWAVES + C.wave, NGW = C.G * NWAVES, lane = C.lane;
    const float* mod = WSP(float, WS_MOD); const int* slotpos = WSP(int, WS_SLOTPOS); const bf16_t* Y = WSP(bf16_t, WS_YR);
    for (int tp = gw; tp < T / 2; tp += NGW) {
        const int t0 = 2 * tp; const int b = t0 / SEQ; const float* g2 = mod + b * 12288 + 5 * 2048;
        const int4 spa = *(const int4*)(slotpos + (size_t)t0 * 4), spb = *(const int4*)(slotpos + (size_t)t0 * 4 + 4);
        const int pp[8] = {spa.x, spa.y, spa.z, spa.w, spb.x, spb.y, spb.z, spb.w};
#pragma unroll
        for (int j = 0; j < 4; ++j) {
            const int c0 = 8 * lane + 512 * j;
            u32x4 yv[8]; f32x4 xa[2][2];
#pragma unroll
            for (int k = 0; k < 8; ++k) yv[k] = *(const u32x4*)(Y + (size_t)pp[k] * 2048 + c0);
#pragma unroll
            for (int u = 0; u < 2; ++u) { xa[u][0] = *(const f32x4*)(C.out + (size_t)(t0 + u) * D + c0); xa[u][1] = *(const f32x4*)(C.out + (size_t)(t0 + u) * D + c0 + 4); }
            const f32x4 ga = *(const f32x4*)(g2 + c0), gb = *(const f32x4*)(g2 + c0 + 4);
#pragma unroll
            for (int u = 0; u < 2; ++u) { float s[8] = {0.f, 0.f, 0.f, 0.f, 0.f, 0.f, 0.f, 0.f};
#pragma unroll
                for (int k = 0; k < 4; ++k) { const u32x4 y = yv[4 * u + k];
                    s[0] += bflo(y.x); s[1] += bfhi(y.x); s[2] += bflo(y.y); s[3] += bfhi(y.y); s[4] += bflo(y.z); s[5] += bfhi(y.z); s[6] += bflo(y.w); s[7] += bfhi(y.w); }
                float* orow = C.out + (size_t)(t0 + u) * D + c0;
                *(f32x4*)(orow) = xa[u][0] + ga * (f32x4){s[0], s[1], s[2], s[3]}; *(f32x4*)(orow + 4) = xa[u][1] + gb * (f32x4){s[4], s[5], s[6], s[7]}; }
        }
    }
}


DI bool refresh(Ctx& C) { int t = threadIdx.x; asm volatile("" : "+v"(t)); C.tid = t; C.lane = t & 63; return true; }
DI void phase_gemm_proj(Ctx& C, PG8_LAS unsigned char* ring) {
    pg8::Gemm g{WSP(bf16_t, WS_H), WSP(bf16_t, WS_WTIN), T, NPROJ, D / 2, F8_SC_GU}; pg8::StaticOrder S; S.init(T, NPROJ, C.G, C.bid);
    EpiPlainBf16 E{WSP(bf16_t, WS_PROJ), NPROJ};
    pg8::gemm_phase<EpiPlainBf16, pg8::StaticOrder, true, true, true>(ring, g, S, E);
}
DI void phase_gemm_lora(Ctx& C, PG8_LAS unsigned char* ring) {

        static_assert(WS_MERGED == WS_OA + (size_t)T * 1024 * 2, "g | lw | a contiguous");
        int Kl = 256; asm volatile("" : "+s"(Kl));
        pg8::Gemm g{WSP(bf16_t, WS_OB), WSP(bf16_t, WS_BTLORA), 2 * T, 3072, Kl, 0}; LoraOrder S; S.init(T, 3072, C.G, C.bid);
        EpiLora E{WSP(bf16_t, WS_OA), C.w0(), C.a0()};
        pg8::gemm_phase<EpiLora, LoraOrder, true, true>(ring, g, S, E);
    }
DI void phase_gemm_gateup(Ctx& C, PG8_LAS unsigned char* ring) {
    pg8::Gemm g{WSP(bf16_t, WS_H), WSP(bf16_t, WS_WTGU), P_MAX, 32 * 4096, D / 2, F8_SC_GU}; MoeOrder S{WSP(int, WS_TILEEXP), 16, C.G, (C.G % 8 == 0) ? (C.bid % 8) * (C.G / 8) + C.bid / 8 : C.bid, WSP(int, WS_ROWTOK)};
    EpiGateUp E{WSP(unsigned char, WS_ACT), C.b_exp_gate(), C.b_exp_up()};
    pg8::gemm_phase<EpiGateUp, MoeOrder, true, true, true, true>(ring, g, S, E);
}
constexpr int N_PHASES = 16;
__global__ void __launch_bounds__(NTHR, 2) fwd(Args args) {
    extern __shared__ __attribute__((aligned(16))) unsigned char lds_raw[];
    Ctx C{args};
    C.lds = (LAS unsigned char*)lds_raw;
    C.tid = threadIdx.x; C.lane = C.tid & 63; C.wave = __builtin_amdgcn_readfirstlane(C.tid >> 6); C.G = gridDim.x; C.bid = blockIdx.x;
    C.out = args.out; C.ws = args.ws;
    volatile LAS unsigned* MISC = (volatile LAS unsigned*)(C.lds + MISC_OFF);
    for (int u = C.tid; u < (LDS_BYTES - RING_BYTES) / 4; u += NTHR) ((LAS unsigned*)(C.lds + RING_BYTES))[u] = 0u;
    __syncthreads();
    const int lo = args.ph_lo, hi = args.ph_hi;
    XcdBarrier bar; bar.bar = WSP(unsigned, WS_CTL) + CW_BAR; bar.x = 0; bar.st = nullptr;
    if (hi - lo > 1) bar = xcd_barrier_post(WSP(unsigned, WS_CTL) + CW_BAR, MISC + 8);
#define IN(k) (lo <= (k) && (k) < hi && refresh(C))
#define SEAM(k) do { if (IN(k) && IN((k) + 1)) xcd_barrier(bar); } while (0)
#ifndef REP_MASK
#define REP_MASK 0
#endif
#define REPQ(k) (((REP_MASK) >> (k)) & 1)
#define REPLOOP(k) _Pragma("nounroll") for (int rep_ = 0; rep_ <= REPQ(k); ++rep_)
    PG8_LAS unsigned char* ring = (PG8_LAS unsigned char*)C.lds;

    if (IN(0)) { REPLOOP(0) { if (rep_) xcd_barrier(bar); phase_prologue(C); } } SEAM(0);
    if (IN(1)) { REPLOOP(1) { if (rep_) xcd_barrier(bar); phase_norm1(C); } } SEAM(1);
    if (IN(2)) { REPLOOP(2) { if (rep_) xcd_barrier(bar); phase_gemm_proj(C, ring); } } SEAM(2);
    if (IN(3)) { REPLOOP(3) { if (rep_) xcd_barrier(bar); phase_prep(C); } } SEAM(3);
    if (IN(4)) { REPLOOP(4) { if (rep_) xcd_barrier(bar); phase_gemm_lora(C, ring); } } SEAM(4);
    if (IN(5)) { REPLOOP(5) { if (rep_) xcd_barrier(bar); phase_r1(C); } } SEAM(5);
    if (IN(6)) { REPLOOP(6) { if (rep_) xcd_barrier(bar); phase_r2_attn(C, CW_QUEUE + 512 * rep_); } } SEAM(6);
    if (IN(7)) { REPLOOP(7) { if (rep_) xcd_barrier(bar); phase_r3(C); } } SEAM(7);
    if (IN(8)) {
        static_assert(WS_OB8 == WS_OA8 + (size_t)T * 1024 && WS_WTBB == WS_WTBA + (size_t)D * 1024, "o_a | o_b and w_branch_a | w_branch_b are stacked");
        pg8::Gemm g{WSP(bf16_t, WS_OA8), WSP(bf16_t, WS_WTBA), 2 * T, 2 * D, 512, F8_SC_GU}; BranchOrder S; S.init(T, D, C.G, C.bid);
        EpiBranchFused E{WSP(unsigned char, WS_MERGED8), WSP(bf16_t, WS_PROJ)};
        pg8::gemm_phase<EpiBranchFused, BranchOrder, true, true, true>(ring, g, S, E);
    } SEAM(8);
    if (IN(10)) {
        pg8::Gemm g{WSP(bf16_t, WS_MERGED8), WSP(bf16_t, WS_WTOUT), T, D, D / 2, F8_SC_GU}; pg8::StaticOrder S; S.init(T, D, C.G, C.bid);
        EpiOut E{C.out, C.x(), WSP(float, WS_MOD), WSP(float, WS_ROWSS)};
        pg8::gemm_phase<EpiOut, pg8::StaticOrder, true, true, true>(ring, g, S, E);
    } SEAM(10);
    if (IN(11)) { REPLOOP(11) { if (rep_) xcd_barrier(bar); phase_norm2_router(C); } } SEAM(11);
    if (IN(12)) { REPLOOP(12) { if (rep_) xcd_barrier(bar); phase_route(C); } } SEAM(12);
    if (IN(13)) { REPLOOP(13) { if (rep_) xcd_barrier(bar); phase_gemm_gateup(C, ring); } } SEAM(13);
    if (IN(14)) {
        pg8::Gemm g{WSP(bf16_t, WS_ACT), WSP(bf16_t, WS_WTDN), P_MAX, 32 * 2048, D / 2, F8_SC_DN}; MoeOrder S{WSP(int, WS_TILEEXP), 8, C.G, (C.G % 8 == 0) ? (C.bid % 8) * (C.G / 8) + C.bid / 8 : C.bid, WSP(int, WS_ROWTOK)};
        EpiDown E{WSP(bf16_t, WS_YR), C.b_exp_down(), WSP(float, WS_ROWGATE)};
        pg8::gemm_phase<EpiDown, MoeOrder, true, true, true>(ring, g, S, E);
    } SEAM(14);
    if (IN(15)) { phase_combine(C); }
#undef IN
#undef SEAM
}

#ifndef N_LAUNCH_MODE
#define N_LAUNCH_MODE 1
#endif
extern "C" void kernel_launch(void* const* d_in, const int* in_sizes, int n_in, void* d_out, int out_size, void* d_ws, size_t ws_size, hipStream_t stream) {
    static int grid = 0;
    if (grid == 0) {
        if (n_in != 36 || out_size != T * D || ws_size < WS_END) { fprintf(stderr, "kernel_launch: unexpected shapes (n_in %d out %d ws %zu)\n", n_in, out_size, ws_size); grid = -1; return; }
        int dev = 0, cus = 0, per_cu = 0;
        if (hipGetDevice(&dev) != hipSuccess || hipDeviceGetAttribute(&cus, hipDeviceAttributeMultiprocessorCount, dev) != hipSuccess) { grid = -1; return; }
        if (hipFuncSetAttribute((const void*)fwd, hipFuncAttributeMaxDynamicSharedMemorySize, LDS_BYTES) != hipSuccess) { fprintf(stderr, "kernel_launch: hipFuncSetAttribute failed\n"); grid = -1; return; }
        if (hipOccupancyMaxActiveBlocksPerMultiprocessor(&per_cu, (const void*)fwd, NTHR, LDS_BYTES) != hipSuccess || per_cu < 1) { fprintf(stderr, "kernel_launch: occupancy query says %d\n", per_cu); }
        (void)hipGetLastError();
        grid = cus;
    }
    if (grid < 0) return;
    (void)hipMemsetAsync((char*)d_ws + WS_CTL, 0, CTL_ZERO_BYTES, stream);
    Args a{};
    for (int i = 0; i < 36; ++i) a.in[i] = (const float*)d_in[i];
    a.out = (float*)d_out; a.ws = (unsigned char*)d_ws;
#if N_LAUNCH_MODE == 1
    a.ph_lo = 0; a.ph_hi = N_PHASES;
    hipLaunchKernelGGL(fwd, dim3(grid), dim3(NTHR), LDS_BYTES, stream, a);
#else
    for (int p = 0; p < N_PHASES; ++p) { a.ph_lo = p; a.ph_hi = p + 1; hipLaunchKernelGGL(fwd, dim3(grid), dim3(NTHR), LDS_BYTES, stream, a); }
#endif
}
```

```cpp
#include <hip/hip_runtime.h>
#include <cstdio>
#include <cstdint>
#include <cmath>

#define GAS __attribute__((address_space(1)))
#define LAS __attribute__((address_space(3)))
#define DI __device__ __forceinline__
typedef unsigned short bf16_t;
typedef short bf16x8 __attribute__((ext_vector_type(8)));
typedef short s16x4 __attribute__((ext_vector_type(4)));
typedef float f32x4 __attribute__((ext_vector_type(4)));
typedef float f32x2 __attribute__((ext_vector_type(2)));
typedef float f32x16 __attribute__((ext_vector_type(16)));
typedef unsigned u32x4 __attribute__((ext_vector_type(4)));
typedef unsigned u32x2 __attribute__((ext_vector_type(2)));

typedef float f32x2_t __attribute__((ext_vector_type(2))); typedef __bf16 bf16x2_t __attribute__((ext_vector_type(2)));
DI unsigned cvtpk(float lo, float hi) { f32x2_t v = {lo, hi}; bf16x2_t b = __builtin_convertvector(v, bf16x2_t); return __builtin_bit_cast(unsigned, b); }
DI unsigned f2bf(float f) { return cvtpk(f, f) & 0xffffu; }
DI unsigned pk2(float lo, float hi) { return cvtpk(lo, hi); }
DI float bf2f(unsigned b) { return __builtin_bit_cast(float, b << 16); }
DI float bflo(unsigned w) { return __builtin_bit_cast(float, w << 16); }
DI float bfhi(unsigned w) { return __builtin_bit_cast(float, w & 0xffff0000u); }
#define DPPF(v, ctrl) __builtin_bit_cast(float, __builtin_amdgcn_update_dpp(0, __builtin_bit_cast(int, (v)), (ctrl), 0xf, 0xf, true))
#define DPPF_ROWS(v, ctrl, rmask) __builtin_bit_cast(float, __builtin_amdgcn_update_dpp(0, __builtin_bit_cast(int, (v)), (ctrl), (rmask), 0xf, false))
DI float sum8_dpp(float v) {
    v += DPPF(v, 0xB1); v += DPPF(v, 0x4E); v += DPPF(v, 0x141); return v;
}
DI float wave_sum(float v) {
    v = sum8_dpp(v); v += DPPF(v, 0x140);
    v += DPPF_ROWS(v, 0x142, 0xa); v += DPPF_ROWS(v, 0x143, 0xc);
    return __builtin_bit_cast(float, __builtin_amdgcn_readlane(__builtin_bit_cast(int, v), 63));
}
DI float sum_x16(float v) {
    const auto p = __builtin_amdgcn_permlane16_swap(__float_as_uint(v), __float_as_uint(v), false, false); return __uint_as_float(p[0]) + __uint_as_float(p[1]); }
DI float sum_x32(float v) {
    const auto p = __builtin_amdgcn_permlane32_swap(__float_as_uint(v), __float_as_uint(v), false, false); return __uint_as_float(p[0]) + __uint_as_float(p[1]); }
DI float sum32_dpp(float v) {
    v = sum8_dpp(v); v += DPPF(v, 0x140); return sum_x16(v); }
DI float sigmoidf_(float x) { return __builtin_amdgcn_rcpf(1.f + __expf(-x)); }
#define LDS_BARRIER() asm volatile("s_waitcnt lgkmcnt(0)\n\ts_barrier" ::: "memory")
DI int crow(int r, int hi) { return (r & 3) + 8 * (r >> 2) + 4 * hi; }
#define MFMA32(a, b, c) __builtin_amdgcn_mfma_f32_32x32x16_bf16((a), (b), (c), 0, 0, 0)
#define MFMA16(a, b, c) __builtin_amdgcn_mfma_f32_16x16x32_bf16((a), (b), (c), 0, 0, 0)

namespace pg8 {
#define PG8_LAS __attribute__((address_space(3)))
constexpr int BM = 256, BK = 64, HALF = 128, HTB = HALF * BK * 2, STAGE_BYTES = 8 * HTB, NXCD = 8, WGM = 4;
__host__ __device__ __forceinline__ int lds_byte(int r, int c) { const int st = (r >> 4) * 2 + (c >> 5), rr = r & 15, cc = c & 31, ob = rr * 64 + cc * 2; return st * 1024 + (ob ^ (((ob >> 9) & 1) << 5)); }
__host__ __device__ __forceinline__ void stage_rc(int b, int& R, int& C) { const int st = b / 1024, sb = b % 1024, swz = sb ^ (((sb >> 9) & 1) << 5); R = (st >> 1) * 16 + swz / 64; C = (st & 1) * 32 + (swz % 64) / 2; }
__host__ __device__ __forceinline__ int perm32(int rho) { const int n = rho >> 4, i = rho & 15; return 8 * (i >> 2) + 4 * n + (i & 3); }
struct Unit { int pm, pn; };
struct Gemm { const bf16_t* A; const bf16_t* Bt; int M, N, K; int f8scale; };
struct StaticOrder {
    int nM, nN, nwg, G, c;
    __host__ __device__ void init(int M, int N, int G_, int c_) { nM = M / BM; nN = N / BM; nwg = nM * nN; G = G_; c = c_; }
    __host__ __device__ bool next(int i, Unit& u) const {
        const long L = (long)i * G + c; if (L >= nwg) return false;
        int wgid = (int)L; { const int q = nwg / NXCD, r = nwg % NXCD, xcd = wgid % NXCD, off = wgid / NXCD; wgid = (xcd < r ? xcd * (q + 1) : r * (q + 1) + (xcd - r) * q) + off; }
        const int nig = WGM * nN, gid = wgid / nig, fm = gid * WGM, gsz = (nM - fm) < WGM ? (nM - fm) : WGM;
        u.pm = fm + ((wgid % nig) % gsz); u.pn = (wgid % nig) / gsz; return true;
    }
    __device__ __forceinline__ void a_ready(const Unit&) const {}
    __device__ __forceinline__ void done(const Unit&) const {}
};
__device__ __forceinline__ unsigned cvt_pk_bf16(float lo, float hi) { unsigned r; asm volatile("v_cvt_pk_bf16_f32 %0, %1, %2" : "=v"(r) : "v"(lo), "v"(hi)); return r; }
typedef int v8i_t __attribute__((ext_vector_type(8))); typedef int v4i_t __attribute__((ext_vector_type(4)));
#define PG8_CAT(x0, x1) __builtin_shufflevector(__builtin_bit_cast(v4i_t, (x0)), __builtin_bit_cast(v4i_t, (x1)), 0, 1, 2, 3, 4, 5, 6, 7)
template <class Epi, class Sched, bool ALIGN_EPI = false, bool SP2 = false, bool F8 = false, bool GATHER = false>
__device__ __forceinline__ void gemm_phase(PG8_LAS unsigned char* lds, const Gemm g, const Sched& S, const Epi& E) {
    const int tid = threadIdx.x, wid = __builtin_amdgcn_readfirstlane(tid >> 6), lane = tid & 63, wr = wid >> 2, wc = wid & 3, fr = lane & 15, fq = lane >> 4;
    const int K = g.K, nt = K / BK; const int f8sc = g.f8scale, f8one = 0x7f7f7f7f; (void)f8sc; (void)f8one;
    unsigned voffA[2], voffB[2];
#pragma unroll
    for (int i = 0; i < 2; ++i) { int R, C; stage_rc(tid * 16 + i * 8192, R, C); const int Rb = Epi::PERM ? ((R & ~31) + perm32(R & 31)) : R;
        voffA[i] = (unsigned)(R * K + C) * 2u; voffB[i] = (unsigned)(Rb * K + C) * 2u; }
    const size_t kstep = (size_t)(BK * 2);
    const size_t hstep = (size_t)HALF * K * 2;
    const size_t tstep = 2 * hstep;
    const unsigned ldsw = (unsigned)wid * 1024u;
    const int aoff = lds_byte(wr * 64 + fr, fq * 8), boff = lds_byte(wc * 32 + fr, fq * 8);
#define PG8_SA(b, h) (((b) * 2 + (h)) * HTB)
#define PG8_SB(b, h) ((4 + (b) * 2 + (h)) * HTB)
#define PG8_STAGE(bufoff, gbase, voff) do { _Pragma("unroll") for (int _i = 0; _i < 2; ++_i) \
        __builtin_amdgcn_global_load_lds((const unsigned*)((const char*)(gbase) + (voff)[_i]), (PG8_LAS unsigned*)(lds + (bufoff) + ldsw + _i * 8192), 16, 0, 0); } while (0)
#define PG8_STAGE_A(bufoff, ptr, half, gset, kofs) do { if constexpr (GATHER) { _Pragma("unroll") for (int _i = 0; _i < 2; ++_i) \
        __builtin_amdgcn_global_load_lds((const unsigned*)((const char*)g.A + (size_t)gset[half][_i] + (size_t)(kofs)), (PG8_LAS unsigned*)(lds + (bufoff) + ldsw + _i * 8192), 16, 0, 0); } \
        else { PG8_STAGE(bufoff, (ptr) + (half) * hstep, voffA); } } while (0)
#define PG8_LDA(dst, b, h) do { _Pragma("unroll") for (int m = 0; m < 4; ++m) { if constexpr (F8) { dst##8[m] = PG8_CAT(*(const PG8_LAS bf16x8*)(lds + PG8_SA(b, h) + aoff + m * 2048), *(const PG8_LAS bf16x8*)(lds + PG8_SA(b, h) + aoff + m * 2048 + 1024)); } \
        else { _Pragma("unroll") for (int k = 0; k < 2; ++k) dst[m][k] = *(const PG8_LAS bf16x8*)(lds + PG8_SA(b, h) + aoff + m * 2048 + k * 1024); } } } while (0)
#define PG8_LDB(dst, b, h) do { _Pragma("unroll") for (int n = 0; n < 2; ++n) { if constexpr (F8) { dst##8[n] = PG8_CAT(*(const PG8_LAS bf16x8*)(lds + PG8_SB(b, h) + boff + n * 2048), *(const PG8_LAS bf16x8*)(lds + PG8_SB(b, h) + boff + n * 2048 + 1024)); } \
        else { _Pragma("unroll") for (int k = 0; k < 2; ++k) dst[n][k] = *(const PG8_LAS bf16x8*)(lds + PG8_SB(b, h) + boff + n * 2048 + k * 1024); } } } while (0)
#define PG8_MMA(ai, bj, At, Bt) do { __builtin_amdgcn_s_setprio(1); _Pragma("unroll") for (int m = 0; m < 4; ++m) _Pragma("unroll") for (int n = 0; n < 2; ++n) { \
        if constexpr (F8) { asm volatile("v_mfma_scale_f32_16x16x128_f8f6f4 %0, %1, %2, %0, %3, %4 op_sel_hi:[0,0,0]" : "+v"(acc[ai][bj][m][n]) : "v"(Bt##8[n]), "v"(At##8[m]), "v"(f8sc), "v"(f8one)); } \
        else { _Pragma("unroll") for (int k = 0; k < 2; ++k) acc[ai][bj][m][n] = __builtin_amdgcn_mfma_f32_16x16x32_bf16(Bt[n][k], At[m][k], acc[ai][bj][m][n], 0, 0, 0); } } __builtin_amdgcn_s_setprio(0); } while (0)
#define PG8_WAIT_V(n) asm volatile("s_waitcnt vmcnt(" #n ")" ::: "memory")
#define PG8_WAIT_L(n) asm volatile("s_waitcnt lgkmcnt(" #n ")" ::: "memory")
#define PG8_BAR __builtin_amdgcn_s_barrier()
#define PG8_SCHED __builtin_amdgcn_sched_barrier(0)
    Unit cur, nxt; int ui = 0;
    if (!S.next(0, cur)) return;
    f32x4 acc[2][2][4][2];
#pragma unroll
    for (int a = 0; a < 2; ++a)
#pragma unroll
        for (int b = 0; b < 2; ++b)
#pragma unroll
            for (int m = 0; m < 4; ++m)
#pragma unroll
                for (int n = 0; n < 2; ++n) acc[a][b][m][n] = (f32x4){0.f, 0.f, 0.f, 0.f};
    bf16x8 At[4][2], B0[2][2], B1[2][2]; v8i_t At8[4], B08[2], B18[2];
    const char* cA = (const char*)g.A + (size_t)cur.pm * tstep; const char* cB = (const char*)g.Bt + (size_t)cur.pn * tstep;
    unsigned gc[2][2] = {{0u, 0u}, {0u, 0u}}, gn[2][2] = {{0u, 0u}, {0u, 0u}}; (void)gc; (void)gn;
#define PG8_GOFF(dst, u) do { if constexpr (GATHER) { _Pragma("unroll") for (int _h = 0; _h < 2; ++_h) _Pragma("unroll") for (int _i = 0; _i < 2; ++_i) { int R_, C_; stage_rc(tid * 16 + _i * 8192, R_, C_); \
        int tok_ = S.rowtok[(u).pm * BM + _h * HALF + R_]; tok_ = tok_ < 0 ? 0 : tok_; dst[_h][_i] = (unsigned)tok_ * (unsigned)(K * 2) + (unsigned)(C_ * 2); } } } while (0)
    PG8_GOFF(gc, cur);
    S.a_ready(cur);
    if constexpr (SP2) {
        PG8_STAGE(PG8_SB(0, 0), cB, voffB); PG8_STAGE(PG8_SB(0, 1), cB + hstep, voffB); PG8_STAGE_A(PG8_SA(0, 0), cA, 0, gc, 0); PG8_STAGE_A(PG8_SA(0, 1), cA, 1, gc, 0);
        if (wr == 1) PG8_BAR;
        PG8_WAIT_V(2); PG8_BAR;
        PG8_STAGE(PG8_SB(1, 0), cB + kstep, voffB); PG8_STAGE_A(PG8_SA(1, 0), cA + kstep, 0, gc, kstep); PG8_STAGE(PG8_SB(1, 1), cB + hstep + kstep, voffB);
        PG8_WAIT_V(6); PG8_BAR;
    } else {
        PG8_STAGE(PG8_SB(0, 0), cB, voffB); PG8_STAGE_A(PG8_SA(0, 0), cA, 0, gc, 0); PG8_STAGE(PG8_SB(0, 1), cB + hstep, voffB); PG8_STAGE_A(PG8_SA(0, 1), cA, 1, gc, 0);
        if (wr == 1) PG8_BAR;
        PG8_WAIT_V(4); PG8_BAR;
        PG8_STAGE(PG8_SB(1, 0), cB + kstep, voffB); PG8_STAGE_A(PG8_SA(1, 0), cA + kstep, 0, gc, kstep); PG8_STAGE(PG8_SB(1, 1), cB + hstep + kstep, voffB);
        PG8_WAIT_V(6); PG8_BAR;
    }
    for (;;) {
        const bool has_next = S.next(ui + 1, nxt);
        const char* nA = has_next ? (const char*)g.A + (size_t)nxt.pm * tstep : cA; const char* nB = has_next ? (const char*)g.Bt + (size_t)nxt.pn * tstep : cB;
        if constexpr (GATHER) { if (has_next) { PG8_GOFF(gn, nxt); } else { gn[0][0] = gc[0][0]; gn[0][1] = gc[0][1]; gn[1][0] = gc[1][0]; gn[1][1] = gc[1][1]; } }
        for (int t = 0; t < nt; t += 2) {
            const bool last = (t == nt - 2);
            const char* a1 = cA + (size_t)(t + 1) * kstep;
            const char* a2 = last ? nA : cA + (size_t)(t + 2) * kstep; const char* b2 = last ? nB : cB + (size_t)(t + 2) * kstep;
            const char* a3 = a2 + kstep; const char* b3 = b2 + kstep;
            const size_t kA1 = (size_t)(t + 1) * kstep, kA2 = last ? (size_t)0 : (size_t)(t + 2) * kstep, kA3 = kA2 + kstep; (void)kA1; (void)kA2; (void)kA3;
            unsigned g2[2][2]; _Pragma("unroll") for (int _h = 0; _h < 2; ++_h) _Pragma("unroll") for (int _i = 0; _i < 2; ++_i) g2[_h][_i] = last ? gn[_h][_i] : gc[_h][_i]; (void)g2;
            if (last && has_next) S.a_ready(nxt);
            if constexpr (SP2) {
            PG8_LDB(B0, 0, 0); PG8_LDB(B1, 0, 1); PG8_SCHED; PG8_LDA(At, 0, 0); PG8_STAGE_A(PG8_SA(1, 1), a1, 1, gc, kA1);
            PG8_WAIT_V(8); PG8_WAIT_L(0); PG8_BAR; PG8_MMA(0, 0, At, B0); PG8_MMA(0, 1, At, B1); PG8_BAR; PG8_SCHED;
            PG8_LDA(At, 0, 1); PG8_STAGE(PG8_SB(0, 0), b2, voffB); PG8_STAGE(PG8_SB(0, 1), b2 + hstep, voffB); PG8_STAGE_A(PG8_SA(0, 0), a2, 0, g2, kA2);
            PG8_WAIT_V(8); PG8_WAIT_L(0); PG8_BAR; PG8_MMA(1, 0, At, B0); PG8_MMA(1, 1, At, B1); PG8_BAR; PG8_SCHED;
            PG8_LDB(B0, 1, 0); PG8_LDB(B1, 1, 1); PG8_SCHED; PG8_LDA(At, 1, 0); PG8_STAGE_A(PG8_SA(0, 1), a2, 1, g2, kA2);
            PG8_WAIT_V(8); PG8_WAIT_L(0); PG8_BAR; PG8_MMA(0, 0, At, B0); PG8_MMA(0, 1, At, B1); PG8_BAR; PG8_SCHED;
            PG8_LDA(At, 1, 1); PG8_STAGE(PG8_SB(1, 0), b3, voffB); PG8_STAGE(PG8_SB(1, 1), b3 + hstep, voffB); PG8_STAGE_A(PG8_SA(1, 0), a3, 0, g2, kA3);
            PG8_WAIT_V(8); PG8_WAIT_L(0); PG8_BAR; PG8_MMA(1, 0, At, B0); PG8_MMA(1, 1, At, B1); PG8_BAR; PG8_SCHED;
            } else {
            PG8_LDB(B0, 0, 0); PG8_SCHED; PG8_LDA(At, 0, 0); PG8_STAGE_A(PG8_SA(1, 1), a1, 1, gc, kA1);
            PG8_WAIT_L(8); PG8_BAR; PG8_WAIT_L(0); PG8_MMA(0, 0, At, B0); PG8_BAR; PG8_SCHED;
            PG8_LDB(B1, 0, 1); PG8_STAGE(PG8_SB(0, 0), b2, voffB);
            PG8_BAR; PG8_WAIT_L(0); PG8_MMA(0, 1, At, B1); PG8_BAR;
            PG8_LDA(At, 0, 1); PG8_STAGE_A(PG8_SA(0, 0), a2, 0, g2, kA2);
            PG8_BAR; PG8_WAIT_L(0); PG8_MMA(1, 0, At, B0); PG8_BAR; PG8_SCHED;
            PG8_STAGE(PG8_SB(0, 1), b2 + hstep, voffB);
            PG8_WAIT_V(6); PG8_BAR; PG8_MMA(1, 1, At, B1); PG8_BAR;
            PG8_LDB(B0, 1, 0); PG8_SCHED; PG8_LDA(At, 1, 0); PG8_STAGE_A(PG8_SA(0, 1), a2, 1, g2, kA2);
            PG8_WAIT_L(8); PG8_BAR; PG8_WAIT_L(0); PG8_MMA(0, 0, At, B0); PG8_BAR; PG8_SCHED;
            PG8_LDB(B1, 1, 1); PG8_STAGE(PG8_SB(1, 0), b3, voffB);
            PG8_BAR; PG8_WAIT_L(0); PG8_MMA(0, 1, At, B1); PG8_BAR;
            PG8_LDA(At, 1, 1); PG8_STAGE_A(PG8_SA(1, 0), a3, 0, g2, kA3);
            PG8_BAR; PG8_WAIT_L(0); PG8_MMA(1, 0, At, B0); PG8_BAR; PG8_SCHED;
            PG8_STAGE(PG8_SB(1, 1), b3 + hstep, voffB);
            PG8_WAIT_V(6); PG8_BAR; PG8_MMA(1, 1, At, B1); PG8_BAR;
            }
        }
        if constexpr (F8) { asm volatile("s_nop 15\n\ts_nop 15" ::: "memory"); }
        if constexpr (ALIGN_EPI) { if (wr == 0) PG8_BAR; }
        bool partial_ = false;
        if constexpr (Epi::HAS_MID) partial_ = S.partial(cur);
        if constexpr (!Epi::AFTER_DRAIN) { if constexpr (Epi::HAS_MID) { if (partial_) E.mid(acc, cur, wr, wc, fr, fq); else E(acc, cur, wr, wc, fr, fq); } else { E(acc, cur, wr, wc, fr, fq); } S.done(cur); }
        if (!has_next) break;
        if (!partial_)
#pragma unroll
        for (int a = 0; a < 2; ++a)
#pragma unroll
            for (int b = 0; b < 2; ++b)
#pragma unroll
                for (int m = 0; m < 4; ++m)
#pragma unroll
                    for (int n = 0; n < 2; ++n) acc[a][b][m][n] = (f32x4){0.f, 0.f, 0.f, 0.f};
        cur = nxt; cA = nA; cB = nB; ++ui; gc[0][0] = gn[0][0]; gc[0][1] = gn[0][1]; gc[1][0] = gn[1][0]; gc[1][1] = gn[1][1];
        if constexpr (ALIGN_EPI) { if (wr == 1) PG8_BAR; }
    }
    PG8_WAIT_V(0);
    if constexpr (!ALIGN_EPI) { if (wr == 0) PG8_BAR; }
    PG8_BAR;
    if constexpr (Epi::AFTER_DRAIN) { E.fused(acc, cur, wr, wc, fr, fq, lds, wid, lane); S.done(cur); }
#undef PG8_SA
#undef PG8_SB
#undef PG8_STAGE
#undef PG8_STAGE_A
#undef PG8_GOFF
#undef PG8_LDA
#undef PG8_LDB
#undef PG8_MMA
#undef PG8_WAIT_V
#undef PG8_WAIT_L
#undef PG8_BAR
#undef PG8_SCHED
}
}

#define XB_TMO      128
#define XB_XCNT(j)  (256  + 64 * (j))
#define XB_XSUB(j)  (1280 + 64 * (j))
#define XB_XGEN(j)  (2304 + 64 * (j))
#define XB_TOP      3328
#define XB_TOPGEN   3392
#define XCD_BAR_WORDS 3456
#define XB_SPIN_CAP (1u << 23)
__device__ __forceinline__ unsigned xb_ld(unsigned* p)              { return __hip_atomic_load(p, __ATOMIC_RELAXED, __HIP_MEMORY_SCOPE_AGENT); }
__device__ __forceinline__ unsigned xb_add(unsigned* p, unsigned v) { return __hip_atomic_fetch_add(p, v, __ATOMIC_RELAXED, __HIP_MEMORY_SCOPE_AGENT); }
__device__ __forceinline__ unsigned xb_xcc_id() { return (unsigned)__builtin_amdgcn_s_getreg((3 << 11) | 20) & 0xFu; }
#define XB_SPIN(cond, bar) do { unsigned _sp = 0; while (cond) { __builtin_amdgcn_s_sleep(1); \
    if ((++_sp & 255u) == 0u) { if (xb_ld(&(bar)[XB_TMO])) break; if (_sp > XB_SPIN_CAP) { atomicAdd(&(bar)[XB_TMO], 1u); break; } } } } while (0)
struct XcdBarrier { unsigned* bar; unsigned x; volatile LAS unsigned* st; };
__device__ __forceinline__ XcdBarrier xcd_barrier_post(unsigned* bar, volatile LAS unsigned* st) {
    XcdBarrier b; b.bar = bar; b.x = xb_xcc_id(); b.st = st;
    if (threadIdx.x == 0) (void)xb_add(&bar[XB_XCNT(b.x)], 1u);
    return b;
}
__device__ __forceinline__ void xcd_barrier_complete(unsigned* bar, unsigned x, unsigned& nloc, unsigned& nx) {
    const unsigned G = gridDim.x * gridDim.y * gridDim.z;
    unsigned sum, cnt, mine, sp = 0u;
    for (;;) {
        sum = 0u; cnt = 0u; mine = 0u;
#pragma unroll
        for (unsigned j = 0; j < 16; ++j) { const unsigned c = xb_ld(&bar[XB_XCNT(j)]); sum += c; cnt += (c > 0u) ? 1u : 0u; mine = (j == x) ? c : mine; }
        if (sum == G) break;
        __builtin_amdgcn_s_sleep(1);
        if ((++sp & 255u) == 0u) { if (xb_ld(&bar[XB_TMO])) break; if (sp > XB_SPIN_CAP) { atomicAdd(&bar[XB_TMO], 1u); break; } }
    }
    nloc = mine > 0u ? mine : 1u; nx = cnt > 0u ? cnt : 1u;
}
__device__ __forceinline__ void xcd_barrier(const XcdBarrier& b) {
    asm volatile("s_waitcnt vmcnt(0)" ::: "memory");
    __syncthreads();
    if (threadIdx.x == 0) {
        unsigned* bar = b.bar;
        __builtin_amdgcn_s_waitcnt(0);
        unsigned nloc = b.st[0], nx = b.st[1];
        if (nloc == 0u) { xcd_barrier_complete(bar, b.x, nloc, nx); b.st[0] = nloc; b.st[1] = nx; }
        const unsigned old = xb_add(&bar[XB_XSUB(b.x)], 1u);
        const unsigned gen = old / nloc;
        if (old + 1u == (gen + 1u) * nloc) {
            __builtin_amdgcn_fence(__ATOMIC_RELEASE, "agent");
            asm volatile("s_waitcnt vmcnt(0)" ::: "memory");
            const unsigned og = xb_add(&bar[XB_TOP], 1u);
            const unsigned tg = og / nx;
            if (og + 1u == (tg + 1u) * nx) xb_add(&bar[XB_TOPGEN], 1u);
            else XB_SPIN(xb_ld(&bar[XB_TOPGEN]) == tg, bar);
            __builtin_amdgcn_fence(__ATOMIC_ACQUIRE, "agent");
            xb_add(&bar[XB_XGEN(b.x)], 1u);
            asm volatile("s_waitcnt vmcnt(0)" ::: "memory");
        } else {
            XB_SPIN(xb_ld(&bar[XB_XGEN(b.x)]) == gen, bar);
            __builtin_amdgcn_fence(__ATOMIC_ACQUIRE, "agent");
            asm volatile("s_waitcnt vmcnt(0)" ::: "memory");
        }
    }
    __syncthreads();
}

constexpr int NWAVES = 8, NTHR = 512;
constexpr int T = 32768, SEQ = 16384, D = 2048, NPROJ = 10752, NEXP = 32, TOPK = 4;
constexpr int C_R = 0, C_K = 1024, C_V = 2048, C_WD = 3072, C_AD = 3168, C_GD = 3264, C_QD = 3584, C_KD = 4608, C_VD = 5632, C_GA = 6656, C_GB = 8704;
constexpr int P_MAX = 131072 + 32 * 256;
constexpr int MAX_TILES = P_MAX / 256;
constexpr float ATT_C2 = 0.125f * 1.4426950408889634f;
constexpr float LAMBDA_INIT = 0.2f;

constexpr size_t MiB = 1u << 20;
constexpr size_t WS_CTL = 0, CTL_ZERO_BYTES = 64 * 1024;
constexpr size_t WS_MOD = 1 * MiB;
constexpr size_t WS_GS2 = WS_MOD + 128 * 1024;
constexpr size_t WS_WRT = WS_GS2 + 32 * 1024;
constexpr size_t WS_WGCNT = WS_WRT + 256 * 1024;
constexpr size_t WS_TILEEXP = WS_WGCNT + 32 * 1024;
constexpr size_t WS_ROPE = 2 * MiB;
constexpr size_t WS_TOPIDX = 3 * MiB;
constexpr size_t WS_TOPW = WS_TOPIDX + 512 * 1024;
constexpr size_t WS_SLOTPOS = 4 * MiB;
constexpr size_t WS_ROWTOK = WS_SLOTPOS + 512 * 1024;
constexpr size_t WS_ROWGATE = WS_ROWTOK + 576 * 1024;
constexpr size_t WS_BONUS = 6 * MiB;
constexpr size_t WS_BTLORA = 8 * MiB;
constexpr size_t WS_ROWSS = 12 * MiB;
constexpr size_t WS_WTIN = 16 * MiB;
constexpr size_t WS_WTBA = 58 * MiB, WS_WTBB = 60 * MiB, WS_WTOUT = 66 * MiB;
constexpr size_t WS_H = 74 * MiB;
constexpr size_t WS_PROJ = 202 * MiB;
constexpr size_t WS_MFRAG = 874 * MiB, WS_NFRAG = 938 * MiB, WS_PBUF = 1002 * MiB, WS_Y0 = 1066 * MiB, WS_SBUF = 1130 * MiB;
constexpr size_t WS_OB = 1194 * MiB, WS_OA = 1258 * MiB;
constexpr size_t WS_MERGED = 1322 * MiB;
constexpr size_t WS_OA8 = WS_MERGED, WS_OB8 = WS_MERGED + 32 * MiB, WS_MERGED8 = WS_MERGED + 64 * MiB;
constexpr size_t WS_VSC = 1194 * MiB;
constexpr size_t WS_MA = 1194 * MiB;
constexpr size_t WS_WTGU = 1450 * MiB;
constexpr size_t WS_WTDN = 1706 * MiB;
constexpr size_t WS_VT = 1834 * MiB;
constexpr size_t WS_QK8 = 1866 * MiB;
constexpr size_t WS_END = 1962 * MiB;
constexpr size_t WS_XS = WS_PROJ;
constexpr size_t WS_YR = WS_PROJ;
constexpr size_t WS_ACT = WS_MFRAG;
constexpr int F8_SW = 7, F8_SH = 4, F8_SA = 2, F8_SV = 4, F8_SQ = 6, F8_SK = 4;
constexpr int F8_SC_GU = (127 - F8_SW - F8_SH) * 0x01010101, F8_SC_DN = (127 - F8_SW - F8_SA) * 0x01010101;
static_assert((size_t)T * NPROJ * 2 <= WS_MFRAG - WS_PROJ && WS_YR + (size_t)P_MAX * 2048 * 2 <= WS_MFRAG && (size_t)P_MAX * 2048 <= WS_WTGU - WS_ACT, "ws map");
constexpr int CW_QUEUE = 4608;
constexpr int CW_BAR = 1024;

constexpr int RING_BYTES = 131072, MISC_OFF = RING_BYTES + 320, LDS_BYTES = 147456;

struct Args { const float* in[36]; float* out; unsigned char* ws; int ph_lo, ph_hi; };
struct Ctx {
    const Args& a;
    LAS unsigned char* lds;
    int tid, lane, wave, G, bid;
    float* out;
    unsigned char* ws;
    DI const float* x() const { return a.in[0]; }
    DI const float* c() const { return a.in[1]; }
    DI const float* w_ada() const { return a.in[2]; }
    DI const float* b_ada() const { return a.in[3]; }
    DI const float* norm1_gain() const { return a.in[4]; }
    DI const float* norm2_gain() const { return a.in[5]; }
    DI const float* w_in() const { return a.in[6]; }
    DI const float* shift_mu() const { return a.in[7]; }
    DI const float* w0() const { return a.in[8]; }
    DI const float* w_decay_up() const { return a.in[9]; }
    DI const float* a0() const { return a.in[10]; }
    DI const float* w_aaa_up() const { return a.in[11]; }
    DI const float* w_gate_up() const { return a.in[12]; }
    DI const float* k_k() const { return a.in[13]; }
    DI const float* k_a() const { return a.in[14]; }
    DI const float* r_k() const { return a.in[15]; }
    DI const float* gn_w() const { return a.in[16]; }
    DI const float* gn_b() const { return a.in[17]; }
    DI const float* q_gain() const { return a.in[18]; }
    DI const float* k_gain() const { return a.in[19]; }
    DI const float* lam_q1() const { return a.in[20]; }
    DI const float* lam_k1() const { return a.in[21]; }
    DI const float* lam_q2() const { return a.in[22]; }
    DI const float* lam_k2() const { return a.in[23]; }
    DI const float* subln_gain() const { return a.in[24]; }
    DI const float* w_branch_a() const { return a.in[25]; }
    DI const float* w_branch_b() const { return a.in[26]; }
    DI const float* w_out() const { return a.in[27]; }
    DI const float* w_router() const { return a.in[28]; }
    DI const float* b_router() const { return a.in[29]; }
    DI const float* w_exp_gate() const { return a.in[30]; }
    DI const float* b_exp_gate() const { return a.in[31]; }
    DI const float* w_exp_up() const { return a.in[32]; }
    DI const float* b_exp_up() const { return a.in[33]; }
    DI const float* w_exp_down() const { return a.in[34]; }
    DI const float* b_exp_down() const { return a.in[35]; }
};
#define WSP(type, off) ((type*)(C.ws + (off)))

DI unsigned pk4_fp8(float a, float b, float c, float d) {
    a = __builtin_amdgcn_fmed3f(a, -448.f, 448.f); b = __builtin_amdgcn_fmed3f(b, -448.f, 448.f); c = __builtin_amdgcn_fmed3f(c, -448.f, 448.f); d = __builtin_amdgcn_fmed3f(d, -448.f, 448.f);
    int p = __builtin_amdgcn_cvt_pk_fp8_f32(a, b, 0, false); p = __builtin_amdgcn_cvt_pk_fp8_f32(c, d, p, true); return (unsigned)p; }
struct EpiPlainBf16 {
    static constexpr bool PERM = true, AFTER_DRAIN = false, HAS_MID = false;
    bf16_t* O; int ldc;
    DI void operator()(const f32x4 (&acc)[2][2][4][2], const pg8::Unit& u, int wr, int wc, int fr, int fq) const {
        const int row0 = u.pm * 256 + wr * 64 + fr, col0 = u.pn * 256 + wc * 32 + 8 * fq;
#pragma unroll
        for (int ai = 0; ai < 2; ++ai)
#pragma unroll
            for (int m = 0; m < 4; ++m) { bf16_t* rowp = O + (size_t)(row0 + ai * 128 + m * 16) * ldc + col0;
#pragma unroll
                for (int bj = 0; bj < 2; ++bj) { const f32x4 v0 = acc[ai][bj][m][0], v1 = acc[ai][bj][m][1];
                    u32x4 w; w.x = pg8::cvt_pk_bf16(v0[0], v0[1]); w.y = pg8::cvt_pk_bf16(v0[2], v0[3]); w.z = pg8::cvt_pk_bf16(v1[0], v1[1]); w.w = pg8::cvt_pk_bf16(v1[2], v1[3]);
                    *(u32x4*)(rowp + bj * 128) = w; } }
    }
};
struct LoraOrder : pg8::StaticOrder {
    DI bool next(int i, pg8::Unit& u) const { if (!pg8::StaticOrder::next(i, u)) return false; if (u.pn >= 8) u.pm += T / 256; return true; }
};
struct EpiLora {
    static constexpr bool PERM = true, AFTER_DRAIN = false, HAS_MID = false;
    bf16_t* G0; const float *w0, *a0;
    DI void operator()(const f32x4 (&acc)[2][2][4][2], const pg8::Unit& u, int wr, int wc, int fr, int fq) const {
        const int sec = u.pn >> 2;
        bf16_t* base = G0 + (size_t)(sec == 2 ? 0 : sec + 1) * ((size_t)T * 1024);
        const int row0 = (u.pm & (T / 256 - 1)) * 256 + wr * 64 + fr, col0 = (u.pn & 3) * 256 + wc * 32 + 8 * fq;
        const float* bias = sec == 0 ? w0 : a0;
#pragma unroll
        for (int bj = 0; bj < 2; ++bj) {
            f32x4 b0 = (f32x4){0.f, 0.f, 0.f, 0.f}, b1 = b0;
            if (sec < 2) { b0 = *(const f32x4*)(bias + col0 + bj * 128); b1 = *(const f32x4*)(bias + col0 + bj * 128 + 4); }
#pragma unroll
            for (int ai = 0; ai < 2; ++ai)
#pragma unroll
                for (int m = 0; m < 4; ++m) {
                    f32x4 v0 = acc[ai][bj][m][0] + b0, v1 = acc[ai][bj][m][1] + b1;
                    if (sec == 0) {
#pragma unroll
                        for (int e = 0; e < 4; ++e) {
                            float z = -v0[e]; float sp = fmaxf(z, 0.f) + __logf(1.f + __expf(-fabsf(z))); v0[e] = -__expf(-sp - 0.5f);
                            z = -v1[e]; sp = fmaxf(z, 0.f) + __logf(1.f + __expf(-fabsf(z))); v1[e] = -__expf(-sp - 0.5f); }
                    } else if (sec == 1) {
#pragma unroll
                        for (int e = 0; e < 4; ++e) { v0[e] = sigmoidf_(v0[e]); v1[e] = sigmoidf_(v1[e]); }
                    }
                    u32x4 w; w.x = pg8::cvt_pk_bf16(v0[0], v0[1]); w.y = pg8::cvt_pk_bf16(v0[2], v0[3]); w.z = pg8::cvt_pk_bf16(v1[0], v1[1]); w.w = pg8::cvt_pk_bf16(v1[2], v1[3]);
                    *(u32x4*)(base + (size_t)(row0 + ai * 128 + m * 16) * 1024 + col0 + bj * 128) = w;
                }
        }
    }
};
struct BranchOrder : pg8::StaticOrder {
    DI bool next(int i, pg8::Unit& u) const { if (!pg8::StaticOrder::next(i >> 1, u)) return false; if (i & 1) { u.pm += T / 256; u.pn += D / 256; } return true; }
    DI bool partial(const pg8::Unit& u) const { return u.pm < T / 256; }
};
struct EpiBranchFused {
    static constexpr bool PERM = true, AFTER_DRAIN = false, HAS_MID = true;
    unsigned char* O8; const bf16_t* proj;
    DI void mid(f32x4 (&acc)[2][2][4][2], const pg8::Unit& u, int wr, int wc, int fr, int fq) const {
        const int row0 = u.pm * 256 + wr * 64 + fr, col0 = u.pn * 256 + wc * 32 + 8 * fq;
#pragma unroll
        for (int ai = 0; ai < 2; ++ai)
#pragma unroll
            for (int m = 0; m < 4; ++m) { const size_t row = (size_t)(row0 + ai * 128 + m * 16);
#pragma unroll
                for (int bj = 0; bj < 2; ++bj) {
                    const u32x4 ga = *(const u32x4*)(proj + row * NPROJ + C_GA + col0 + bj * 128), gb = *(const u32x4*)(proj + row * NPROJ + C_GB + col0 + bj * 128);
                    const unsigned gaw[4] = {ga.x, ga.y, ga.z, ga.w}, gbw[4] = {gb.x, gb.y, gb.z, gb.w};
#pragma unroll
                    for (int q = 0; q < 4; ++q) {
                        const float r0 = (1.f + __expf(-bflo(gbw[q]))) * __builtin_amdgcn_rcpf(1.f + __expf(-bflo(gaw[q]))), r1 = (1.f + __expf(-bfhi(gbw[q]))) * __builtin_amdgcn_rcpf(1.f + __expf(-bfhi(gaw[q])));
                        acc[ai][bj][m][q >> 1][2 * (q & 1)] *= r0; acc[ai][bj][m][q >> 1][2 * (q & 1) + 1] *= r1; } } }
    }
    DI void operator()(const f32x4 (&acc)[2][2][4][2], const pg8::Unit& u, int wr, int wc, int fr, int fq) const {
        const int row0 = (u.pm - T / 256) * 256 + wr * 64 + fr, col0 = (u.pn - D / 256) * 256 + wc * 32 + 8 * fq; const float s_ = (float)(1 << F8_SH);
#pragma unroll
        for (int ai = 0; ai < 2; ++ai) {
            u32x4 gbv[4][2];
#pragma unroll
            for (int m = 0; m < 4; ++m)
#pragma unroll
                for (int bj = 0; bj < 2; ++bj) gbv[m][bj] = *(const u32x4*)(proj + (size_t)(row0 + ai * 128 + m * 16) * NPROJ + C_GB + col0 + bj * 128);
#pragma unroll
            for (int m = 0; m < 4; ++m) { const size_t row = (size_t)(row0 + ai * 128 + m * 16);
#pragma unroll
                for (int bj = 0; bj < 2; ++bj) {
                    const u32x4 gb = gbv[m][bj];
                    f32x4 v0 = acc[ai][bj][m][0], v1 = acc[ai][bj][m][1];
                    v0[0] *= sigmoidf_(bflo(gb.x)) * s_; v0[1] *= sigmoidf_(bfhi(gb.x)) * s_; v0[2] *= sigmoidf_(bflo(gb.y)) * s_; v0[3] *= sigmoidf_(bfhi(gb.y)) * s_;
                    v1[0] *= sigmoidf_(bflo(gb.z)) * s_; v1[1] *= sigmoidf_(bfhi(gb.z)) * s_; v1[2] *= sigmoidf_(bflo(gb.w)) * s_; v1[3] *= sigmoidf_(bfhi(gb.w)) * s_;
                    *(u32x2*)(O8 + row * 2048 + col0 + bj * 128) = (u32x2){pk4_fp8(v0[0], v0[1], v0[2], v0[3]), pk4_fp8(v1[0], v1[1], v1[2], v1[3])}; } }
        }
    }
};
template <bool ADD> struct EpiBranch {
    static constexpr bool PERM = true, AFTER_DRAIN = false, HAS_MID = false;
    bf16_t* MA; unsigned char* O8; const bf16_t* proj; int gcol0;
    DI void operator()(const f32x4 (&acc)[2][2][4][2], const pg8::Unit& u, int wr, int wc, int fr, int fq) const {
        const int row0 = u.pm * 256 + wr * 64 + fr, col0 = u.pn * 256 + wc * 32 + 8 * fq;
#pragma unroll
        for (int ai = 0; ai < 2; ++ai) {
            u32x4 gwv[4][2], pwv[4][2];
#pragma unroll
            for (int m = 0; m < 4; ++m)
#pragma unroll
                for (int bj = 0; bj < 2; ++bj) { const size_t row = (size_t)(row0 + ai * 128 + m * 16);
                    gwv[m][bj] = *(const u32x4*)(proj + row * NPROJ + gcol0 + col0 + bj * 128);
                    if (ADD) pwv[m][bj] = *(const u32x4*)(MA + row * 2048 + col0 + bj * 128); }
#pragma unroll
            for (int m = 0; m < 4; ++m) { const size_t row = (size_t)(row0 + ai * 128 + m * 16);
#pragma unroll
                for (int bj = 0; bj < 2; ++bj) {
                    const u32x4 gw = gwv[m][bj];
                    f32x4 v0 = acc[ai][bj][m][0], v1 = acc[ai][bj][m][1];
                    v0[0] *= sigmoidf_(bflo(gw.x)); v0[1] *= sigmoidf_(bfhi(gw.x)); v0[2] *= sigmoidf_(bflo(gw.y)); v0[3] *= sigmoidf_(bfhi(gw.y));
                    v1[0] *= sigmoidf_(bflo(gw.z)); v1[1] *= sigmoidf_(bfhi(gw.z)); v1[2] *= sigmoidf_(bflo(gw.w)); v1[3] *= sigmoidf_(bfhi(gw.w));
                    if (ADD) { const u32x4 pw = pwv[m][bj]; const float s_ = (float)(1 << F8_SH);
                        v0[0] += bflo(pw.x); v0[1] += bfhi(pw.x); v0[2] += bflo(pw.y); v0[3] += bfhi(pw.y);
                        v1[0] += bflo(pw.z); v1[1] += bfhi(pw.z); v1[2] += bflo(pw.w); v1[3] += bfhi(pw.w);
                        *(u32x2*)(O8 + row * 2048 + col0 + bj * 128) = (u32x2){pk4_fp8(v0[0] * s_, v0[1] * s_, v0[2] * s_, v0[3] * s_), pk4_fp8(v1[0] * s_, v1[1] * s_, v1[2] * s_, v1[3] * s_)};
                    } else {
                        u32x4 w; w.x = pg8::cvt_pk_bf16(v0[0], v0[1]); w.y = pg8::cvt_pk_bf16(v0[2], v0[3]); w.z = pg8::cvt_pk_bf16(v1[0], v1[1]); w.w = pg8::cvt_pk_bf16(v1[2], v1[3]);
                        *(u32x4*)(MA + row * 2048 + col0 + bj * 128) = w; } } }
        }
    }
};
struct EpiOut {
    static constexpr bool PERM = false, AFTER_DRAIN = false, HAS_MID = false;
    float* O; const float* X; const float* mod; float* rowss;
    DI void operator()(const f32x4 (&acc)[2][2][4][2], const pg8::Unit& u, int wr, int wc, int fr, int fq) const {
        const int row0 = u.pm * 256 + wr * 64 + fr, col0 = u.pn * 256 + wc * 32 + 4 * fq;
        const float* g1 = mod + (size_t)((u.pm * 256) / SEQ) * 12288 + 4096;
        f32x4 gv[2][2];
#pragma unroll
        for (int bj = 0; bj < 2; ++bj)
#pragma unroll
            for (int n = 0; n < 2; ++n) gv[bj][n] = *(const f32x4*)(g1 + col0 + bj * 128 + n * 16);
#pragma unroll
        for (int ai = 0; ai < 2; ++ai) {
            f32x4 xv[4][2][2];
#pragma unroll
            for (int m = 0; m < 4; ++m)
#pragma unroll
                for (int bj = 0; bj < 2; ++bj)
#pragma unroll
                    for (int n = 0; n < 2; ++n) xv[m][bj][n] = *(const f32x4*)(X + (size_t)(row0 + ai * 128 + m * 16) * 2048 + col0 + bj * 128 + n * 16);
#pragma unroll
            for (int m = 0; m < 4; ++m) { const size_t ro = (size_t)(row0 + ai * 128 + m * 16) * 2048 + col0; float ss = 0.f;
#pragma unroll
                for (int bj = 0; bj < 2; ++bj)
#pragma unroll
                    for (int n = 0; n < 2; ++n) {
                        const f32x4 ov = xv[m][bj][n] + gv[bj][n] * acc[ai][bj][m][n]; ss += (ov[0] * ov[0] + ov[1] * ov[1]) + (ov[2] * ov[2] + ov[3] * ov[3]);
                        *(f32x4*)(O + ro + bj * 128 + n * 16) = ov; }
                ss = sum_x32(sum_x16(ss));
                if (fq == 0) rowss[(size_t)(row0 + ai * 128 + m * 16) * 32 + u.pn * 4 + wc] = ss; }
        }
    }
};
struct EpiGateUp {
    static constexpr bool PERM = true, AFTER_DRAIN = false, HAS_MID = false;
    unsigned char* ACT; const float *bg, *bu;
    DI void operator()(const f32x4 (&acc)[2][2][4][2], const pg8::Unit& u, int wr, int wc, int fr, int fq) const {
        const int e = u.pn >> 4, ct = u.pn & 15;
        const int row0 = u.pm * 256 + wr * 64 + fr, col0 = ct * 128 + wc * 32 + 8 * fq;
        const f32x4 g0 = *(const f32x4*)(bg + e * 2048 + col0), g1 = *(const f32x4*)(bg + e * 2048 + col0 + 4);
        const f32x4 u0 = *(const f32x4*)(bu + e * 2048 + col0), u1 = *(const f32x4*)(bu + e * 2048 + col0 + 4);
#pragma unroll
        for (int ai = 0; ai < 2; ++ai)
#pragma unroll
            for (int m = 0; m < 4; ++m) {
                f32x4 gt0 = acc[ai][0][m][0] + g0, gt1 = acc[ai][0][m][1] + g1, up0 = acc[ai][1][m][0] + u0, up1 = acc[ai][1][m][1] + u1, r0, r1;
#pragma unroll
                for (int k = 0; k < 4; ++k) {
                    float g = fminf(gt0[k], 7.f), p = __builtin_amdgcn_fmed3f(up0[k], -7.f, 7.f); r0[k] = (p + 1.f) * g * __builtin_amdgcn_rcpf(1.f + __builtin_amdgcn_exp2f(g * (-1.702f * 1.4426950408889634f)));
                    g = fminf(gt1[k], 7.f); p = __builtin_amdgcn_fmed3f(up1[k], -7.f, 7.f); r1[k] = (p + 1.f) * g * __builtin_amdgcn_rcpf(1.f + __builtin_amdgcn_exp2f(g * (-1.702f * 1.4426950408889634f))); }
                const float sa = (float)(1 << F8_SA);
                *(u32x2*)(ACT + (size_t)(row0 + ai * 128 + m * 16) * 2048 + col0) = (u32x2){pk4_fp8(r0[0] * sa, r0[1] * sa, r0[2] * sa, r0[3] * sa), pk4_fp8(r1[0] * sa, r1[1] * sa, r1[2] * sa, r1[3] * sa)};
            }
    }
};
struct EpiDown {
    static constexpr bool PERM = true, AFTER_DRAIN = false, HAS_MID = false;
    bf16_t* Y; const float* bd; const float* row_gate;
    DI void operator()(const f32x4 (&acc)[2][2][4][2], const pg8::Unit& u, int wr, int wc, int fr, int fq) const {
        const int e = u.pn >> 3, ct = u.pn & 7;
        const int row0 = u.pm * 256 + wr * 64 + fr, col0 = ct * 256 + wc * 32 + 8 * fq;
        f32x4 bv[2][2]; float gwv[2][4];
#pragma unroll
        for (int bj = 0; bj < 2; ++bj) { bv[bj][0] = *(const f32x4*)(bd + e * 2048 + col0 + bj * 128); bv[bj][1] = *(const f32x4*)(bd + e * 2048 + col0 + bj * 128 + 4); }
#pragma unroll
        for (int ai = 0; ai < 2; ++ai)
#pragma unroll
            for (int m = 0; m < 4; ++m) gwv[ai][m] = row_gate[row0 + ai * 128 + m * 16];
#pragma unroll
        for (int ai = 0; ai < 2; ++ai)
#pragma unroll
            for (int m = 0; m < 4; ++m) { const int row = row0 + ai * 128 + m * 16; const float gw = gwv[ai][m];
#pragma unroll
                for (int bj = 0; bj < 2; ++bj) {
                    const f32x4 b0 = bv[bj][0], b1 = bv[bj][1];
                    const f32x4 v0 = (acc[ai][bj][m][0] + b0) * gw, v1 = (acc[ai][bj][m][1] + b1) * gw;
                    u32x4 w; w.x = pg8::cvt_pk_bf16(v0[0], v0[1]); w.y = pg8::cvt_pk_bf16(v0[2], v0[3]); w.z = pg8::cvt_pk_bf16(v1[0], v1[1]); w.w = pg8::cvt_pk_bf16(v1[2], v1[3]);
                    *(u32x4*)(Y + (size_t)row * 2048 + col0 + bj * 128) = w; } }
    }
};
struct MoeOrder {
    const int* tile_tab; int NCT, G, c; const int* rowtok;
    DI bool next(int i, pg8::Unit& u) const {
        const int n_tiles = tile_tab[0]; const long L = (long)i * G + c;
        const int RB = 256 / NCT;
        const int blk = (int)(L >> 8), l = (int)(L & 255), x = l >> 5, s = l & 31;
        int rt, ct;
        if (NCT == 16) { rt = blk * RB + 4 * (x >> 1) + (s >> 3); ct = 8 * (x & 1) + (s & 7); }
        else { rt = blk * RB + 4 * x + (s >> 3); ct = s & 7; }
        if (G != 256 || NCT * RB != 256) { if (L >= (long)n_tiles * NCT) return false; rt = (int)(L / NCT); ct = (int)(L % NCT); }
        else if (blk * RB >= n_tiles) return false;
        if (rt >= n_tiles) return false;
        u.pm = rt; u.pn = tile_tab[16 + rt] * NCT + ct; return true;
    }
    DI void a_ready(const pg8::Unit&) const {}
    DI void done(const pg8::Unit&) const {}
};
DI void transpose_item(const float* src, int ld_src, int k0, int n0, bf16_t* dst, int ld_dst, size_t drow0, int dcol0, LAS float* scr, int lane) {
#pragma unroll 8
    for (int i = 0; i < 32; ++i) { const int kk = 2 * i + (lane >> 5); scr[kk * 33 + (lane & 31)] = src[(size_t)(k0 + kk) * ld_src + n0 + (lane & 31)]; }
    asm volatile("s_waitcnt lgkmcnt(0)" ::: "memory");
    const int c = lane & 7;
#pragma unroll
    for (int j = 0; j < 4; ++j) { const int n = (lane >> 3) + 8 * j; const LAS float* s = scr + (8 * c) * 33 + n;
        u32x4 o; o.x = pk2(s[0 * 33], s[1 * 33]); o.y = pk2(s[2 * 33], s[3 * 33]); o.z = pk2(s[4 * 33], s[5 * 33]); o.w = pk2(s[6 * 33], s[7 * 33]);
        *(u32x4*)(dst + (drow0 + n) * (size_t)ld_dst + dcol0 + 8 * c) = o; }
    asm volatile("s_waitcnt lgkmcnt(0)" ::: "memory");
}
DI void transpose_item_f8(const float* src, int ld_src, int k0, int n0, unsigned char* dst, int ld_dst, size_t drow0, int dcol0, LAS float* scr, int lane) {
#pragma unroll 8
    for (int i = 0; i < 32; ++i) { const int kk = 2 * i + (lane >> 5); scr[kk * 33 + (lane & 31)] = src[(size_t)(k0 + kk) * ld_src + n0 + (lane & 31)]; }
    asm volatile("s_waitcnt lgkmcnt(0)" ::: "memory");
    const int c = lane & 7; const float sw = (float)(1 << F8_SW);
#pragma unroll
    for (int j = 0; j < 4; ++j) { const int n = (lane >> 3) + 8 * j; const LAS float* s = scr + (8 * c) * 33 + n;
        const u32x2 o = {pk4_fp8(s[0 * 33] * sw, s[1 * 33] * sw, s[2 * 33] * sw, s[3 * 33] * sw), pk4_fp8(s[4 * 33] * sw, s[5 * 33] * sw, s[6 * 33] * sw, s[7 * 33] * sw)};
        *(u32x2*)(dst + (drow0 + n) * (size_t)ld_dst + dcol0 + 8 * c) = o; }
    asm volatile("s_waitcnt lgkmcnt(0)" ::: "memory");
}
DI void transpose64_f8(const float* src, int ld_src, int k0, int n0, unsigned char* dst, int ld_dst, size_t drow0, int dcol0, int lane) {
    const float* s = src + (size_t)k0 * ld_src + n0 + lane; const float sw = (float)(1 << F8_SW);
    unsigned char* d = dst + (drow0 + lane) * (size_t)ld_dst + dcol0;
    u32x4 o[4];
#pragma unroll
    for (int h = 0; h < 2; ++h) {
        float v[32];
#pragma unroll
        for (int k = 0; k < 32; ++k) v[k] = s[(size_t)(32 * h + k) * ld_src];
#pragma unroll
        for (int q = 0; q < 2; ++q) {
            o[2 * h + q].x = pk4_fp8(v[16 * q + 0] * sw, v[16 * q + 1] * sw, v[16 * q + 2] * sw, v[16 * q + 3] * sw); o[2 * h + q].y = pk4_fp8(v[16 * q + 4] * sw, v[16 * q + 5] * sw, v[16 * q + 6] * sw, v[16 * q + 7] * sw);
            o[2 * h + q].z = pk4_fp8(v[16 * q + 8] * sw, v[16 * q + 9] * sw, v[16 * q + 10] * sw, v[16 * q + 11] * sw); o[2 * h + q].w = pk4_fp8(v[16 * q + 12] * sw, v[16 * q + 13] * sw, v[16 * q + 14] * sw, v[16 * q + 15] * sw); }
        if (h == 0) __builtin_amdgcn_sched_barrier(0);
    }
#pragma unroll
    for (int q = 0; q < 4; ++q) *(u32x4*)(d + 16 * q) = o[q];
}
DI void zero_item_f8(unsigned char* dst, int ld_dst, size_t drow0, int dcol0, int lane) {
    const int c = lane & 7;
#pragma unroll
    for (int j = 0; j < 4; ++j) { const int n = (lane >> 3) + 8 * j; *(u32x2*)(dst + (drow0 + n) * (size_t)ld_dst + dcol0 + 8 * c) = (u32x2){0u, 0u}; }
}
DI void zero_item(bf16_t* dst, int ld_dst, size_t drow0, int dcol0, int lane) {
    const int c = lane & 7;
#pragma unroll
    for (int j = 0; j < 4; ++j) { const int n = (lane >> 3) + 8 * j; *(u32x4*)(dst + (drow0 + n) * (size_t)ld_dst + dcol0 + 8 * c) = (u32x4){0u, 0u, 0u, 0u}; }
}
DI void sincos_d(double x, float& s, float& c) {
    const double n = __builtin_rint(x * 0.63661977236758134308);
    const double r = (x - n * 1.5707963267948966192) - n * 6.123233995736766e-17;
    const double r2 = r * r;
    double sp = -7.647163731819816e-13; sp = sp * r2 + 1.605904383682161e-10; sp = sp * r2 - 2.505210838544172e-08; sp = sp * r2 + 2.755731922398589e-06;
    sp = sp * r2 - 1.984126984126984e-04; sp = sp * r2 + 8.333333333333333e-03; sp = sp * r2 - 1.666666666666667e-01; sp = r + r * r2 * sp;
    double cp = 4.779477332387385e-14; cp = cp * r2 - 1.147074559772972e-11; cp = cp * r2 + 2.087675698786810e-09; cp = cp * r2 - 2.755731922398589e-07;
    cp = cp * r2 + 2.480158730158730e-05; cp = cp * r2 - 1.388888888888889e-03; cp = cp * r2 + 4.166666666666666e-02; cp = cp * r2 - 0.5; cp = 1.0 + r2 * cp;
    const int q = ((int)n) & 3;
    const double ss = (q == 0) ? sp : (q == 1) ? cp : (q == 2) ? -sp : -cp;
    const double cc = (q == 0) ? cp : (q == 1) ? -sp : (q == 2) ? -cp : sp;
    s = (float)ss; c = (float)cc;
}
DI void phase_prologue(Ctx& C) {
    const int gw = C.bid * NWAVES + C.wave, NGW = C.G * NWAVES;
    const int gt = C.bid * NTHR + C.tid, NGT = C.G * NTHR;
    {
        LAS float* sc = (LAS float*)(C.lds + 70000);
        LAS float* red = (LAS float*)(C.lds + 90000);
        for (int i = C.tid; i < 4096; i += NTHR) { const float v = C.c()[i]; sc[i] = v / (1.f + __expf(-v)); }
        __syncthreads();
        float* mod = WSP(float, WS_MOD);
        for (int cb = C.bid; cb < 256; cb += C.G) {
            const int j0 = cb * 48;
            if (C.tid < 504) {
                const int cq = C.tid % 12, kg = C.tid / 12;
                f32x4 a0 = (f32x4){0.f, 0.f, 0.f, 0.f}, a1 = a0;
#pragma clang loop unroll(disable)
                for (int kb = 0; kb < 52; kb += 13) {
                    f32x4 wv[13];
#pragma unroll
                    for (int u = 0; u < 13; ++u) { const int kk = kg + 42 * (kb + u), kc = kk < 2048 ? kk : 2047; wv[u] = *(const f32x4*)(C.w_ada() + (size_t)kc * 12288 + j0 + 4 * cq); }
#pragma unroll
                    for (int u = 0; u < 13; ++u) { const int kk = kg + 42 * (kb + u); const bool ok = kk < 2048; const int kc = ok ? kk : 2047; const float c0 = ok ? sc[kc] : 0.f, c1 = ok ? sc[2048 + kc] : 0.f; a0 += wv[u] * c0; a1 += wv[u] * c1; }
                }
                LAS float* r = red + (kg * 12 + cq) * 8;
                r[0] = a0[0]; r[1] = a0[1]; r[2] = a0[2]; r[3] = a0[3]; r[4] = a1[0]; r[5] = a1[1]; r[6] = a1[2]; r[7] = a1[3];
            }
            __syncthreads();
            if (C.tid < 96) { const int b = C.tid / 48, j = C.tid % 48, cq = j >> 2, e = j & 3; float s = 0.f;
                for (int kg = 0; kg < 42; ++kg) s += red[(kg * 12 + cq) * 8 + b * 4 + e];
                mod[b * 12288 + j0 + j] = s + C.b_ada()[j0 + j]; }
            __syncthreads();
        }
    }
    {
        f32x2* rope = WSP(f32x2, WS_ROPE);
        for (int i = gt; i < SEQ * 8; i += NGT) { const int pos = i >> 3, fi = i & 7;
            const float invf = fi == 0 ? 1.0f : fi == 1 ? 0.1939227432012558f : fi == 2 ? 0.03760603070259094f : fi == 3 ? 0.007292664609849453f :
                               fi == 4 ? 0.0014142135623842478f : fi == 5 ? 0.00027424818836152554f : fi == 6 ? 5.3182957344688475e-05f : 1.0313385246263351e-05f;
            const float ang = (float)pos * invf; float s, c; sincos_d((double)ang, s, c); rope[i] = (f32x2){c, s}; }
    }
    {
        bf16_t* bl = WSP(bf16_t, WS_BTLORA);
        for (int i = gt; i < 3072 * 256; i += NGT) { const int n = i >> 8, k = i & 255; float v = 0.f;
            if (n < 1024) { if (k < 96) v = C.w_decay_up()[k * 1024 + n]; }
            else if (n < 2048) { if (k >= 128 && k < 224) v = C.w_aaa_up()[(k - 128) * 1024 + (n - 1024)]; }
            else v = C.w_gate_up()[k * 1024 + (n - 2048)];
            bl[i] = (bf16_t)f2bf(v); }
        bf16_t* wr = WSP(bf16_t, WS_WRT);
        for (int i = gt; i < 32 * 2048; i += NGT) { const int e = i >> 11, k = i & 2047; const float v = C.w_router()[k * 32 + e];
            const unsigned h = f2bf(v); wr[i] = (bf16_t)h; wr[65536 + i] = (bf16_t)f2bf(v - bf2f(h)); }
    }
    {
        LAS float* scr = (LAS float*)(C.lds + C.wave * 8448);
        constexpr int I_IN = 32 * 336, I_GU = 32 * 32 * 32  , I_BR = 16 * 64, I_OUT = 32 * 64;
        constexpr int NITEMS = I_IN + 3 * I_GU + 2 * I_BR + I_OUT;
        unsigned char* wtin = WSP(unsigned char, WS_WTIN); unsigned char* wtgu = WSP(unsigned char, WS_WTGU); unsigned char* wtdn = WSP(unsigned char, WS_WTDN);
        for (int it = gw; it < NITEMS; it += NGW) {
            int r = it;
            if (r < I_IN) { const int kb = r / 336, nb = r % 336;
                if (nb == 110 || nb == 111) zero_item_f8(wtin, 2048, (size_t)nb * 32, kb * 64, C.lane);
                else transpose_item_f8(C.w_in(), 10688, kb * 64, (nb < 110 ? nb : nb - 2) * 32, wtin, 2048, (size_t)nb * 32, kb * 64, scr, C.lane);
                continue; } r -= I_IN;
            if (r < 3 * I_GU) { const int which = r / I_GU; r %= I_GU; const int e = r >> 10, kb = (r >> 5) & 31, nb = r & 31, n0 = nb * 64;
                if (which < 2) transpose64_f8((which ? C.w_exp_up() : C.w_exp_gate()) + (size_t)e * 2048 * 2048, 2048, kb * 64, n0, wtgu, 2048, (size_t)e * 4096 + (n0 >> 7) * 256 + which * 128 + (n0 & 127), kb * 64, C.lane);
                else transpose64_f8(C.w_exp_down() + (size_t)e * 2048 * 2048, 2048, kb * 64, n0, wtdn, 2048, (size_t)e * 2048 + n0, kb * 64, C.lane);
                continue; } r -= 3 * I_GU;
            if (r < I_BR) { transpose_item_f8(C.w_branch_a(), 2048, (r >> 6) * 64, (r & 63) * 32, WSP(unsigned char, WS_WTBA), 1024, (size_t)(r & 63) * 32, (r >> 6) * 64, scr, C.lane); continue; } r -= I_BR;
            if (r < I_BR) { transpose_item_f8(C.w_branch_b(), 2048, (r >> 6) * 64, (r & 63) * 32, WSP(unsigned char, WS_WTBB), 1024, (size_t)(r & 63) * 32, (r >> 6) * 64, scr, C.lane); continue; } r -= I_BR;
            transpose_item_f8(C.w_out(), 2048, (r >> 6) * 64, (r & 63) * 32, WSP(unsigned char, WS_WTOUT), 2048, (size_t)(r & 63) * 32, (r >> 6) * 64, scr, C.lane);
        }
    }
}
DI void phase_norm1(Ctx& C) {
    const int gw = C.bid * NWAVES + C.wave, NGW = C.G * NWAVES;
    const float* mod = WSP(float, WS_MOD);
    if (C.bid == 0) {
        float* gs2 = WSP(float, WS_GS2);
        for (int i = C.tid; i < 4096; i += NTHR) { const int b = i >> 11, k = i & 2047; gs2[i] = C.norm2_gain()[k] * (1.f + mod[b * 12288 + 4 * 2048 + k]); }
    }
    unsigned char* H = WSP(unsigned char, WS_H);
    for (int rb = gw; rb < T / 16; rb += NGW) {
        const int b = (rb * 16) / SEQ;
        f32x4 gs[8], sh[8];
#pragma unroll
        for (int j = 0; j < 8; ++j) { const int k = 4 * C.lane + 256 * j;
            const f32x4 g = *(const f32x4*)(C.norm1_gain() + k), s = *(const f32x4*)(mod + b * 12288 + 2048 + k);
            gs[j] = g * (s + 1.f); sh[j] = *(const f32x4*)(mod + b * 12288 + k); }
        for (int i = 0; i < 16; ++i) {
            const size_t row = (size_t)rb * 16 + i;
            const f32x4* xr = (const f32x4*)(C.x() + row * D) + C.lane;
            f32x4 v[8]; float s = 0.f;
#pragma unroll
            for (int j = 0; j < 8; ++j) { v[j] = xr[64 * j]; s += (v[j][0] * v[j][0] + v[j][1] * v[j][1]) + (v[j][2] * v[j][2] + v[j][3] * v[j][3]); }
            const float rstd = 1.f / sqrtf(wave_sum(s) * (1.f / D) + 1e-6f);
            unsigned* o4 = (unsigned*)(H + row * D) + C.lane; const float sc_ = (float)(1 << F8_SH);
#pragma unroll
            for (int j = 0; j < 8; ++j) { const f32x4 y = (v[j] * rstd * gs[j] + sh[j]) * sc_; o4[64 * j] = pk4_fp8(y[0], y[1], y[2], y[3]); }
        }
    }
}


DI bf16x8 pack_step(const f32x16& x, int s) {
    u32x4 p; p.x = cvtpk(x[8 * s], x[8 * s + 1]); p.y = cvtpk(x[8 * s + 2], x[8 * s + 3]); p.z = cvtpk(x[8 * s + 4], x[8 * s + 5]); p.w = cvtpk(x[8 * s + 6], x[8 * s + 7]);
    return __builtin_bit_cast(bf16x8, p);
}

DI void phase_prep(Ctx& C) {
    const int gw = C.bid * NWAVES + C.wave, NGW = C.G * NWAVES;
    bf16_t* proj = WSP(bf16_t, WS_PROJ); bf16_t* lin = WSP(bf16_t, WS_OB);
    const f32x2* rope = WSP(f32x2, WS_ROPE);
    {   unsigned char* vt = WSP(unsigned char, WS_VT); const float sv = (float)(1 << F8_SV);
        for (int task = gw; task < 16 * 256; task += NGW) {
            const int bh = task >> 8, kt = task & 255; const size_t row0 = (size_t)(bh >> 3) * SEQ + (size_t)kt * 64;
            const bf16_t* vp = proj + row0 * NPROJ + C_VD + (bh & 7) * 128 + 2 * C.lane;
            unsigned kv[64];
#pragma unroll
            for (int k = 0; k < 64; ++k) kv[k] = *(const unsigned*)(vp + (size_t)k * NPROJ);
            u32x4 o0[4], o1[4];
#pragma unroll
            for (int i = 0; i < 16; ++i) { const int k0 = 8 * (i & 3) + 4 * (i >> 3) + 32 * ((i >> 2) & 1);
                const unsigned a = pk4_fp8(bflo(kv[k0]) * sv, bflo(kv[k0 + 1]) * sv, bflo(kv[k0 + 2]) * sv, bflo(kv[k0 + 3]) * sv), b = pk4_fp8(bfhi(kv[k0]) * sv, bfhi(kv[k0 + 1]) * sv, bfhi(kv[k0 + 2]) * sv, bfhi(kv[k0 + 3]) * sv);
                o0[i >> 2][i & 3] = a; o1[i >> 2][i & 3] = b; }
            unsigned char* dst = vt + ((size_t)task * 128 + 2 * C.lane) * 64;
#pragma unroll
            for (int q = 0; q < 4; ++q) { *(u32x4*)(dst + 16 * q) = o0[q]; *(u32x4*)(dst + 64 + 16 * q) = o1[q]; }
        }
    }
    for (int t = gw; t < T; t += NGW) {
        const int pos = t % SEQ;
        const bf16_t* pr = proj + (size_t)t * NPROJ; const bf16_t* pp = pr - NPROJ;
        {
            const int l = C.lane; u32x4 o = {0u, 0u, 0u, 0u}; int j0;
            if (l < 56) {
                const int col = C_WD + 8 * l; const int kind = l < 12 ? 1 : (l < 24 ? 2 : 3);
                j0 = l < 12 ? 8 * l : (l < 24 ? 128 + 8 * (l - 12) : 256 + 8 * (l - 24));
                const u32x4 cw = *(const u32x4*)(pr + col); u32x4 pw = {0u, 0u, 0u, 0u}; if (pos > 0) pw = *(const u32x4*)(pp + col);
                const f32x4 m0 = *(const f32x4*)(C.shift_mu() + col), m1 = *(const f32x4*)(C.shift_mu() + col + 4);
                const float cv[8] = {bflo(cw.x), bfhi(cw.x), bflo(cw.y), bfhi(cw.y), bflo(cw.z), bfhi(cw.z), bflo(cw.w), bfhi(cw.w)};
                const float pv[8] = {bflo(pw.x), bfhi(pw.x), bflo(pw.y), bfhi(pw.y), bflo(pw.z), bfhi(pw.z), bflo(pw.w), bfhi(pw.w)};
                const float mu[8] = {m0[0], m0[1], m0[2], m0[3], m1[0], m1[1], m1[2], m1[3]};
                float r[8];
#pragma unroll
                for (int e = 0; e < 8; ++e) { const float sft = cv[e] + (pv[e] - cv[e]) * mu[e];
                    r[e] = kind == 1 ? (1.f - 2.f * __builtin_amdgcn_rcpf(__expf(2.f * sft) + 1.f)) : (kind == 2 ? sft : sigmoidf_(sft)); }
                o = (u32x4){cvtpk(r[0], r[1]), cvtpk(r[2], r[3]), cvtpk(r[4], r[5]), cvtpk(r[6], r[7])};
            } else { j0 = l < 60 ? 96 + 8 * (l - 56) : 224 + 8 * (l - 60); }
            *(u32x4*)(lin + (j0 < 256 ? (size_t)t * 256 + j0 : (size_t)T * 256 + (size_t)t * 256 + (j0 - 256))) = o;
        }
        {
            const int g = C.lane >> 1, half = C.lane & 1;
            bf16_t* gp = proj + (size_t)t * NPROJ + C_QD + g * 64 + half * 32;
            u32x4 w[4]; float v[32];
#pragma unroll
            for (int i = 0; i < 4; ++i) w[i] = *(const u32x4*)(gp + 8 * i);
            float ss = 0.f;
#pragma unroll
            for (int i = 0; i < 4; ++i) { v[8 * i + 0] = bflo(w[i].x); v[8 * i + 1] = bfhi(w[i].x); v[8 * i + 2] = bflo(w[i].y); v[8 * i + 3] = bfhi(w[i].y);
                v[8 * i + 4] = bflo(w[i].z); v[8 * i + 5] = bfhi(w[i].z); v[8 * i + 6] = bflo(w[i].w); v[8 * i + 7] = bfhi(w[i].w); }
#pragma unroll
            for (int d = 0; d < 32; ++d) ss += v[d] * v[d];
            ss += DPPF(ss, 0xB1);
            const float rstd = 1.f / sqrtf(ss * (1.f / 64.f) + 1e-6f);
            const float* gain = (g < 16 ? C.q_gain() : C.k_gain()) + half * 32;
#pragma unroll
            for (int d = 0; d < 32; ++d) v[d] = v[d] * rstd * gain[d];
            if (half == 0) {
#pragma unroll
                for (int i = 0; i < 8; ++i) { const f32x2 cs = rope[pos * 8 + i]; const float x1 = v[i], x2 = v[i + 8]; v[i] = x1 * cs[0] - x2 * cs[1]; v[i + 8] = x2 * cs[0] + x1 * cs[1]; }
            }
            const float sc = g < 16 ? ATT_C2 * (float)(1 << F8_SQ) : (float)(1 << F8_SK);
            unsigned char* q8 = WSP(unsigned char, WS_QK8) + (size_t)t * 2048 + g * 64 + half * 32;
#pragma unroll
            for (int i = 0; i < 2; ++i) { u32x4 o;
                o.x = pk4_fp8(v[16 * i] * sc, v[16 * i + 1] * sc, v[16 * i + 2] * sc, v[16 * i + 3] * sc); o.y = pk4_fp8(v[16 * i + 4] * sc, v[16 * i + 5] * sc, v[16 * i + 6] * sc, v[16 * i + 7] * sc);
                o.z = pk4_fp8(v[16 * i + 8] * sc, v[16 * i + 9] * sc, v[16 * i + 10] * sc, v[16 * i + 11] * sc); o.w = pk4_fp8(v[16 * i + 12] * sc, v[16 * i + 13] * sc, v[16 * i + 14] * sc, v[16 * i + 15] * sc);
                *(u32x4*)(q8 + 16 * i) = o; }
        }
    }
}

constexpr int RS = 72, MATB = 64 * RS * 2;
constexpr int L_TCA = 0, L_TCR = MATB, L_TCB = 2 * MATB, L_TCK = 3 * MATB, L_CTA = 4 * MATB, L_CTV = 5 * MATB, L_CTBH = 6 * MATB, L_CTKH = 7 * MATB,
              L_AK = 8 * MATB, L_RB = 9 * MATB, L_RK = 10 * MATB, L_T = 11 * MATB, L_F = 12 * MATB, L_GT = L_F + 64 * 68 * 4, L_GL = L_GT + 2048;
constexpr int L_XCT = L_TCA, L_U0CT = L_TCB, L_WCT = L_TCK;
constexpr int L_RAW = L_AK;
constexpr int RAW_RKV = 65 * 128, RAW_LW = 3 * RAW_RKV, RAW_A = RAW_LW + 64 * 128;
static_assert(L_RAW + RAW_A + 64 * 128 <= L_GT, "R1 raw buffer");
static_assert(L_GL + 256 <= RING_BYTES, "R1 LDS map");
DI f32x16 mm_tile(const LAS bf16_t* A, const LAS bf16_t* B, int arow0, int brow0, int r32, int hi, f32x16 acc) {
#pragma unroll
    for (int s = 0; s < 4; ++s) {
        const bf16x8 a = *(const LAS bf16x8*)(A + (arow0 + r32) * RS + 16 * s + 8 * hi);
        const bf16x8 b = *(const LAS bf16x8*)(B + (brow0 + r32) * RS + 16 * s + 8 * hi);
        acc = MFMA32(a, b, acc);
    }
    return acc;
}
DI void store_tile_T(LAS bf16_t* M, const f32x16& c, int row0, int col, int hi) {
#pragma unroll
    for (int g = 0; g < 4; ++g) { const int r = row0 + 8 * g + 4 * hi;
        *(LAS u32x2*)(M + col * RS + r) = (u32x2){cvtpk(c[4 * g], c[4 * g + 1]), cvtpk(c[4 * g + 2], c[4 * g + 3])}; }
}
DI void phase_r1(Ctx& C) {
    const bf16_t* proj = WSP(bf16_t, WS_PROJ);
    const bf16_t* LW = WSP(bf16_t, WS_MERGED); const bf16_t* AA = LW + (size_t)T * 1024;
    float* bonus = WSP(float, WS_BONUS);
    u32x4* mfrag = WSP(u32x4, WS_MFRAG); u32x4* nfrag = WSP(u32x4, WS_NFRAG);
    bf16_t* pbuf = WSP(bf16_t, WS_PBUF); bf16_t* y0buf = WSP(bf16_t, WS_Y0);
    LAS unsigned char* L = C.lds;
    const int lane = C.lane, w = C.wave, r32 = lane & 31, hi = lane >> 5;
    u32x4 raw[6];
#define R1_LOAD(item_) do { const int cg_ = (item_) >> 4, h_ = (item_) & 15; const size_t tk_ = (size_t)cg_ * 64 + (C.tid >> 3); const int cc_ = (C.tid & 7) * 8; \
        const bf16_t* pr_ = proj + tk_ * NPROJ + h_ * 64 + cc_; \
        raw[0] = *(const u32x4*)(pr_ + C_R); raw[1] = *(const u32x4*)(pr_ + C_K); raw[2] = *(const u32x4*)(pr_ + C_V); \
        raw[3] = *(const u32x4*)(LW + tk_ * 1024 + h_ * 64 + cc_); raw[4] = *(const u32x4*)(AA + tk_ * 1024 + h_ * 64 + cc_); \
        raw[5] = (u32x4){0u, 0u, 0u, 0u}; \
        if (C.tid < 24 && (cg_ & 255) != 0) raw[5] = *(const u32x4*)(proj + ((size_t)cg_ * 64 - 1) * NPROJ + (C.tid >> 3) * 1024 + h_ * 64 + cc_); } while (0)
    if (C.bid < 8192) R1_LOAD(C.bid);
    for (int item = C.bid; item < 8192; item += C.G) {
        const int cg = item >> 4, h = item & 15, b = cg >> 8, cidx = cg & 255;
        const int ch = (b * 16 + h) * 256 + cidx; const size_t tok0 = (size_t)cg * 64;
        {
            const int t_ = C.tid >> 3, cb_ = (C.tid & 7) * 16;
            *(LAS u32x4*)(L + L_RAW + 0 * RAW_RKV + (t_ + 1) * 128 + cb_) = raw[0]; *(LAS u32x4*)(L + L_RAW + 1 * RAW_RKV + (t_ + 1) * 128 + cb_) = raw[1];
            *(LAS u32x4*)(L + L_RAW + 2 * RAW_RKV + (t_ + 1) * 128 + cb_) = raw[2];
            *(LAS u32x4*)(L + L_RAW + RAW_LW + t_ * 128 + cb_) = raw[3]; *(LAS u32x4*)(L + L_RAW + RAW_A + t_ * 128 + cb_) = raw[4];
            if (C.tid < 24) *(LAS u32x4*)(L + L_RAW + (C.tid >> 3) * RAW_RKV + cb_) = raw[5];
            LDS_BARRIER();
            if (item + C.G < 8192) R1_LOAD(item + C.G);
        }
        {
            const int c = lane, hc = h * 64 + c;
            const float mur = C.shift_mu()[C_R + hc], muk = C.shift_mu()[C_K + hc], muv = C.shift_mu()[C_V + hc];
            const float kkc = C.k_k()[hc], kac = C.k_a()[hc], rkc = C.r_k()[hc];
            const size_t t0 = tok0 + 8 * w;
            const LAS bf16_t* RW = (const LAS bf16_t*)(L + L_RAW);
            float rp = bf2f(RW[(0 * RAW_RKV) / 2 + (8 * w) * 64 + c]), kp = bf2f(RW[(1 * RAW_RKV) / 2 + (8 * w) * 64 + c]), vp = bf2f(RW[(2 * RAW_RKV) / 2 + (8 * w) * 64 + c]);
            float rs[8], km[8], vs[8], kk[8], av[8], cum[8], lwv[8];
            float run = 0.f;
#pragma unroll
            for (int i = 0; i < 8; ++i) {
                const int tr_ = (8 * w + i + 1) * 64 + c;
                const float r = bf2f(RW[(0 * RAW_RKV) / 2 + tr_]), k = bf2f(RW[(1 * RAW_RKV) / 2 + tr_]), v = bf2f(RW[(2 * RAW_RKV) / 2 + tr_]);
                rs[i] = r + (rp - r) * mur; const float ks = k + (kp - k) * muk; vs[i] = v + (vp - v) * muv; rp = r; kp = k; vp = v;
                lwv[i] = bf2f(RW[RAW_LW / 2 + (8 * w + i) * 64 + c]); av[i] = bf2f(RW[RAW_A / 2 + (8 * w + i) * 64 + c]);
                float q = ks * kkc; const float ss = wave_sum(q * q); q = q * __builtin_amdgcn_rsqf(fmaxf(ss, 1e-24f)); kk[i] = q;
                km[i] = ks * (1.f + (av[i] - 1.f) * kac);
                const float bs = wave_sum(rs[i] * km[i] * rkc);
                if (lane == 0) bonus[(t0 + i) * 16 + h] = bs;
                run += lwv[i]; cum[i] = run;
            }
            LAS float* GT = (LAS float*)(L + L_GT); LAS float* GL = (LAS float*)(L + L_GL);
            GT[w * 64 + c] = run;
            LDS_BARRIER();
            float off = 0.f, tot = 0.f;
#pragma unroll
            for (int g = 0; g < 8; ++g) { const float x = GT[g * 64 + c]; tot += x; off += (g < w) ? x : 0.f; }
            if (w == 0) GL[c] = __expf(tot);
            u32x4 cta, ctv, ctbh, ctkh; unsigned* pa = (unsigned*)&cta; unsigned* pv = (unsigned*)&ctv; unsigned* pb = (unsigned*)&ctbh; unsigned* pk = (unsigned*)&ctkh;
            float at[8], bh[8], kh[8];
            LAS bf16_t* TCA = (LAS bf16_t*)(L + L_TCA); LAS bf16_t* TCR = (LAS bf16_t*)(L + L_TCR); LAS bf16_t* TCB = (LAS bf16_t*)(L + L_TCB); LAS bf16_t* TCK = (LAS bf16_t*)(L + L_TCK);
#pragma unroll
            for (int i = 0; i < 8; ++i) {
                const float cm = off + cum[i];
                const float epos = __expf(cm), eneg = __expf(-cm), eprev = __expf(cm - lwv[i]), ratio = __expf(tot - cm);
                const float ka = kk[i] * av[i];
                at[i] = -kk[i] * eprev; bh[i] = ka * ratio; kh[i] = km[i] * ratio;
                const int t = 8 * w + i;
                TCA[t * RS + c] = (bf16_t)f2bf(at[i]); TCR[t * RS + c] = (bf16_t)f2bf(rs[i] * epos); TCB[t * RS + c] = (bf16_t)f2bf(ka * eneg); TCK[t * RS + c] = (bf16_t)f2bf(km[i] * eneg);
            }
#pragma unroll
            for (int i = 0; i < 4; ++i) { pa[i] = pk2(at[2 * i], at[2 * i + 1]); pv[i] = pk2(vs[2 * i], vs[2 * i + 1]); pb[i] = pk2(bh[2 * i], bh[2 * i + 1]); pk[i] = pk2(kh[2 * i], kh[2 * i + 1]); }
            *(LAS u32x4*)(L + L_CTA + (c * RS + 8 * w) * 2) = cta; *(LAS u32x4*)(L + L_CTV + (c * RS + 8 * w) * 2) = ctv;
            *(LAS u32x4*)(L + L_CTBH + (c * RS + 8 * w) * 2) = ctbh; *(LAS u32x4*)(L + L_CTKH + (c * RS + 8 * w) * 2) = ctkh;
        }
        LDS_BARRIER();
        {
            const int p = w >> 1, it = w & 1;
            const LAS bf16_t* Y = (const LAS bf16_t*)(L + ((p & 1) ? L_TCK : L_TCB));
            const LAS bf16_t* X = (const LAS bf16_t*)(L + ((p & 2) ? L_TCR : L_TCA));
            const int t = 32 * it + r32;
#pragma unroll
            for (int jt = 0; jt < 2; ++jt) {
                f32x16 c = {};
                c = mm_tile(Y, X, 32 * jt, 32 * it, r32, hi, c);
#pragma unroll
                for (int r = 0; r < 16; ++r) { const int j = 32 * jt + crow(r, hi); const bool keep = (p < 2) ? (j < t) : (j <= t); c[r] = keep ? c[r] : 0.f; }
                if (p == 0) {
                    LAS float* F = (LAS float*)(L + L_F);
#pragma unroll
                    for (int g = 0; g < 4; ++g) *(LAS f32x4*)(F + t * 68 + 32 * jt + 8 * g + 4 * hi) = (f32x4){c[4 * g], c[4 * g + 1], c[4 * g + 2], c[4 * g + 3]};
                } else {
                    LAS bf16_t* Mo = (LAS bf16_t*)(L + (p == 1 ? L_AK : (p == 2 ? L_RB : L_RK)));
                    store_tile_T(Mo, c, 32 * jt, t, hi);
                }
            }
        }
        LDS_BARRIER();
        {
            const int blk = C.tid >> 8, j = (C.tid >> 3) & 31, p = C.tid & 7, o = 32 * blk;
            const LAS float* F = (const LAS float*)(L + L_F);
            float Tr[4];
#pragma unroll
            for (int q = 0; q < 4; ++q) Tr[q] = 0.f;
#pragma unroll
            for (int tq = 0; tq < 4; ++tq) {
#pragma unroll
                for (int tp = 0; tp < 8; ++tp) {
                    const int t = 8 * tq + tp; float part = 0.f;
#pragma unroll
                    for (int q = 0; q <= tq; ++q) part += F[(o + t) * 68 + o + 8 * q + p] * Tr[q];
                    part = sum8_dpp(part);
                    const float val = part + ((t == j) ? 1.f : 0.f);
                    if (p == tp) Tr[tq] = val;
                }
            }
            LAS bf16_t* Tm = (LAS bf16_t*)(L + L_T); LAS bf16_t* TT = (LAS bf16_t*)(L + L_TCA); LAS bf16_t* Abf = (LAS bf16_t*)(L + L_TCB);
#pragma unroll
            for (int q = 0; q < 4; ++q) { const bf16_t tv = (bf16_t)f2bf(Tr[q]);
                Tm[(o + 8 * q + p) * RS + o + j] = tv; TT[(o + j) * RS + o + 8 * q + p] = tv;
                if (blk == 0) Tm[(8 * q + p) * RS + 32 + j] = 0; }
            { const int t = 32 + (C.tid >> 4), k = 2 * (C.tid & 15);
              *(LAS unsigned*)(Abf + t * RS + k) = cvtpk(F[t * 68 + k], F[t * 68 + k + 1]); }
        }
        LDS_BARRIER();
        if (w == 0) {
            LAS bf16_t* Tm = (LAS bf16_t*)(L + L_T); const LAS bf16_t* TT = (const LAS bf16_t*)(L + L_TCA); const LAS bf16_t* Abf = (const LAS bf16_t*)(L + L_TCB); LAS bf16_t* XT = (LAS bf16_t*)(L + L_TCK);
            f32x16 c = {};
#pragma unroll
            for (int s = 0; s < 2; ++s) c = MFMA32(*(const LAS bf16x8*)(Abf + (32 + r32) * RS + 16 * s + 8 * hi), *(const LAS bf16x8*)(TT + r32 * RS + 16 * s + 8 * hi), c);
            store_tile_T(XT, c, 32, r32, hi);
            asm volatile("s_waitcnt lgkmcnt(0)" ::: "memory");
            f32x16 d = {};
#pragma unroll
            for (int s = 2; s < 4; ++s) d = MFMA32(*(const LAS bf16x8*)(Tm + (32 + r32) * RS + 16 * s + 8 * hi), *(const LAS bf16x8*)(XT + r32 * RS + 16 * s + 8 * hi), d);
#pragma unroll
            for (int r = 0; r < 16; ++r) Tm[(32 + crow(r, hi)) * RS + r32] = (bf16_t)f2bf(d[r]);
        }
        LDS_BARRIER();
        {
            const int prod = w >> 2, tt = (w >> 1) & 1, ct = w & 1;
            const LAS bf16_t* A = (const LAS bf16_t*)(L + (prod ? L_AK : L_T));
            const LAS bf16_t* B = (const LAS bf16_t*)(L + (prod ? L_CTV : L_CTA));
            f32x16 c = {}; c = mm_tile(A, B, 32 * tt, 32 * ct, r32, hi, c);
            store_tile_T((LAS bf16_t*)(L + (prod ? L_XCT : L_WCT)), c, 32 * tt, 32 * ct + r32, hi);
        }
        LDS_BARRIER();
        if (w < 4) {
            const int tt = w >> 1, vt = w & 1;
            f32x16 c = {}; c = mm_tile((const LAS bf16_t*)(L + L_T), (const LAS bf16_t*)(L + L_XCT), 32 * tt, 32 * vt, r32, hi, c);
            store_tile_T((LAS bf16_t*)(L + L_U0CT), c, 32 * tt, 32 * vt + r32, hi);
        } else {
            const int kt = (w >> 1) & 1, it = w & 1;
            f32x16 c = {}; c = mm_tile((const LAS bf16_t*)(L + L_WCT), (const LAS bf16_t*)(L + L_CTBH), 32 * kt, 32 * it, r32, hi, c);
            const float gl = ((const LAS float*)(L + L_GL))[32 * it + r32];
#pragma unroll
            for (int r = 0; r < 16; ++r) if (32 * kt + crow(r, hi) == 32 * it + r32) c[r] += gl;
            u32x4* dst = mfrag + ((size_t)(ch * 4 + kt * 2 + it) * 2) * 64 + lane;
            dst[0] = __builtin_bit_cast(u32x4, pack_step(c, 0)); dst[64] = __builtin_bit_cast(u32x4, pack_step(c, 1));
        }
        LDS_BARRIER();
        if (w < 4) {
            {   const int it = w >> 1, vt = w & 1;
                f32x16 c = {};
                c = mm_tile((const LAS bf16_t*)(L + L_CTBH), (const LAS bf16_t*)(L + L_U0CT), 32 * it, 32 * vt, r32, hi, c);
                c = mm_tile((const LAS bf16_t*)(L + L_CTKH), (const LAS bf16_t*)(L + L_CTV), 32 * it, 32 * vt, r32, hi, c);
                u32x4* dst = nfrag + ((size_t)(ch * 4 + it * 2 + vt) * 2) * 64 + lane;
                dst[0] = __builtin_bit_cast(u32x4, pack_step(c, 0)); dst[64] = __builtin_bit_cast(u32x4, pack_step(c, 1)); }
            {   const int kt = w >> 1, tt = w & 1, t = 32 * tt + r32;
                f32x16 c = {};
                c = mm_tile((const LAS bf16_t*)(L + L_WCT), (const LAS bf16_t*)(L + L_RB), 32 * kt, 32 * tt, r32, hi, c);
                const LAS bf16_t* TCR = (const LAS bf16_t*)(L + L_TCR);
#pragma unroll
                for (int g = 0; g < 4; ++g) { const int k0 = 32 * kt + 8 * g + 4 * hi; const u32x2 rr = *(const LAS u32x2*)(TCR + t * RS + k0);
                    const u32x2 o = {cvtpk(c[4 * g] + bflo(rr.x), c[4 * g + 1] + bfhi(rr.x)), cvtpk(c[4 * g + 2] + bflo(rr.y), c[4 * g + 3] + bfhi(rr.y))};
                    *(u32x2*)(pbuf + (size_t)ch * 4096 + ((tt * 4 + 2 * kt + (g >> 1)) * 64 + r32 + 32 * (g & 1)) * 8 + 4 * hi) = o; } }
        } else {
            const int vt = (w >> 1) & 1, tt = w & 1, t = 32 * tt + r32;
            f32x16 c = {};
            c = mm_tile((const LAS bf16_t*)(L + L_U0CT), (const LAS bf16_t*)(L + L_RB), 32 * vt, 32 * tt, r32, hi, c);
            c = mm_tile((const LAS bf16_t*)(L + L_CTV), (const LAS bf16_t*)(L + L_RK), 32 * vt, 32 * tt, r32, hi, c);
            const LAS bf16_t* CTV = (const LAS bf16_t*)(L + L_CTV); bf16_t* vsc = WSP(bf16_t, WS_VSC);
#pragma unroll
            for (int g = 0; g < 4; ++g) { const int v0 = 32 * vt + 8 * g + 4 * hi; const size_t di = (size_t)ch * 4096 + ((((tt * 2 + vt) * 4 + g) * 64) + lane) * 4;
                *(u32x2*)(y0buf + di) = (u32x2){cvtpk(c[4 * g], c[4 * g + 1]), cvtpk(c[4 * g + 2], c[4 * g + 3])};
                *(u32x2*)(vsc + di) = (u32x2){(unsigned)CTV[(v0 + 0) * RS + t] | ((unsigned)CTV[(v0 + 1) * RS + t] << 16), (unsigned)CTV[(v0 + 2) * RS + t] | ((unsigned)CTV[(v0 + 3) * RS + t] << 16)}; }
        }
        LDS_BARRIER();
    }
}

DI void r2_wave(Ctx& C, int wi) {
    const int bh = wi >> 1, vt = wi & 1, lane = C.lane, r32 = lane & 31, hi = lane >> 5;
    const u32x4* mfrag = WSP(u32x4, WS_MFRAG); const u32x4* nfrag = WSP(u32x4, WS_NFRAG);
    bf16_t* sbuf = WSP(bf16_t, WS_SBUF);
    f32x16 X[2]; X[0] = f32x16{}; X[1] = f32x16{};
    u32x4 mA[8], nA[4], mB[8], nB[4], mC[8], nC[4];
#define R2_LOAD(M_, N_, cidx) do { const size_t ch_ = (size_t)bh * 256 + (cidx); \
        _Pragma("unroll") for (int q_ = 0; q_ < 8; ++q_) M_[q_] = mfrag[((ch_ * 4 + (q_ >> 1)) * 2 + (q_ & 1)) * 64 + lane];            \
        _Pragma("unroll") for (int q_ = 0; q_ < 4; ++q_) N_[q_] = nfrag[((ch_ * 4 + (q_ >> 1) * 2 + vt) * 2 + (q_ & 1)) * 64 + lane]; } while (0)
#define R2_STEP(M_, N_, cidx) do { const size_t ch_ = (size_t)bh * 256 + (cidx); \
          \
        _Pragma("unroll") for (int kt = 0; kt < 2; ++kt) _Pragma("unroll") for (int g = 0; g < 4; ++g) \
            *(u32x2*)(sbuf + ch_ * 4096 + ((vt * 4 + 2 * kt + (g >> 1)) * 64 + r32 + 32 * (g & 1)) * 8 + 4 * hi) = (u32x2){cvtpk(X[kt][4 * g], X[kt][4 * g + 1]), cvtpk(X[kt][4 * g + 2], X[kt][4 * g + 3])}; \
        f32x16 acc[2]; \
        _Pragma("unroll") for (int it = 0; it < 2; ++it) _Pragma("unroll") for (int s = 0; s < 2; ++s) { const u32x4 q = N_[it * 2 + s]; \
            acc[it][8 * s + 0] = bflo(q.x); acc[it][8 * s + 1] = bfhi(q.x); acc[it][8 * s + 2] = bflo(q.y); acc[it][8 * s + 3] = bfhi(q.y); \
            acc[it][8 * s + 4] = bflo(q.z); acc[it][8 * s + 5] = bfhi(q.z); acc[it][8 * s + 6] = bflo(q.w); acc[it][8 * s + 7] = bfhi(q.w); } \
        _Pragma("unroll") for (int kt = 0; kt < 2; ++kt) _Pragma("unroll") for (int s = 0; s < 2; ++s) { const bf16x8 xb = pack_step(X[kt], s); \
            _Pragma("unroll") for (int it = 0; it < 2; ++it) acc[it] = MFMA32(__builtin_bit_cast(bf16x8, M_[(kt * 2 + it) * 2 + s]), xb, acc[it]); } \
        X[0] = acc[0]; X[1] = acc[1]; \
        if ((cidx) + 3 < 256) R2_LOAD(M_, N_, (cidx) + 3); } while (0)
    R2_LOAD(mA, nA, 0); R2_LOAD(mB, nB, 1); R2_LOAD(mC, nC, 2);
    for (int cidx = 0; cidx < 255; cidx += 3) { R2_STEP(mA, nA, cidx); R2_STEP(mB, nB, cidx + 1); R2_STEP(mC, nC, cidx + 2); }
    R2_STEP(mA, nA, 255);
#undef R2_LOAD
#undef R2_STEP
}

constexpr int A_STG = 16384, A_NSTG = 8;
constexpr int A_WS = RING_BYTES + 4096;
constexpr int A_O2 = 0;
constexpr int A_IDX = A_WS + 8 * 256;
constexpr int A_ONES = A_IDX + 64;
static_assert(A_NSTG * A_STG <= RING_BYTES && A_ONES + 32 <= LDS_BYTES && A_WS >= RING_BYTES + 1024, "attention LDS map");
typedef short v4i16_t __attribute__((ext_vector_type(4)));
DI s16x4 vtr(const LAS unsigned char* p) { return __builtin_bit_cast(s16x4, __builtin_amdgcn_ds_read_tr16_b64_v4i16((LAS v4i16_t*)p)); }
DI void attn_unit(Ctx& C, int b, int h, int u, float lam) {
    int lane_ = C.lane; asm volatile("" : "+v"(lane_));
    const int lane = lane_, w = C.wave, tid = w * 64 + lane, r32 = lane & 31, hi = lane >> 5, rg = w & 3, mp = w >> 2; (void)tid;
    LAS unsigned char* L = C.lds;
    const bf16_t* proj = WSP(bf16_t, WS_PROJ);
    const size_t rowbase = (size_t)b * SEQ;
    const int q0 = u * 128 + rg * 32;
    const int my_chunk = q0 >> 6, NT = 2 * u + 2;
    const unsigned char* qk8 = WSP(unsigned char, WS_QK8);
    pg8::v8i_t qf;
    {   const unsigned char* qp = qk8 + (rowbase + q0 + r32) * 2048 + h * 128 + mp * 64 + 32 * hi;
        qf = __builtin_shufflevector(*(const pg8::v4i_t*)(qp), *(const pg8::v4i_t*)(qp + 16), 0, 1, 2, 3, 4, 5, 6, 7); }
    const unsigned lds0 = (unsigned)(size_t)L;
    const unsigned char* ktb = qk8 + rowbase * 2048 + 1024 + h * 128;
    const unsigned koff = (unsigned)((8 * w + (lane >> 3)) * 2048 + (((lane & 7) ^ (((8 * w + (lane >> 3)) >> 1) & 7)) << 4));
    const unsigned char* vtb = WSP(unsigned char, WS_VT) + (size_t)((b * 8 + h) * 256) * 8192;
    const unsigned voff = (unsigned)((16 * w + (lane >> 2)) * 64 + (((lane & 3) ^ (((16 * w + (lane >> 2)) >> 2) & 3)) << 4));
#define A_GLDS(gsrc, ldsdst) do { unsigned keep_; asm volatile("s_mov_b32 %0, m0\n\ts_mov_b32 m0, %2\n\ts_nop 0\n\tglobal_load_lds_dwordx4 %1, off\n\ts_mov_b32 m0, %0" : "=&s"(keep_) : "v"(gsrc), "s"(ldsdst) : "memory"); } while (0)
#define A_DMA(kt, st) do { const unsigned lb_ = (unsigned)__builtin_amdgcn_readfirstlane((int)(lds0 + (st) * A_STG + w * 1024)); \
        A_GLDS(ktb + (size_t)(kt) * 64 * 2048 + koff, lb_); A_GLDS(vtb + (size_t)(kt) * 8192 + voff, lb_ + 8192); } while (0)
#define A_WAITBAR() asm volatile("s_waitcnt vmcnt(0) lgkmcnt(0)\n\ts_barrier" ::: "memory")
#define A_WAITBAR_N(n) asm volatile("s_waitcnt vmcnt(" #n ") lgkmcnt(0)\n\ts_barrier" ::: "memory")
    const int ksw = (r32 >> 1) & 7, kofa = r32 * 128 + (((mp * 4 + 2 * hi) ^ ksw) << 4);
    const int vsw = (r32 >> 2) & 3, vofa = 8192 + r32 * 64 + (((2 * hi) ^ vsw) << 4);
    f32x16 o[4]; o[0] = f32x16{}; o[1] = f32x16{}; o[2] = f32x16{}; o[3] = f32x16{};
    f32x16 negm = f32x16{};
    f32x16 osum = f32x16{};
    LAS float* wsf = (LAS float*)(L + A_WS) + w * 64;
    A_DMA(0, 0); A_DMA(1, 1); if (NT > 2) A_DMA(2, 2); if (NT > 3) A_DMA(3, 3); if (NT > 4) A_DMA(4, 4);
    A_WAITBAR();
    f32x16 pA0, pA1, pB0, pB1; float rmc;
#define A_ROWMAX2(dst, P0, P1) do { float rm_ = P0[0]; _Pragma("unroll") for (int r = 0; r < 16; ++r) { rm_ = fmaxf(rm_, P0[r]); rm_ = fmaxf(rm_, P1[r]); } \
        auto rr_ = __builtin_amdgcn_permlane32_swap(__float_as_uint(rm_), __float_as_uint(rm_), false, false); dst = fmaxf(__uint_as_float(rr_[0]), __uint_as_float(rr_[1])); } while (0)
#define A_QK8(DST, st, kb) do { const LAS unsigned char* kp_ = L + (st) * A_STG + (kb) * 4096; \
        const pg8::v8i_t kf_ = __builtin_shufflevector(__builtin_bit_cast(pg8::v4i_t, *(const LAS bf16x8*)(kp_ + kofa)), __builtin_bit_cast(pg8::v4i_t, *(const LAS bf16x8*)(kp_ + (kofa ^ 16))), 0, 1, 2, 3, 4, 5, 6, 7); \
        asm volatile("v_mfma_scale_f32_32x32x64_f8f6f4 %0, %1, %2, %5, %3, %4 op_sel_hi:[0,0,0]" : "=&v"(DST) : "v"(kf_), "v"(qf), "v"((127 - F8_SK) * 0x01010101), "v"((127 - F8_SQ) * 0x01010101), "v"(negm)); } while (0)
#define A_KF(st, kb) __builtin_shufflevector(__builtin_bit_cast(pg8::v4i_t, *(const LAS bf16x8*)(L + (st) * A_STG + (kb) * 4096 + kofa)), __builtin_bit_cast(pg8::v4i_t, *(const LAS bf16x8*)(L + (st) * A_STG + (kb) * 4096 + (kofa ^ 16))), 0, 1, 2, 3, 4, 5, 6, 7)
#define A_QKM(DST, KF) asm volatile("v_mfma_scale_f32_32x32x64_f8f6f4 %0, %1, %2, %5, %3, %4 op_sel_hi:[0,0,0]" : "=&v"(DST) : "v"(KF), "v"(qf), "v"((127 - F8_SK) * 0x01010101), "v"((127 - F8_SQ) * 0x01010101), "v"(negm))
    A_QK8(pA0, 0, 0); A_QK8(pA1, 0, 1);
    asm volatile("s_nop 15\n\ts_nop 15\n\ts_nop 15\n\ts_nop 15" : "+v"(pA0), "+v"(pA1));
    A_ROWMAX2(rmc, pA0, pA1);
    pB0 = f32x16{}; pB1 = f32x16{};
#define A_SM4(g, C0, C1, PW) do { const int r0 = 4 * ((g) & 3); float e0, e1, e2, e3; \
        if ((g) < 4) { e0 = C0[r0]; e1 = C0[r0 + 1]; e2 = C0[r0 + 2]; e3 = C0[r0 + 3]; } else { e0 = C1[r0]; e1 = C1[r0 + 1]; e2 = C1[r0 + 2]; e3 = C1[r0 + 3]; } \
        e0 = __builtin_amdgcn_exp2f(e0); e1 = __builtin_amdgcn_exp2f(e1); e2 = __builtin_amdgcn_exp2f(e2); e3 = __builtin_amdgcn_exp2f(e3); \
        { int q_ = PW[g]; q_ = __builtin_amdgcn_cvt_pk_fp8_f32(e0, e1, q_, false); q_ = __builtin_amdgcn_cvt_pk_fp8_f32(e2, e3, q_, true);     asm volatile("" : "+v"(q_)); PW[g] = q_; } } while (0)
#define A_VF(stv, d0) __builtin_shufflevector(__builtin_bit_cast(pg8::v4i_t, *(const LAS bf16x8*)(L + (stv) * A_STG + vofa + (d0) * 2048)), __builtin_bit_cast(pg8::v4i_t, *(const LAS bf16x8*)(L + (stv) * A_STG + (vofa ^ 16) + (d0) * 2048)), 0, 1, 2, 3, 4, 5, 6, 7)
#define A_PVM(d0, PA, VB) asm volatile("v_mfma_scale_f32_32x32x64_f8f6f4 %0, %1, %2, %0, %3, %4 op_sel_hi:[0,0,0]" : "+v"(o[d0]) : "v"(PA), "v"(VB), "v"(0x7f7f7f7f), "v"((127 - F8_SV) * 0x01010101))
#define A_ONESF() __builtin_shufflevector(__builtin_bit_cast(pg8::v4i_t, *(const LAS bf16x8*)(L + A_ONES)), __builtin_bit_cast(pg8::v4i_t, *(const LAS bf16x8*)(L + A_ONES + 16)), 0, 1, 2, 3, 4, 5, 6, 7)
#define A_OSM(PA, ON) asm volatile("v_mfma_scale_f32_32x32x64_f8f6f4 %0, %1, %2, %0, %3, %3 op_sel_hi:[0,0,0]" : "+v"(osum) : "v"(PA), "v"(ON), "v"(0x7f7f7f7f))
#define A_SB() __builtin_amdgcn_sched_barrier(0)
#define A_STEP(kt, C0, C1, N0, N1, PWC, PWP, SVP_, KF0, KF1, PRE_, SKP_, NKF0, NKF1) do { const int svp_ = (SVP_); \
        bool resc = false; \
        if ((kt) <= my_chunk && ((kt) == 0 || __any(rmc > 8.f))) {      \
            const float dl = (kt) == 0 ? rmc : fmaxf(rmc, 0.f); resc = true; \
            _Pragma("unroll") for (int r = 0; r < 16; ++r) { C0[r] -= dl; C1[r] -= dl; negm[r] -= dl; } \
            if (hi == 0) wsf[r32] = __builtin_amdgcn_exp2f(-dl); } \
          \
        { pg8::v8i_t vb0, vb1; \
            A_QKM(N0, KF0); vb0 = A_VF(svp_, 0); A_SM4(0, C0, C1, PWC); A_SB(); \
            A_QKM(N1, KF1); vb1 = A_VF(svp_, 1); A_SM4(1, C0, C1, PWC); A_SB(); \
            A_PVM(0, PWP, vb0);  A_SM4(2, C0, C1, PWC); A_SB(); vb0 = A_VF(svp_, 2); \
            A_PVM(1, PWP, vb1);  A_SM4(3, C0, C1, PWC); A_SB(); vb1 = A_VF(svp_, 3); \
            A_PVM(2, PWP, vb0);  A_SM4(4, C0, C1, PWC); A_SB(); vb0 = A_ONESF(); \
            A_PVM(3, PWP, vb1);  A_SM4(5, C0, C1, PWC); A_SB(); \
            A_OSM(PWP, vb0);     A_SM4(6, C0, C1, PWC); A_SB(); if (PRE_) { NKF0 = A_KF(SKP_, 0); NKF1 = A_KF(SKP_, 1); } \
            A_SM4(7, C0, C1, PWC); A_SB(); } \
        if (resc) {                                           \
            asm volatile("s_waitcnt lgkmcnt(0)\n\ts_nop 15\n\ts_nop 15\n\ts_nop 15\n\ts_nop 15" ::: "memory");     \
            _Pragma("unroll") for (int r = 0; r < 16; ++r) { const float fr_ = wsf[crow(r, hi)]; osum[r] *= fr_; \
                _Pragma("unroll") for (int d0 = 0; d0 < 4; ++d0) o[d0][r] *= fr_; } } \
        A_ROWMAX2(rmc, N0, N1); \
        } while (0)
    pg8::v8i_t pwX = {0, 0, 0, 0, 0, 0, 0, 0}, pwY = {0, 0, 0, 0, 0, 0, 0, 0};
    int sb = 0;
#define A_SG(d) ((sb + (d)) >= A_NSTG ? (sb + (d)) - A_NSTG : (sb + (d)))
    for (int kt = 0; kt < NT; kt += 2) {
        if (kt > 0) { if (kt + 4 < NT) A_WAITBAR_N(4); else if (kt + 3 < NT) A_WAITBAR_N(2); else A_WAITBAR(); }
        if (kt + 5 < NT) A_DMA(kt + 5, A_SG(5));
        if (kt + 6 < NT) A_DMA(kt + 6, A_SG(6));
        { const int s0 = A_SG(0), sm1 = kt == 0 ? s0 : A_SG(7), s1 = A_SG(1), s2 = A_SG(2);
          pg8::v8i_t ka0 = A_KF(s1, 0), ka1 = A_KF(s1, 1), kb0, kb1;
          A_STEP(kt, pA0, pA1, pB0, pB1, pwX, pwY, sm1, ka0, ka1, true, s2, kb0, kb1);
          A_STEP(kt + 1, pB0, pB1, pA0, pA1, pwY, pwX, s0, kb0, kb1, false, s2, ka0, ka1); }
        sb = A_SG(2);
    }
    if (my_chunk == NT - 1) {
        const int svp_ = A_SG(7);
        const pg8::v8i_t vb0 = A_VF(svp_, 0), vb1 = A_VF(svp_, 1), vb2 = A_VF(svp_, 2), vb3 = A_VF(svp_, 3);
        const pg8::v8i_t on_ = A_ONESF();
        A_PVM(0, pwY, vb0); A_PVM(1, pwY, vb1); A_PVM(2, pwY, vb2); A_PVM(3, pwY, vb3); A_OSM(pwY, on_);
    }
#undef A_SG
#undef A_SM4
#undef A_VF
#undef A_PVM
#undef A_ONESF
#undef A_OSM
#undef A_SB
    asm volatile("s_nop 15\n\ts_nop 15\n\ts_nop 15\n\ts_nop 15" ::: "memory");
#undef A_STEP
#undef A_QK8
#undef A_KF
#undef A_QKM
#undef A_ROWMAX2
#undef A_DMA
#undef A_GLDS
#undef A_WAITBAR
#undef A_WAITBAR_N
#pragma unroll
    for (int r = 0; r < 16; ++r) { const float il = __builtin_amdgcn_rcpf(fmaxf(osum[r], 1e-30f));
#pragma unroll
        for (int d0 = 0; d0 < 4; ++d0) o[d0][r] *= il; }
    LDS_BARRIER();
    LAS float* O2 = (LAS float*)(L + A_O2) + rg * 4096;
    if (mp == 1) {
#pragma unroll
        for (int d0 = 0; d0 < 4; ++d0)
#pragma unroll
            for (int r = 0; r < 16; ++r) O2[(d0 * 16 + r) * 64 + lane] = o[d0][r];
    }
    LDS_BARRIER();
    if (mp == 0) {
        unsigned char* ob = WSP(unsigned char, WS_OB8);
        float sg[4];
#pragma unroll
        for (int d0 = 0; d0 < 4; ++d0) sg[d0] = C.subln_gain()[32 * d0 + r32] * (1.f - LAMBDA_INIT);
#pragma unroll
        for (int r = 0; r < 16; ++r) {
            float dv[4], ss = 0.f;
#pragma unroll
            for (int d0 = 0; d0 < 4; ++d0) { dv[d0] = o[d0][r] - lam * O2[(d0 * 16 + r) * 64 + lane]; ss += dv[d0] * dv[d0]; }
            ss = sum32_dpp(ss);
            const float rstd = __builtin_amdgcn_rsqf(ss * (1.f / 128.f) + 1e-6f);
            unsigned char* orow = ob + (rowbase + q0 + crow(r, hi)) * 1024 + h * 128 + r32;
#pragma unroll
            for (int d0 = 0; d0 < 4; ++d0) orow[32 * d0] = (unsigned char)(pk4_fp8(dv[d0] * rstd * sg[d0] * (float)(1 << F8_SH), 0.f, 0.f, 0.f) & 0xffu);
        }
    }
    LDS_BARRIER();
}
DI void phase_r2_attn(Ctx& C, int qword) {
    unsigned* ctl = WSP(unsigned, WS_CTL);
#ifndef R2_PROBE
#define R2_PROBE 0
#endif
    if (C.bid < 8) { r2_wave(C, C.bid * 8 + C.wave); if (R2_PROBE) r2_wave(C, C.bid * 8 + C.wave); }
    float s1 = C.lam_q1()[C.lane] * C.lam_k1()[C.lane], s2 = C.lam_q2()[C.lane] * C.lam_k2()[C.lane];
    s1 = wave_sum(s1); s2 = wave_sum(s2);
    const float lam = __expf(s1) - __expf(s2) + LAMBDA_INIT;
    LAS int* idxp = (LAS int*)(C.lds + A_IDX);
    if (C.tid < 8) ((LAS unsigned*)(C.lds + A_ONES))[C.tid] = 0x38383838u;
    __syncthreads();
    const int myq = (int)(xb_xcc_id() & 7u);
    for (int qo = 0; qo < 8; ++qo) {
        const int j = (myq + qo) & 7;
        for (;;) {
            if (C.tid == 0) *idxp = (int)__hip_atomic_fetch_add(ctl + qword + 64 * j, 1u, __ATOMIC_RELAXED, __HIP_MEMORY_SCOPE_AGENT);
            LDS_BARRIER();
            const int q = *idxp;
            LDS_BARRIER();
            if (q >= 256) break;
            const int pair = 2 * j + (q & 1);
            attn_unit(C, pair >> 3, pair & 7, 127 - (q >> 1), lam);
        }
    }
}

DI void phase_r3(Ctx& C) {
    const int lane = C.lane, w = C.wave, r32 = lane & 31, hi = lane >> 5, tt = w & 1, chi = w >> 1;
    const bf16_t* proj = WSP(bf16_t, WS_PROJ); const bf16_t* sbuf = WSP(bf16_t, WS_SBUF); const bf16_t* pbuf = WSP(bf16_t, WS_PBUF); const bf16_t* y0buf = WSP(bf16_t, WS_Y0);
    const float* bonus = WSP(float, WS_BONUS); const bf16_t* vsc = WSP(bf16_t, WS_VSC); const bf16_t* oa = WSP(bf16_t, WS_OA); unsigned char* oa8 = WSP(unsigned char, WS_OA8);
    for (int item = C.bid; item < 2048; item += C.G) {
        const int cg = item >> 2, h = (item & 3) * 4 + chi, b = cg >> 8, cidx = cg & 255;
        const size_t ch = (size_t)(b * 16 + h) * 256 + cidx, tok = (size_t)cg * 64 + 32 * tt + r32;
        f32x16 acc[2]; acc[0] = f32x16{}; acc[1] = f32x16{};
#pragma unroll
        for (int s = 0; s < 4; ++s) {
            const bf16x8 pb = *(const bf16x8*)(pbuf + ch * 4096 + ((tt * 4 + s) * 64 + lane) * 8);
#pragma unroll
            for (int vt = 0; vt < 2; ++vt) { const bf16x8 sa = *(const bf16x8*)(sbuf + ch * 4096 + ((vt * 4 + s) * 64 + lane) * 8); acc[vt] = MFMA32(sa, pb, acc[vt]); }
        }
        u32x2 yy[8], vc[8], gg[8]; f32x4 gw[8], gb[8];
        const float bs = bonus[tok * 16 + h];
#pragma unroll
        for (int q = 0; q < 8; ++q) { const int vt = q >> 2, g = q & 3, v0 = h * 64 + 32 * vt + 8 * g + 4 * hi; const size_t fi = ch * 4096 + ((((tt * 2 + vt) * 4 + g) * 64) + lane) * 4;
            yy[q] = *(const u32x2*)(y0buf + fi); vc[q] = *(const u32x2*)(vsc + fi); gg[q] = *(const u32x2*)(oa + tok * 1024 + v0);
            gw[q] = *(const f32x4*)(C.gn_w() + v0); gb[q] = *(const f32x4*)(C.gn_b() + v0); }
        float y[32]; float sum = 0.f;
#pragma unroll
        for (int q = 0; q < 8; ++q) { const int vt = q >> 2, g = q & 3;
            y[4 * q + 0] = acc[vt][4 * g + 0] + bflo(yy[q].x); y[4 * q + 1] = acc[vt][4 * g + 1] + bfhi(yy[q].x); y[4 * q + 2] = acc[vt][4 * g + 2] + bflo(yy[q].y); y[4 * q + 3] = acc[vt][4 * g + 3] + bfhi(yy[q].y); }
#pragma unroll
        for (int i = 0; i < 32; ++i) sum += y[i];
        sum = sum_x32(sum);
        const float mean = sum * (1.f / 64.f); float vs = 0.f;
#pragma unroll
        for (int i = 0; i < 32; ++i) { const float d = y[i] - mean; vs += d * d; }
        vs = sum_x32(vs);
        const float rstd = __builtin_amdgcn_rsqf(vs * (1.f / 64.f) + 64e-5f);
        unsigned ow[8];
#pragma unroll
        for (int q = 0; q < 8; ++q) {
            const f32x4 vcur = {bflo(vc[q].x), bfhi(vc[q].x), bflo(vc[q].y), bfhi(vc[q].y)}, gv = {bflo(gg[q].x), bfhi(gg[q].x), bflo(gg[q].y), bfhi(gg[q].y)};
            f32x4 ov;
#pragma unroll
            for (int e = 0; e < 4; ++e) { const float yn = (y[4 * q + e] - mean) * rstd * gw[q][e] + gb[q][e]; ov[e] = (yn + bs * vcur[e]) * gv[e] * (float)(1 << F8_SH); }
            ow[q] = pk4_fp8(ov[0], ov[1], ov[2], ov[3]);
        }
#pragma unroll
        for (int q = 0; q < 8; ++q) { const int vt = q >> 2, g = q & 3, v0 = h * 64 + 32 * vt + 8 * g + 4 * hi; *(unsigned*)(oa8 + tok * 1024 + v0) = ow[q]; }
    }
}
DI void phase_norm2_router(Ctx& C) {
    const int lane = C.lane, w = C.wave, fr = lane & 15, fq = lane >> 4;
    const float* mod = WSP(float, WS_MOD); const float* gs2 = WSP(float, WS_GS2);
    const bf16_t* wr = WSP(bf16_t, WS_WRT);
    unsigned char* H2 = WSP(unsigned char, WS_H);
    int* topidx = WSP(int, WS_TOPIDX); float* topw = WSP(float, WS_TOPW); int* wgcnt = WSP(int, WS_WGCNT);
    LAS float* lgp = (LAS float*)(C.lds);
    LAS float* rst = (LAS float*)(C.lds + RING_BYTES);
    for (int tb = C.bid; tb < 256; tb += C.G) {
        const size_t rowb = (size_t)tb * 128; const int b = (int)(rowb / SEQ);
        LAS float* rstd_l = (LAS float*)(C.lds + RING_BYTES + 1024);
        LAS int* hist = (LAS int*)(C.lds + RING_BYTES + 1536);
        (void)rst;
        if (C.tid < 32) hist[C.tid] = 0;
        {
            const float* rs = WSP(float, WS_ROWSS) + (rowb + 16 * w) * 32; float pv[16];
#pragma unroll
            for (int i = 0; i < 16; ++i) pv[i] = (lane < 32) ? rs[i * 32 + lane] : 0.f;
#pragma unroll
            for (int i = 0; i < 16; ++i) { const float r = __builtin_amdgcn_rsqf(wave_sum(pv[i]) * (1.f / D) + 1e-6f); if (lane == 0) rstd_l[16 * w + i] = r; } }
        __syncthreads();
        const int k0 = 256 * w + 8 * fq;
        const float* gsb = gs2 + b * 2048 + k0; const float* shb = mod + b * 12288 + 3 * 2048 + k0;
        const bf16_t* wb = wr + fr * 2048 + k0;
        const float* xb = C.out + (rowb + fr) * D + k0; unsigned char* hb = H2 + (rowb + fr) * D + k0;
        float rs8[8];
#pragma unroll
        for (int gi = 0; gi < 8; ++gi) rs8[gi] = rstd_l[16 * gi + fr];
        f32x4 acc[8][2];
#pragma unroll
        for (int gi = 0; gi < 8; ++gi) { acc[gi][0] = (f32x4){0.f, 0.f, 0.f, 0.f}; acc[gi][1] = acc[gi][0]; }
        for (int ks = 0; ks < 8; ++ks) {
            f32x4 xv[8][2];
#pragma unroll
            for (int gi = 0; gi < 8; ++gi) { xv[gi][0] = *(const f32x4*)(xb + (size_t)gi * 16 * D + 32 * ks); xv[gi][1] = *(const f32x4*)(xb + (size_t)gi * 16 * D + 32 * ks + 4); }
            const f32x4 g0 = *(const f32x4*)(gsb + 32 * ks), g1 = *(const f32x4*)(gsb + 32 * ks + 4), s0 = *(const f32x4*)(shb + 32 * ks), s1 = *(const f32x4*)(shb + 32 * ks + 4);
            const bf16x8 bh0 = *(const bf16x8*)(wb + 32 * ks), bl0 = *(const bf16x8*)(wb + 65536 + 32 * ks), bh1 = *(const bf16x8*)(wb + 16 * 2048 + 32 * ks), bl1 = *(const bf16x8*)(wb + 65536 + 16 * 2048 + 32 * ks);
#pragma unroll
            for (int gi = 0; gi < 8; ++gi) {
                const f32x4 y0 = xv[gi][0] * rs8[gi] * g0 + s0, y1 = xv[gi][1] * rs8[gi] * g1 + s1;
                u32x4 ah, al;
                { const unsigned h0 = f2bf(y0[0]), h1 = f2bf(y0[1]), h2 = f2bf(y0[2]), h3 = f2bf(y0[3]), h4 = f2bf(y1[0]), h5 = f2bf(y1[1]), h6 = f2bf(y1[2]), h7 = f2bf(y1[3]);
                  ah = (u32x4){h0 | (h1 << 16), h2 | (h3 << 16), h4 | (h5 << 16), h6 | (h7 << 16)};
                  al = (u32x4){pk2(y0[0] - bf2f(h0), y0[1] - bf2f(h1)), pk2(y0[2] - bf2f(h2), y0[3] - bf2f(h3)), pk2(y1[0] - bf2f(h4), y1[1] - bf2f(h5)), pk2(y1[2] - bf2f(h6), y1[3] - bf2f(h7))}; }
                { const float sh_ = (float)(1 << F8_SH); *(u32x2*)(hb + (size_t)gi * 16 * D + 32 * ks) = (u32x2){pk4_fp8(y0[0] * sh_, y0[1] * sh_, y0[2] * sh_, y0[3] * sh_), pk4_fp8(y1[0] * sh_, y1[1] * sh_, y1[2] * sh_, y1[3] * sh_)}; }
                const bf16x8 A_h = __builtin_bit_cast(bf16x8, ah), A_l = __builtin_bit_cast(bf16x8, al);
                acc[gi][0] = MFMA16(A_h, bh0, acc[gi][0]); acc[gi][0] = MFMA16(A_h, bl0, acc[gi][0]); acc[gi][0] = MFMA16(A_l, bh0, acc[gi][0]);
                acc[gi][1] = MFMA16(A_h, bh1, acc[gi][1]); acc[gi][1] = MFMA16(A_h, bl1, acc[gi][1]); acc[gi][1] = MFMA16(A_l, bh1, acc[gi][1]);
            }
        }
#pragma unroll
        for (int gi = 0; gi < 8; ++gi)
#pragma unroll
            for (int nt = 0; nt < 2; ++nt)
#pragma unroll
                for (int i = 0; i < 4; ++i) lgp[(w * 128 + 16 * gi + 4 * fq + i) * 32 + 16 * nt + fr] = acc[gi][nt][i];
        LDS_BARRIER();
        {   const int row = C.tid >> 2, e0 = 8 * (C.tid & 3); float s[8];
#pragma unroll
            for (int e = 0; e < 8; ++e) s[e] = C.b_router()[e0 + e];
#pragma unroll
            for (int ww = 0; ww < 8; ++ww) { const f32x4 a = *(const LAS f32x4*)(lgp + (ww * 128 + row) * 32 + e0), c = *(const LAS f32x4*)(lgp + (ww * 128 + row) * 32 + e0 + 4);
                s[0] += a[0]; s[1] += a[1]; s[2] += a[2]; s[3] += a[3]; s[4] += c[0]; s[5] += c[1]; s[6] += c[2]; s[7] += c[3]; }
            LDS_BARRIER();
            *(LAS f32x4*)(lgp + row * 32 + e0) = (f32x4){s[0], s[1], s[2], s[3]}; *(LAS f32x4*)(lgp + row * 32 + e0 + 4) = (f32x4){s[4], s[5], s[6], s[7]}; }
        LDS_BARRIER();
        if (C.tid < 128) {
            float v0 = -INFINITY, v1 = -INFINITY, v2 = -INFINITY, v3 = -INFINITY; int i0 = 0, i1 = 0, i2 = 0, i3 = 0;
            for (int e = 0; e < 32; ++e) { const float v = lgp[C.tid * 32 + ((e + C.tid) & 31) * 0 + e];
                if (v > v0) { v3 = v2; i3 = i2; v2 = v1; i2 = i1; v1 = v0; i1 = i0; v0 = v; i0 = e; }
                else if (v > v1) { v3 = v2; i3 = i2; v2 = v1; i2 = i1; v1 = v; i1 = e; }
                else if (v > v2) { v3 = v2; i3 = i2; v2 = v; i2 = e; }
                else if (v > v3) { v3 = v; i3 = e; } }
            const float e1 = __expf(v1 - v0), e2 = __expf(v2 - v0), e3 = __expf(v3 - v0), inv = 1.f / (1.f + e1 + e2 + e3);
            const size_t tkn = rowb + C.tid;
            *(int4*)(topidx + tkn * 4) = make_int4(i0, i1, i2, i3);
            *(f32x4*)(topw + tkn * 4) = (f32x4){inv, e1 * inv, e2 * inv, e3 * inv};
            atomicAdd((int*)&hist[i0], 1); atomicAdd((int*)&hist[i1], 1); atomicAdd((int*)&hist[i2], 1); atomicAdd((int*)&hist[i3], 1);
        }
        __syncthreads();
        if (C.tid < 32) wgcnt[tb * 32 + C.tid] = hist[C.tid];
        __syncthreads();
    }
}

DI void phase_route(Ctx& C) {
    const int lane = C.lane, w = C.wave, tid = C.tid;
    const int* wgcnt = WSP(int, WS_WGCNT); const int* topidx = WSP(int, WS_TOPIDX); const float* topw = WSP(float, WS_TOPW);
    int* slotpos = WSP(int, WS_SLOTPOS); int* rowtok = WSP(int, WS_ROWTOK); float* rowgate = WSP(float, WS_ROWGATE); int* tiletab = WSP(int, WS_TILEEXP);
    LAS int* part = (LAS int*)(C.lds);
    LAS int* tot = part + 512;
    LAS int* pstart = tot + 32;
    LAS int* pre = pstart + 40;
    LAS int* wcnt = pre + 32;
    LAS int* spos = wcnt + 256;
    { const int e = tid & 31, j = tid >> 5; int s = 0; for (int i = 0; i < 16; ++i) s += wgcnt[(16 * j + i) * 32 + e]; part[j * 32 + e] = s; }
    __syncthreads();
    if (tid < 32) { int s = 0; for (int j = 0; j < 16; ++j) s += part[j * 32 + tid]; tot[tid] = s; }
    __syncthreads();
    if (tid == 0) { int run = 0; for (int e = 0; e < 32; ++e) { pstart[e] = run; run += ((tot[e] + 255) >> 8) << 8; } pstart[32] = run; }
    __syncthreads();
    if (C.bid == 0) {
        if (tid == 0) tiletab[0] = pstart[32] >> 8;
        for (int e = 0; e < 32; ++e) { const int t0 = pstart[e] >> 8, t1 = pstart[e + 1] >> 8; for (int t = t0 + tid; t < t1; t += NTHR) tiletab[16 + t] = e; }
    }
    for (int e = C.bid; e < 32; e += C.G) {
        const int p0 = pstart[e] + tot[e], p1 = pstart[e + 1];
        for (int p = p0 + tid; p < p1; p += NTHR) { rowtok[p] = -1; rowgate[p] = 0.f; }
    }
    for (int tb = C.bid; tb < 256; tb += C.G) {
        if (tid < 32) { int s = 0; for (int j = 0; j < (tb >> 4); ++j) s += part[j * 32 + tid]; for (int t2 = (tb >> 4) << 4; t2 < tb; ++t2) s += wgcnt[t2 * 32 + tid]; pre[tid] = s; }
        const int slot = tb * 512 + tid;
        const int my_e = topidx[slot]; int my_rank = 0;
        for (int e = 0; e < 32; ++e) { const unsigned long long m = __ballot(my_e == e);
            if (my_e == e) my_rank = __popcll(m & ((1ull << lane) - 1ull));
            if (lane == 0) wcnt[w * 32 + e] = __popcll(m); }
        __syncthreads();
        int base = pstart[my_e] + pre[my_e];
        for (int w2 = 0; w2 < w; ++w2) base += wcnt[w2 * 32 + my_e];
        const int pos = base + my_rank;
        slotpos[slot] = pos; rowtok[pos] = slot >> 2; rowgate[pos] = topw[slot]; spos[tid] = pos;
        __syncthreads();
        __syncthreads();
    }
}

DI void phase_combine(Ctx& C) {
    const int gw = C.bid * NWAVES + C.wave, NGW = C.G * NWAVES, lane = C.lane;
    const float* mod = WSP(float, WS_MOD); const int* slotpos = WSP(int, WS_SLOTPOS); const bf16_t* Y = WSP(bf16_t, WS_YR);
    for (int tp = gw; tp < T / 2; tp += NGW) {
        const int t0 = 2 * tp; const int b = t0 / SEQ; const float* g2 = mod + b * 12288 + 5 * 2048;
        const int4 spa = *(const int4*)(slotpos + (size_t)t0 * 4), spb = *(const int4*)(slotpos + (size_t)t0 * 4 + 4);
        const int pp[8] = {spa.x, spa.y, spa.z, spa.w, spb.x, spb.y, spb.z, spb.w};
#pragma unroll
        for (int j = 0; j < 4; ++j) {
            const int c0 = 8 * lane + 512 * j;
            u32x4 yv[8]; f32x4 xa[2][2];
#pragma unroll
            for (int k = 0; k < 8; ++k) yv[k] = *(const u32x4*)(Y + (size_t)pp[k] * 2048 + c0);
#pragma unroll
            for (int u = 0; u < 2; ++u) { xa[u][0] = *(const f32x4*)(C.out + (size_t)(t0 + u) * D + c0); xa[u][1] = *(const f32x4*)(C.out + (size_t)(t0 + u) * D + c0 + 4); }
            const f32x4 ga = *(const f32x4*)(g2 + c0), gb = *(const f32x4*)(g2 + c0 + 4);
#pragma unroll
            for (int u = 0; u < 2; ++u) { float s[8] = {0.f, 0.f, 0.f, 0.f, 0.f, 0.f, 0.f, 0.f};
#pragma unroll
                for (int k = 0; k < 4; ++k) { const u32x4 y = yv[4 * u + k];
                    s[0] += bflo(y.x); s[1] += bfhi(y.x); s[2] += bflo(y.y); s[3] += bfhi(y.y); s[4] += bflo(y.z); s[5] += bfhi(y.z); s[6] += bflo(y.w); s[7] += bfhi(y.w); }
                float* orow = C.out + (size_t)(t0 + u) * D + c0;
                *(f32x4*)(orow) = xa[u][0] + ga * (f32x4){s[0], s[1], s[2], s[3]}; *(f32x4*)(orow + 4) = xa[u][1] + gb * (f32x4){s[4], s[5], s[6], s[7]}; }
        }
    }
}


DI bool refresh(Ctx& C) { int t = threadIdx.x; asm volatile("" : "+v"(t)); C.tid = t; C.lane = t & 63; return true; }
DI void phase_gemm_proj(Ctx& C, PG8_LAS unsigned char* ring) {
    pg8::Gemm g{WSP(bf16_t, WS_H), WSP(bf16_t, WS_WTIN), T, NPROJ, D / 2, F8_SC_GU}; pg8::StaticOrder S; S.init(T, NPROJ, C.G, C.bid);
    EpiPlainBf16 E{WSP(bf16_t, WS_PROJ), NPROJ};
    pg8::gemm_phase<EpiPlainBf16, pg8::StaticOrder, true, true, true>(ring, g, S, E);
}
DI void phase_gemm_lora(Ctx& C, PG8_LAS unsigned char* ring) {

        static_assert(WS_MERGED == WS_OA + (size_t)T * 1024 * 2, "g | lw | a contiguous");
        int Kl = 256; asm volatile("" : "+s"(Kl));
        pg8::Gemm g{WSP(bf16_t, WS_OB), WSP(bf16_t, WS_BTLORA), 2 * T, 3072, Kl, 0}; LoraOrder S; S.init(T, 3072, C.G, C.bid);
        EpiLora E{WSP(bf16_t, WS_OA), C.w0(), C.a0()};
        pg8::gemm_phase<EpiLora, LoraOrder, true, true>(ring, g, S, E);
    }
DI void phase_gemm_gateup(Ctx& C, PG8_LAS unsigned char* ring) {
    pg8::Gemm g{WSP(bf16_t, WS_H), WSP(bf16_t, WS_WTGU), P_MAX, 32 * 4096, D / 2, F8_SC_GU}; MoeOrder S{WSP(int, WS_TILEEXP), 16, C.G, (C.G % 8 == 0) ? (C.bid % 8) * (C.G / 8) + C.bid / 8 : C.bid, WSP(int, WS_ROWTOK)};
    EpiGateUp E{WSP(unsigned char, WS_ACT), C.b_exp_gate(), C.b_exp_up()};
    pg8::gemm_phase<EpiGateUp, MoeOrder, true, true, true, true>(ring, g, S, E);
}
constexpr int N_PHASES = 16;
__global__ void __launch_bounds__(NTHR, 2) fwd(Args args) {
    extern __shared__ __attribute__((aligned(16))) unsigned char lds_raw[];
    Ctx C{args};
    C.lds = (LAS unsigned char*)lds_raw;
    C.tid = threadIdx.x; C.lane = C.tid & 63; C.wave = __builtin_amdgcn_readfirstlane(C.tid >> 6); C.G = gridDim.x; C.bid = blockIdx.x;
    C.out = args.out; C.ws = args.ws;
    volatile LAS unsigned* MISC = (volatile LAS unsigned*)(C.lds + MISC_OFF);
    for (int u = C.tid; u < (LDS_BYTES - RING_BYTES) / 4; u += NTHR) ((LAS unsigned*)(C.lds + RING_BYTES))[u] = 0u;
    __syncthreads();
    const int lo = args.ph_lo, hi = args.ph_hi;
    XcdBarrier bar; bar.bar = WSP(unsigned, WS_CTL) + CW_BAR; bar.x = 0; bar.st = nullptr;
    if (hi - lo > 1) bar = xcd_barrier_post(WSP(unsigned, WS_CTL) + CW_BAR, MISC + 8);
#define IN(k) (lo <= (k) && (k) < hi && refresh(C))
#define SEAM(k) do { if (IN(k) && IN((k) + 1)) xcd_barrier(bar); } while (0)
#ifndef REP_MASK
#define REP_MASK 0
#endif
#define REPQ(k) (((REP_MASK) >> (k)) & 1)
#define REPLOOP(k) _Pragma("nounroll") for (int rep_ = 0; rep_ <= REPQ(k); ++rep_)
    PG8_LAS unsigned char* ring = (PG8_LAS unsigned char*)C.lds;

    if (IN(0)) { REPLOOP(0) { if (rep_) xcd_barrier(bar); phase_prologue(C); } } SEAM(0);
    if (IN(1)) { REPLOOP(1) { if (rep_) xcd_barrier(bar); phase_norm1(C); } } SEAM(1);
    if (IN(2)) { REPLOOP(2) { if (rep_) xcd_barrier(bar); phase_gemm_proj(C, ring); } } SEAM(2);
    if (IN(3)) { REPLOOP(3) { if (rep_) xcd_barrier(bar); phase_prep(C); } } SEAM(3);
    if (IN(4)) { REPLOOP(4) { if (rep_) xcd_barrier(bar); phase_gemm_lora(C, ring); } } SEAM(4);
    if (IN(5)) { REPLOOP(5) { if (rep_) xcd_barrier(bar); phase_r1(C); } } SEAM(5);
    if (IN(6)) { REPLOOP(6) { if (rep_) xcd_barrier(bar); phase_r2_attn(C, CW_QUEUE + 512 * rep_); } } SEAM(6);
    if (IN(7)) { REPLOOP(7) { if (rep_) xcd_barrier(bar); phase_r3(C); } } SEAM(7);
    if (IN(8)) {
        static_assert(WS_OB8 == WS_OA8 + (size_t)T * 1024 && WS_WTBB == WS_WTBA + (size_t)D * 1024, "o_a | o_b and w_branch_a | w_branch_b are stacked");
        pg8::Gemm g{WSP(bf16_t, WS_OA8), WSP(bf16_t, WS_WTBA), 2 * T, 2 * D, 512, F8_SC_GU}; BranchOrder S; S.init(T, D, C.G, C.bid);
        EpiBranchFused E{WSP(unsigned char, WS_MERGED8), WSP(bf16_t, WS_PROJ)};
        pg8::gemm_phase<EpiBranchFused, BranchOrder, true, true, true>(ring, g, S, E);
    } SEAM(8);
    if (IN(10)) {
        pg8::Gemm g{WSP(bf16_t, WS_MERGED8), WSP(bf16_t, WS_WTOUT), T, D, D / 2, F8_SC_GU}; pg8::StaticOrder S; S.init(T, D, C.G, C.bid);
        EpiOut E{C.out, C.x(), WSP(float, WS_MOD), WSP(float, WS_ROWSS)};
        pg8::gemm_phase<EpiOut, pg8::StaticOrder, true, true, true>(ring, g, S, E);
    } SEAM(10);
    if (IN(11)) { REPLOOP(11) { if (rep_) xcd_barrier(bar); phase_norm2_router(C); } } SEAM(11);
    if (IN(12)) { REPLOOP(12) { if (rep_) xcd_barrier(bar); phase_route(C); } } SEAM(12);
    if (IN(13)) { REPLOOP(13) { if (rep_) xcd_barrier(bar); phase_gemm_gateup(C, ring); } } SEAM(13);
    if (IN(14)) {
        pg8::Gemm g{WSP(bf16_t, WS_ACT), WSP(bf16_t, WS_WTDN), P_MAX, 32 * 2048, D / 2, F8_SC_DN}; MoeOrder S{WSP(int, WS_TILEEXP), 8, C.G, (C.G % 8 == 0) ? (C.bid % 8) * (C.G / 8) + C.bid / 8 : C.bid, WSP(int, WS_ROWTOK)};
        EpiDown E{WSP(bf16_t, WS_YR), C.b_exp_down(), WSP(float, WS_ROWGATE)};
        pg8::gemm_phase<EpiDown, MoeOrder, true, true, true>(ring, g, S, E);
    } SEAM(14);
    if (IN(15)) { phase_combine(C); }
#undef IN
#undef SEAM
}

#ifndef N_LAUNCH_MODE
#define N_LAUNCH_MODE 1
#endif
extern "C" void kernel_launch(void* const* d_in, const int* in_sizes, int n_in, void* d_out, int out_size, void* d_ws, size_t ws_size, hipStream_t stream) {
    static int grid = 0;
    if (grid == 0) {
        if (n_in != 36 || out_size != T * D || ws_size < WS_END) { fprintf(stderr, "kernel_launch: unexpected shapes (n_in %d out %d ws %zu)\n", n_in, out_size, ws_size); grid = -1; return; }
        int dev = 0, cus = 0, per_cu = 0;
        if (hipGetDevice(&dev) != hipSuccess || hipDeviceGetAttribute(&cus, hipDeviceAttributeMultiprocessorCount, dev) != hipSuccess) { grid = -1; return; }
        if (hipFuncSetAttribute((const void*)fwd, hipFuncAttributeMaxDynamicSharedMemorySize, LDS_BYTES) != hipSuccess) { fprintf(stderr, "kernel_launch: hipFuncSetAttribute failed\n"); grid = -1; return; }
        if (hipOccupancyMaxActiveBlocksPerMultiprocessor(&per_cu, (const void*)fwd, NTHR, LDS_BYTES) != hipSuccess || per_cu < 1) { fprintf(stderr, "kernel_launch: occupancy query says %d\n", per_cu); }
        (void)hipGetLastError();
        grid = cus;
    }
    if (grid < 0) return;
    (void)hipMemsetAsync((char*)d_ws + WS_CTL, 0, CTL_ZERO_BYTES, stream);
    Args a{};
    for (int i = 0; i < 36; ++i) a.in[i] = (const float*)d_in[i];
    a.out = (float*)d_out; a.ws = (unsigned char*)d_ws;
#if N_LAUNCH_MODE == 1
    a.ph_lo = 0; a.ph_hi = N_PHASES;
    hipLaunchKernelGGL(fwd, dim3(grid), dim3(NTHR), LDS_BYTES, stream, a);
#else
    for (int p = 0; p < N_PHASES; ++p) { a.ph_lo = p; a.ph_hi = p + 1; hipLaunchKernelGGL(fwd, dim3(grid), dim3(NTHR), LDS_BYTES, stream, a); }
#endif
}
```

```cpp
#include <hip/hip_runtime.h>
#include <cstdio>
#include <cstdint>
#include <cmath>

#define GAS __attribute__((address_space(1)))
#define LAS __attribute__((address_space(3)))
#define DI __device__ __forceinline__
typedef unsigned short bf16_t;
typedef short bf16x8 __attribute__((ext_vector_type(8)));
typedef short s16x4 __attribute__((ext_vector_type(4)));
typedef float f32x4 __attribute__((ext_vector_type(4)));
typedef float f32x2 __attribute__((ext_vector_type(2)));
typedef float f32x16 __attribute__((ext_vector_type(16)));
typedef unsigned u32x4 __attribute__((ext_vector_type(4)));
typedef unsigned u32x2 __attribute__((ext_vector_type(2)));

typedef float f32x2_t __attribute__((ext_vector_type(2))); typedef __bf16 bf16x2_t __attribute__((ext_vector_type(2)));
DI unsigned cvtpk(float lo, float hi) { f32x2_t v = {lo, hi}; bf16x2_t b = __builtin_convertvector(v, bf16x2_t); return __builtin_bit_cast(unsigned, b); }
DI unsigned f2bf(float f) { return cvtpk(f, f) & 0xffffu; }
DI unsigned pk2(float lo, float hi) { return cvtpk(lo, hi); }
DI float bf2f(unsigned b) { return __builtin_bit_cast(float, b << 16); }
DI float bflo(unsigned w) { return __builtin_bit_cast(float, w << 16); }
DI float bfhi(unsigned w) { return __builtin_bit_cast(float, w & 0xffff0000u); }
#define DPPF(v, ctrl) __builtin_bit_cast(float, __builtin_amdgcn_update_dpp(0, __builtin_bit_cast(int, (v)), (ctrl), 0xf, 0xf, true))
#define DPPF_ROWS(v, ctrl, rmask) __builtin_bit_cast(float, __builtin_amdgcn_update_dpp(0, __builtin_bit_cast(int, (v)), (ctrl), (rmask), 0xf, false))
DI float sum8_dpp(float v) {
    v += DPPF(v, 0xB1); v += DPPF(v, 0x4E); v += DPPF(v, 0x141); return v;
}
DI float wave_sum(float v) {
    v = sum8_dpp(v); v += DPPF(v, 0x140);
    v += DPPF_ROWS(v, 0x142, 0xa); v += DPPF_ROWS(v, 0x143, 0xc);
    return __builtin_bit_cast(float, __builtin_amdgcn_readlane(__builtin_bit_cast(int, v), 63));
}
DI float sum_x16(float v) {
    const auto p = __builtin_amdgcn_permlane16_swap(__float_as_uint(v), __float_as_uint(v), false, false); return __uint_as_float(p[0]) + __uint_as_float(p[1]); }
DI float sum_x32(float v) {
    const auto p = __builtin_amdgcn_permlane32_swap(__float_as_uint(v), __float_as_uint(v), false, false); return __uint_as_float(p[0]) + __uint_as_float(p[1]); }
DI float sum32_dpp(float v) {
    v = sum8_dpp(v); v += DPPF(v, 0x140); return sum_x16(v); }
DI float sigmoidf_(float x) { return __builtin_amdgcn_rcpf(1.f + __expf(-x)); }
#define LDS_BARRIER() asm volatile("s_waitcnt lgkmcnt(0)\n\ts_barrier" ::: "memory")
DI int crow(int r, int hi) { return (r & 3) + 8 * (r >> 2) + 4 * hi; }
#define MFMA32(a, b, c) __builtin_amdgcn_mfma_f32_32x32x16_bf16((a), (b), (c), 0, 0, 0)
#define MFMA16(a, b, c) __builtin_amdgcn_mfma_f32_16x16x32_bf16((a), (b), (c), 0, 0, 0)

namespace pg8 {
#define PG8_LAS __attribute__((address_space(3)))
constexpr int BM = 256, BK = 64, HALF = 128, HTB = HALF * BK * 2, STAGE_BYTES = 8 * HTB, NXCD = 8, WGM = 6;
__host__ __device__ __forceinline__ int lds_byte(int r, int c) { const int st = (r >> 4) * 2 + (c >> 5), rr = r & 15, cc = c & 31, ob = rr * 64 + cc * 2; return st * 1024 + (ob ^ (((ob >> 9) & 1) << 5)); }
__host__ __device__ __forceinline__ void stage_rc(int b, int& R, int& C) { const int st = b / 1024, sb = b % 1024, swz = sb ^ (((sb >> 9) & 1) << 5); R = (st >> 1) * 16 + swz / 64; C = (st & 1) * 32 + (swz % 64) / 2; }
__host__ __device__ __forceinline__ int perm32(int rho) { const int n = rho >> 4, i = rho & 15; return 8 * (i >> 2) + 4 * n + (i & 3); }
struct Unit { int pm, pn; };
struct Gemm { const bf16_t* A; const bf16_t* Bt; int M, N, K; int f8scale; };
struct StaticOrder {
    int nM, nN, nwg, G, c;
    __host__ __device__ void init(int M, int N, int G_, int c_) { nM = M / BM; nN = N / BM; nwg = nM * nN; G = G_; c = c_; }
    __host__ __device__ bool next(int i, Unit& u) const {
        const long L = (long)i * G + c; if (L >= nwg) return false;
        int wgid = (int)L; { const int q = nwg / NXCD, r = nwg % NXCD, xcd = wgid % NXCD, off = wgid / NXCD; wgid = (xcd < r ? xcd * (q + 1) : r * (q + 1) + (xcd - r) * q) + off; }
        const int nig = WGM * nN, gid = wgid / nig, fm = gid * WGM, gsz = (nM - fm) < WGM ? (nM - fm) : WGM;
        u.pm = fm + ((wgid % nig) % gsz); u.pn = (wgid % nig) / gsz; return true;
    }
    __device__ __forceinline__ void a_ready(const Unit&) const {}
    __device__ __forceinline__ void done(const Unit&) const {}
};
__device__ __forceinline__ unsigned cvt_pk_bf16(float lo, float hi) { unsigned r; asm volatile("v_cvt_pk_bf16_f32 %0, %1, %2" : "=v"(r) : "v"(lo), "v"(hi)); return r; }
typedef int v8i_t __attribute__((ext_vector_type(8))); typedef int v4i_t __attribute__((ext_vector_type(4)));
#define PG8_CAT(x0, x1) __builtin_shufflevector(__builtin_bit_cast(v4i_t, (x0)), __builtin_bit_cast(v4i_t, (x1)), 0, 1, 2, 3, 4, 5, 6, 7)
template <class Epi, class Sched, bool ALIGN_EPI = false, bool SP2 = false, bool F8 = false, bool GATHER = false>
__device__ __forceinline__ void gemm_phase(PG8_LAS unsigned char* lds, const Gemm g, const Sched& S, const Epi& E) {
    const int tid = threadIdx.x, wid = __builtin_amdgcn_readfirstlane(tid >> 6), lane = tid & 63, wr = wid >> 2, wc = wid & 3, fr = lane & 15, fq = lane >> 4;
    const int K = g.K, nt = K / BK; const int f8sc = g.f8scale, f8one = 0x7f7f7f7f; (void)f8sc; (void)f8one;
    unsigned voffA[2], voffB[2];
#pragma unroll
    for (int i = 0; i < 2; ++i) { int R, C; stage_rc(tid * 16 + i * 8192, R, C); const int Rb = Epi::PERM ? ((R & ~31) + perm32(R & 31)) : R;
        voffA[i] = (unsigned)(R * K + C) * 2u; voffB[i] = (unsigned)(Rb * K + C) * 2u; }
    const size_t kstep = (size_t)(BK * 2);
    const size_t hstep = (size_t)HALF * K * 2;
    const size_t tstep = 2 * hstep;
    const unsigned ldsw = (unsigned)wid * 1024u;
    const int aoff = lds_byte(wr * 64 + fr, fq * 8), boff = lds_byte(wc * 32 + fr, fq * 8);
#define PG8_SA(b, h) (((b) * 2 + (h)) * HTB)
#define PG8_SB(b, h) ((4 + (b) * 2 + (h)) * HTB)
#define PG8_STAGE(bufoff, gbase, voff) do { _Pragma("unroll") for (int _i = 0; _i < 2; ++_i) \
        __builtin_amdgcn_global_load_lds((const unsigned*)((const char*)(gbase) + (voff)[_i]), (PG8_LAS unsigned*)(lds + (bufoff) + ldsw + _i * 8192), 16, 0, 0); } while (0)
#define PG8_STAGE_A(bufoff, ptr, half, gset, kofs) do { if constexpr (GATHER) { _Pragma("unroll") for (int _i = 0; _i < 2; ++_i) \
        __builtin_amdgcn_global_load_lds((const unsigned*)((const char*)g.A + (size_t)gset[half][_i] + (size_t)(kofs)), (PG8_LAS unsigned*)(lds + (bufoff) + ldsw + _i * 8192), 16, 0, 0); } \
        else { PG8_STAGE(bufoff, (ptr) + (half) * hstep, voffA); } } while (0)
#define PG8_LDA(dst, b, h) do { _Pragma("unroll") for (int m = 0; m < 4; ++m) { if constexpr (F8) { dst##8[m] = PG8_CAT(*(const PG8_LAS bf16x8*)(lds + PG8_SA(b, h) + aoff + m * 2048), *(const PG8_LAS bf16x8*)(lds + PG8_SA(b, h) + aoff + m * 2048 + 1024)); } \
        else { _Pragma("unroll") for (int k = 0; k < 2; ++k) dst[m][k] = *(const PG8_LAS bf16x8*)(lds + PG8_SA(b, h) + aoff + m * 2048 + k * 1024); } } } while (0)
#define PG8_LDB(dst, b, h) do { _Pragma("unroll") for (int n = 0; n < 2; ++n) { if constexpr (F8) { dst##8[n] = PG8_CAT(*(const PG8_LAS bf16x8*)(lds + PG8_SB(b, h) + boff + n * 2048), *(const PG8_LAS bf16x8*)(lds + PG8_SB(b, h) + boff + n * 2048 + 1024)); } \
        else { _Pragma("unroll") for (int k = 0; k < 2; ++k) dst[n][k] = *(const PG8_LAS bf16x8*)(lds + PG8_SB(b, h) + boff + n * 2048 + k * 1024); } } } while (0)
#define PG8_MMA(ai, bj, At, Bt) do { __builtin_amdgcn_s_setprio(1); _Pragma("unroll") for (int m = 0; m < 4; ++m) _Pragma("unroll") for (int n = 0; n < 2; ++n) { \
        if constexpr (F8) { asm volatile("v_mfma_scale_f32_16x16x128_f8f6f4 %0, %1, %2, %0, %3, %4 op_sel_hi:[0,0,0]" : "+v"(acc[ai][bj][m][n]) : "v"(Bt##8[n]), "v"(At##8[m]), "v"(f8sc), "v"(f8one)); } \
        else { _Pragma("unroll") for (int k = 0; k < 2; ++k) acc[ai][bj][m][n] = __builtin_amdgcn_mfma_f32_16x16x32_bf16(Bt[n][k], At[m][k], acc[ai][bj][m][n], 0, 0, 0); } } __builtin_amdgcn_s_setprio(0); } while (0)
#define PG8_WAIT_V(n) asm volatile("s_waitcnt vmcnt(" #n ")" ::: "memory")
#define PG8_WAIT_L(n) asm volatile("s_waitcnt lgkmcnt(" #n ")" ::: "memory")
#define PG8_BAR __builtin_amdgcn_s_barrier()
#define PG8_SCHED __builtin_amdgcn_sched_barrier(0)
    Unit cur, nxt; int ui = 0;
    if (!S.next(0, cur)) return;
    f32x4 acc[2][2][4][2];
#pragma unroll
    for (int a = 0; a < 2; ++a)
#pragma unroll
        for (int b = 0; b < 2; ++b)
#pragma unroll
            for (int m = 0; m < 4; ++m)
#pragma unroll
                for (int n = 0; n < 2; ++n) acc[a][b][m][n] = (f32x4){0.f, 0.f, 0.f, 0.f};
    bf16x8 At[4][2], B0[2][2], B1[2][2]; v8i_t At8[4], B08[2], B18[2];
    const char* cA = (const char*)g.A + (size_t)cur.pm * tstep; const char* cB = (const char*)g.Bt + (size_t)cur.pn * tstep;
    unsigned gc[2][2] = {{0u, 0u}, {0u, 0u}}, gn[2][2] = {{0u, 0u}, {0u, 0u}}; (void)gc; (void)gn;
#define PG8_GOFF(dst, u) do { if constexpr (GATHER) { _Pragma("unroll") for (int _h = 0; _h < 2; ++_h) _Pragma("unroll") for (int _i = 0; _i < 2; ++_i) { int R_, C_; stage_rc(tid * 16 + _i * 8192, R_, C_); \
        int tok_ = S.rowtok[(u).pm * BM + _h * HALF + R_]; tok_ = tok_ < 0 ? 0 : tok_; dst[_h][_i] = (unsigned)tok_ * (unsigned)(K * 2) + (unsigned)(C_ * 2); } } } while (0)
    PG8_GOFF(gc, cur);
    S.a_ready(cur);
    if constexpr (SP2) {
        PG8_STAGE(PG8_SB(0, 0), cB, voffB); PG8_STAGE(PG8_SB(0, 1), cB + hstep, voffB); PG8_STAGE_A(PG8_SA(0, 0), cA, 0, gc, 0); PG8_STAGE_A(PG8_SA(0, 1), cA, 1, gc, 0);
        if (wr == 1) PG8_BAR;
        PG8_WAIT_V(2); PG8_BAR;
        PG8_STAGE(PG8_SB(1, 0), cB + kstep, voffB); PG8_STAGE_A(PG8_SA(1, 0), cA + kstep, 0, gc, kstep); PG8_STAGE(PG8_SB(1, 1), cB + hstep + kstep, voffB);
        PG8_WAIT_V(6); PG8_BAR;
    } else {
        PG8_STAGE(PG8_SB(0, 0), cB, voffB); PG8_STAGE_A(PG8_SA(0, 0), cA, 0, gc, 0); PG8_STAGE(PG8_SB(0, 1), cB + hstep, voffB); PG8_STAGE_A(PG8_SA(0, 1), cA, 1, gc, 0);
        if (wr == 1) PG8_BAR;
        PG8_WAIT_V(4); PG8_BAR;
        PG8_STAGE(PG8_SB(1, 0), cB + kstep, voffB); PG8_STAGE_A(PG8_SA(1, 0), cA + kstep, 0, gc, kstep); PG8_STAGE(PG8_SB(1, 1), cB + hstep + kstep, voffB);
        PG8_WAIT_V(6); PG8_BAR;
    }
    for (;;) {
        const bool has_next = S.next(ui + 1, nxt);
        const char* nA = has_next ? (const char*)g.A + (size_t)nxt.pm * tstep : cA; const char* nB = has_next ? (const char*)g.Bt + (size_t)nxt.pn * tstep : cB;
        if constexpr (GATHER) { if (has_next) { PG8_GOFF(gn, nxt); } else { gn[0][0] = gc[0][0]; gn[0][1] = gc[0][1]; gn[1][0] = gc[1][0]; gn[1][1] = gc[1][1]; } }
        for (int t = 0; t < nt; t += 2) {
            const bool last = (t == nt - 2);
            const char* a1 = cA + (size_t)(t + 1) * kstep;
            const char* a2 = last ? nA : cA + (size_t)(t + 2) * kstep; const char* b2 = last ? nB : cB + (size_t)(t + 2) * kstep;
            const char* a3 = a2 + kstep; const char* b3 = b2 + kstep;
            const size_t kA1 = (size_t)(t + 1) * kstep, kA2 = last ? (size_t)0 : (size_t)(t + 2) * kstep, kA3 = kA2 + kstep; (void)kA1; (void)kA2; (void)kA3;
            unsigned g2[2][2]; _Pragma("unroll") for (int _h = 0; _h < 2; ++_h) _Pragma("unroll") for (int _i = 0; _i < 2; ++_i) g2[_h][_i] = last ? gn[_h][_i] : gc[_h][_i]; (void)g2;
            if (last && has_next) S.a_ready(nxt);
            if constexpr (SP2) {
            PG8_LDB(B0, 0, 0); PG8_LDB(B1, 0, 1); PG8_SCHED; PG8_LDA(At, 0, 0); PG8_STAGE_A(PG8_SA(1, 1), a1, 1, gc, kA1);
            PG8_WAIT_V(8); PG8_WAIT_L(0); PG8_BAR; PG8_MMA(0, 0, At, B0); PG8_MMA(0, 1, At, B1); PG8_BAR; PG8_SCHED;
            PG8_LDA(At, 0, 1); PG8_STAGE(PG8_SB(0, 0), b2, voffB); PG8_STAGE(PG8_SB(0, 1), b2 + hstep, voffB); PG8_STAGE_A(PG8_SA(0, 0), a2, 0, g2, kA2);
            PG8_WAIT_V(8); PG8_WAIT_L(0); PG8_BAR; PG8_MMA(1, 0, At, B0); PG8_MMA(1, 1, At, B1); PG8_BAR; PG8_SCHED;
            PG8_LDB(B0, 1, 0); PG8_LDB(B1, 1, 1); PG8_SCHED; PG8_LDA(At, 1, 0); PG8_STAGE_A(PG8_SA(0, 1), a2, 1, g2, kA2);
            PG8_WAIT_V(8); PG8_WAIT_L(0); PG8_BAR; PG8_MMA(0, 0, At, B0); PG8_MMA(0, 1, At, B1); PG8_BAR; PG8_SCHED;
            PG8_LDA(At, 1, 1); PG8_STAGE(PG8_SB(1, 0), b3, voffB); PG8_STAGE(PG8_SB(1, 1), b3 + hstep, voffB); PG8_STAGE_A(PG8_SA(1, 0), a3, 0, g2, kA3);
            PG8_WAIT_V(8); PG8_WAIT_L(0); PG8_BAR; PG8_MMA(1, 0, At, B0); PG8_MMA(1, 1, At, B1); PG8_BAR; PG8_SCHED;
            } else {
            PG8_LDB(B0, 0, 0); PG8_SCHED; PG8_LDA(At, 0, 0); PG8_STAGE_A(PG8_SA(1, 1), a1, 1, gc, kA1);
            PG8_WAIT_L(8); PG8_BAR; PG8_WAIT_L(0); PG8_MMA(0, 0, At, B0); PG8_BAR; PG8_SCHED;
            PG8_LDB(B1, 0, 1); PG8_STAGE(PG8_SB(0, 0), b2, voffB);
            PG8_BAR; PG8_WAIT_L(0); PG8_MMA(0, 1, At, B1); PG8_BAR;
            PG8_LDA(At, 0, 1); PG8_STAGE_A(PG8_SA(0, 0), a2, 0, g2, kA2);
            PG8_BAR; PG8_WAIT_L(0); PG8_MMA(1, 0, At, B0); PG8_BAR; PG8_SCHED;
            PG8_STAGE(PG8_SB(0, 1), b2 + hstep, voffB);
            PG8_WAIT_V(6); PG8_BAR; PG8_MMA(1, 1, At, B1); PG8_BAR;
            PG8_LDB(B0, 1, 0); PG8_SCHED; PG8_LDA(At, 1, 0); PG8_STAGE_A(PG8_SA(0, 1), a2, 1, g2, kA2);
            PG8_WAIT_L(8); PG8_BAR; PG8_WAIT_L(0); PG8_MMA(0, 0, At, B0); PG8_BAR; PG8_SCHED;
            PG8_LDB(B1, 1, 1); PG8_STAGE(PG8_SB(1, 0), b3, voffB);
            PG8_BAR; PG8_WAIT_L(0); PG8_MMA(0, 1, At, B1); PG8_BAR;
            PG8_LDA(At, 1, 1); PG8_STAGE_A(PG8_SA(1, 0), a3, 0, g2, kA3);
            PG8_BAR; PG8_WAIT_L(0); PG8_MMA(1, 0, At, B0); PG8_BAR; PG8_SCHED;
            PG8_STAGE(PG8_SB(1, 1), b3 + hstep, voffB);
            PG8_WAIT_V(6); PG8_BAR; PG8_MMA(1, 1, At, B1); PG8_BAR;
            }
        }
        if constexpr (F8) { asm volatile("s_nop 15\n\ts_nop 15" ::: "memory"); }
        if constexpr (ALIGN_EPI) { if (wr == 0) PG8_BAR; }
        bool partial_ = false;
        if constexpr (Epi::HAS_MID) partial_ = S.partial(cur);
        if constexpr (!Epi::AFTER_DRAIN) { if constexpr (Epi::HAS_MID) { if (partial_) E.mid(acc, cur, wr, wc, fr, fq); else E(acc, cur, wr, wc, fr, fq); } else { E(acc, cur, wr, wc, fr, fq); } S.done(cur); }
        if (!has_next) break;
        if (!partial_)
#pragma unroll
        for (int a = 0; a < 2; ++a)
#pragma unroll
            for (int b = 0; b < 2; ++b)
#pragma unroll
                for (int m = 0; m < 4; ++m)
#pragma unroll
                    for (int n = 0; n < 2; ++n) acc[a][b][m][n] = (f32x4){0.f, 0.f, 0.f, 0.f};
        cur = nxt; cA = nA; cB = nB; ++ui; gc[0][0] = gn[0][0]; gc[0][1] = gn[0][1]; gc[1][0] = gn[1][0]; gc[1][1] = gn[1][1];
        if constexpr (ALIGN_EPI) { if (wr == 1) PG8_BAR; }
    }
    PG8_WAIT_V(0);
    if constexpr (!ALIGN_EPI) { if (wr == 0) PG8_BAR; }
    PG8_BAR;
    if constexpr (Epi::AFTER_DRAIN) { E.fused(acc, cur, wr, wc, fr, fq, lds, wid, lane); S.done(cur); }
#undef PG8_SA
#undef PG8_SB
#undef PG8_STAGE
#undef PG8_STAGE_A
#undef PG8_GOFF
#undef PG8_LDA
#undef PG8_LDB
#undef PG8_MMA
#undef PG8_WAIT_V
#undef PG8_WAIT_L
#undef PG8_BAR
#undef PG8_SCHED
}
}

#define XB_TMO      128
#define XB_XCNT(j)  (256  + 64 * (j))
#define XB_XSUB(j)  (1280 + 64 * (j))
#define XB_XGEN(j)  (2304 + 64 * (j))
#define XB_TOP      3328
#define XB_TOPGEN   3392
#define XCD_BAR_WORDS 3456
#define XB_SPIN_CAP (1u << 23)
__device__ __forceinline__ unsigned xb_ld(unsigned* p)              { return __hip_atomic_load(p, __ATOMIC_RELAXED, __HIP_MEMORY_SCOPE_AGENT); }
__device__ __forceinline__ unsigned xb_add(unsigned* p, unsigned v) { return __hip_atomic_fetch_add(p, v, __ATOMIC_RELAXED, __HIP_MEMORY_SCOPE_AGENT); }
__device__ __forceinline__ unsigned xb_xcc_id() { return (unsigned)__builtin_amdgcn_s_getreg((3 << 11) | 20) & 0xFu; }
#define XB_SPIN(cond, bar) do { unsigned _sp = 0; while (cond) { __builtin_amdgcn_s_sleep(1); \
    if ((++_sp & 255u) == 0u) { if (xb_ld(&(bar)[XB_TMO])) break; if (_sp > XB_SPIN_CAP) { atomicAdd(&(bar)[XB_TMO], 1u); break; } } } } while (0)
struct XcdBarrier { unsigned* bar; unsigned x; volatile LAS unsigned* st; };
__device__ __forceinline__ XcdBarrier xcd_barrier_post(unsigned* bar, volatile LAS unsigned* st) {
    XcdBarrier b; b.bar = bar; b.x = xb_xcc_id(); b.st = st;
    if (threadIdx.x == 0) (void)xb_add(&bar[XB_XCNT(b.x)], 1u);
    return b;
}
__device__ __forceinline__ void xcd_barrier_complete(unsigned* bar, unsigned x, unsigned& nloc, unsigned& nx) {
    const unsigned G = gridDim.x * gridDim.y * gridDim.z;
    unsigned sum, cnt, mine, sp = 0u;
    for (;;) {
        sum = 0u; cnt = 0u; mine = 0u;
#pragma unroll
        for (unsigned j = 0; j < 16; ++j) { const unsigned c = xb_ld(&bar[XB_XCNT(j)]); sum += c; cnt += (c > 0u) ? 1u : 0u; mine = (j == x) ? c : mine; }
        if (sum == G) break;
        __builtin_amdgcn_s_sleep(1);
        if ((++sp & 255u) == 0u) { if (xb_ld(&bar[XB_TMO])) break; if (sp > XB_SPIN_CAP) { atomicAdd(&bar[XB_TMO], 1u); break; } }
    }
    nloc = mine > 0u ? mine : 1u; nx = cnt > 0u ? cnt : 1u;
}
__device__ __forceinline__ void xcd_barrier(const XcdBarrier& b) {
    asm volatile("s_waitcnt vmcnt(0)" ::: "memory");
    __syncthreads();
    if (threadIdx.x == 0) {
        unsigned* bar = b.bar;
        __builtin_amdgcn_s_waitcnt(0);
        unsigned nloc = b.st[0], nx = b.st[1];
        if (nloc == 0u) { xcd_barrier_complete(bar, b.x, nloc, nx); b.st[0] = nloc; b.st[1] = nx; }
        const unsigned old = xb_add(&bar[XB_XSUB(b.x)], 1u);
        const unsigned gen = old / nloc;
        if (old + 1u == (gen + 1u) * nloc) {
            __builtin_amdgcn_fence(__ATOMIC_RELEASE, "agent");
            asm volatile("s_waitcnt vmcnt(0)" ::: "memory");
            const unsigned og = xb_add(&bar[XB_TOP], 1u);
            const unsigned tg = og / nx;
            if (og + 1u == (tg + 1u) * nx) xb_add(&bar[XB_TOPGEN], 1u);
            else XB_SPIN(xb_ld(&bar[XB_TOPGEN]) == tg, bar);
            __builtin_amdgcn_fence(__ATOMIC_ACQUIRE, "agent");
            xb_add(&bar[XB_XGEN(b.x)], 1u);
            asm volatile("s_waitcnt vmcnt(0)" ::: "memory");
        } else {
            XB_SPIN(xb_ld(&bar[XB_XGEN(b.x)]) == gen, bar);
            __builtin_amdgcn_fence(__ATOMIC_ACQUIRE, "agent");
            asm volatile("s_waitcnt vmcnt(0)" ::: "memory");
        }
    }
    __syncthreads();
}

constexpr int NWAVES = 8, NTHR = 512;
constexpr int T = 32768, SEQ = 16384, D = 2048, NPROJ = 10752, NEXP = 32, TOPK = 4;
constexpr int C_R = 0, C_K = 1024, C_V = 2048, C_WD = 3072, C_AD = 3168, C_GD = 3264, C_QD = 3584, C_KD = 4608, C_VD = 5632, C_GA = 6656, C_GB = 8704;
constexpr int P_MAX = 131072 + 32 * 256;
constexpr int MAX_TILES = P_MAX / 256;
constexpr float ATT_C2 = 0.125f * 1.4426950408889634f;
constexpr float LAMBDA_INIT = 0.2f;

constexpr size_t MiB = 1u << 20;
constexpr size_t WS_CTL = 0, CTL_ZERO_BYTES = 64 * 1024;
constexpr size_t WS_MOD = 1 * MiB;
constexpr size_t WS_GS2 = WS_MOD + 128 * 1024;
constexpr size_t WS_WRT = WS_GS2 + 32 * 1024;
constexpr size_t WS_WGCNT = WS_WRT + 256 * 1024;
constexpr size_t WS_TILEEXP = WS_WGCNT + 32 * 1024;
constexpr size_t WS_ROPE = 2 * MiB;
constexpr size_t WS_TOPIDX = 3 * MiB;
constexpr size_t WS_TOPW = WS_TOPIDX + 512 * 1024;
constexpr size_t WS_SLOTPOS = 4 * MiB;
constexpr size_t WS_ROWTOK = WS_SLOTPOS + 512 * 1024;
constexpr size_t WS_ROWGATE = WS_ROWTOK + 576 * 1024;
constexpr size_t WS_BONUS = 6 * MiB;
constexpr size_t WS_BTLORA = 8 * MiB;
constexpr size_t WS_ROWSS = 12 * MiB;
constexpr size_t WS_WTIN = 16 * MiB;
constexpr size_t WS_WTBA = 58 * MiB, WS_WTBB = 60 * MiB, WS_WTOUT = 66 * MiB;
constexpr size_t WS_H = 74 * MiB;
constexpr size_t WS_PROJ = 202 * MiB;
constexpr size_t WS_MFRAG = 874 * MiB, WS_NFRAG = 938 * MiB, WS_PBUF = 1002 * MiB, WS_Y0 = 1066 * MiB, WS_SBUF = 1130 * MiB;
constexpr size_t WS_OB = 1194 * MiB, WS_OA = 1258 * MiB;
constexpr size_t WS_MERGED = 1322 * MiB;
constexpr size_t WS_OA8 = WS_MERGED, WS_OB8 = WS_MERGED + 32 * MiB, WS_MERGED8 = WS_MERGED + 64 * MiB;
constexpr size_t WS_VSC = 1194 * MiB;
constexpr size_t WS_MA = 1194 * MiB;
constexpr size_t WS_WTGU = 1450 * MiB;
constexpr size_t WS_WTDN = 1706 * MiB;
constexpr size_t WS_VT = 1834 * MiB;
constexpr size_t WS_QK8 = 1866 * MiB;
constexpr size_t WS_END = 1962 * MiB;
constexpr size_t WS_XS = WS_PROJ;
constexpr size_t WS_YR = WS_PROJ;
constexpr size_t WS_ACT = WS_MFRAG;
constexpr int F8_SW = 7, F8_SH = 4, F8_SA = 2, F8_SV = 4, F8_SQ = 6, F8_SK = 4;
constexpr int F8_SC_GU = (127 - F8_SW - F8_SH) * 0x01010101, F8_SC_DN = (127 - F8_SW - F8_SA) * 0x01010101;
static_assert((size_t)T * NPROJ * 2 <= WS_MFRAG - WS_PROJ && WS_YR + (size_t)P_MAX * 2048 * 2 <= WS_MFRAG && (size_t)P_MAX * 2048 <= WS_WTGU - WS_ACT, "ws map");
constexpr int CW_QUEUE = 4608;
constexpr int CW_BAR = 1024;

constexpr int RING_BYTES = 131072, MISC_OFF = RING_BYTES + 320, LDS_BYTES = 147456;

struct Args { const float* in[36]; float* out; unsigned char* ws; int ph_lo, ph_hi; };
struct Ctx {
    const Args& a;
    LAS unsigned char* lds;
    int tid, lane, wave, G, bid;
    float* out;
    unsigned char* ws;
    DI const float* x() const { return a.in[0]; }
    DI const float* c() const { return a.in[1]; }
    DI const float* w_ada() const { return a.in[2]; }
    DI const float* b_ada() const { return a.in[3]; }
    DI const float* norm1_gain() const { return a.in[4]; }
    DI const float* norm2_gain() const { return a.in[5]; }
    DI const float* w_in() const { return a.in[6]; }
    DI const float* shift_mu() const { return a.in[7]; }
    DI const float* w0() const { return a.in[8]; }
    DI const float* w_decay_up() const { return a.in[9]; }
    DI const float* a0() const { return a.in[10]; }
    DI const float* w_aaa_up() const { return a.in[11]; }
    DI const float* w_gate_up() const { return a.in[12]; }
    DI const float* k_k() const { return a.in[13]; }
    DI const float* k_a() const { return a.in[14]; }
    DI const float* r_k() const { return a.in[15]; }
    DI const float* gn_w() const { return a.in[16]; }
    DI const float* gn_b() const { return a.in[17]; }
    DI const float* q_gain() const { return a.in[18]; }
    DI const float* k_gain() const { return a.in[19]; }
    DI const float* lam_q1() const { return a.in[20]; }
    DI const float* lam_k1() const { return a.in[21]; }
    DI const float* lam_q2() const { return a.in[22]; }
    DI const float* lam_k2() const { return a.in[23]; }
    DI const float* subln_gain() const { return a.in[24]; }
    DI const float* w_branch_a() const { return a.in[25]; }
    DI const float* w_branch_b() const { return a.in[26]; }
    DI const float* w_out() const { return a.in[27]; }
    DI const float* w_router() const { return a.in[28]; }
    DI const float* b_router() const { return a.in[29]; }
    DI const float* w_exp_gate() const { return a.in[30]; }
    DI const float* b_exp_gate() const { return a.in[31]; }
    DI const float* w_exp_up() const { return a.in[32]; }
    DI const float* b_exp_up() const { return a.in[33]; }
    DI const float* w_exp_down() const { return a.in[34]; }
    DI const float* b_exp_down() const { return a.in[35]; }
};
#define WSP(type, off) ((type*)(C.ws + (off)))

DI unsigned pk4_fp8(float a, float b, float c, float d) {
    a = __builtin_amdgcn_fmed3f(a, -448.f, 448.f); b = __builtin_amdgcn_fmed3f(b, -448.f, 448.f); c = __builtin_amdgcn_fmed3f(c, -448.f, 448.f); d = __builtin_amdgcn_fmed3f(d, -448.f, 448.f);
    int p = __builtin_amdgcn_cvt_pk_fp8_f32(a, b, 0, false); p = __builtin_amdgcn_cvt_pk_fp8_f32(c, d, p, true); return (unsigned)p; }
struct EpiPlainBf16 {
    static constexpr bool PERM = true, AFTER_DRAIN = false, HAS_MID = false;
    bf16_t* O; int ldc;
    DI void operator()(const f32x4 (&acc)[2][2][4][2], const pg8::Unit& u, int wr, int wc, int fr, int fq) const {
        const int row0 = u.pm * 256 + wr * 64 + fr, col0 = u.pn * 256 + wc * 32 + 8 * fq;
#pragma unroll
        for (int ai = 0; ai < 2; ++ai)
#pragma unroll
            for (int m = 0; m < 4; ++m) { bf16_t* rowp = O + (size_t)(row0 + ai * 128 + m * 16) * ldc + col0;
#pragma unroll
                for (int bj = 0; bj < 2; ++bj) { const f32x4 v0 = acc[ai][bj][m][0], v1 = acc[ai][bj][m][1];
                    u32x4 w; w.x = pg8::cvt_pk_bf16(v0[0], v0[1]); w.y = pg8::cvt_pk_bf16(v0[2], v0[3]); w.z = pg8::cvt_pk_bf16(v1[0], v1[1]); w.w = pg8::cvt_pk_bf16(v1[2], v1[3]);
                    *(u32x4*)(rowp + bj * 128) = w; } }
    }
};
struct LoraOrder : pg8::StaticOrder {
    DI bool next(int i, pg8::Unit& u) const { if (!pg8::StaticOrder::next(i, u)) return false; if (u.pn >= 8) u.pm += T / 256; return true; }
};
struct EpiLora {
    static constexpr bool PERM = true, AFTER_DRAIN = false, HAS_MID = false;
    bf16_t* G0; const float *w0, *a0;
    DI void operator()(const f32x4 (&acc)[2][2][4][2], const pg8::Unit& u, int wr, int wc, int fr, int fq) const {
        const int sec = u.pn >> 2;
        bf16_t* base = G0 + (size_t)(sec == 2 ? 0 : sec + 1) * ((size_t)T * 1024);
        const int row0 = (u.pm & (T / 256 - 1)) * 256 + wr * 64 + fr, col0 = (u.pn & 3) * 256 + wc * 32 + 8 * fq;
        const float* bias = sec == 0 ? w0 : a0;
#pragma unroll
        for (int bj = 0; bj < 2; ++bj) {
            f32x4 b0 = (f32x4){0.f, 0.f, 0.f, 0.f}, b1 = b0;
            if (sec < 2) { b0 = *(const f32x4*)(bias + col0 + bj * 128); b1 = *(const f32x4*)(bias + col0 + bj * 128 + 4); }
#pragma unroll
            for (int ai = 0; ai < 2; ++ai)
#pragma unroll
                for (int m = 0; m < 4; ++m) {
                    f32x4 v0 = acc[ai][bj][m][0] + b0, v1 = acc[ai][bj][m][1] + b1;
                    if (sec == 0) {
#pragma unroll
                        for (int e = 0; e < 4; ++e) {
                            float z = -v0[e]; float sp = fmaxf(z, 0.f) + __logf(1.f + __expf(-fabsf(z))); v0[e] = -__expf(-sp - 0.5f);
                            z = -v1[e]; sp = fmaxf(z, 0.f) + __logf(1.f + __expf(-fabsf(z))); v1[e] = -__expf(-sp - 0.5f); }
                    } else if (sec == 1) {
#pragma unroll
                        for (int e = 0; e < 4; ++e) { v0[e] = sigmoidf_(v0[e]); v1[e] = sigmoidf_(v1[e]); }
                    }
                    u32x4 w; w.x = pg8::cvt_pk_bf16(v0[0], v0[1]); w.y = pg8::cvt_pk_bf16(v0[2], v0[3]); w.z = pg8::cvt_pk_bf16(v1[0], v1[1]); w.w = pg8::cvt_pk_bf16(v1[2], v1[3]);
                    *(u32x4*)(base + (size_t)(row0 + ai * 128 + m * 16) * 1024 + col0 + bj * 128) = w;
                }
        }
    }
};
struct BranchOrder : pg8::StaticOrder {
    DI bool next(int i, pg8::Unit& u) const { if (!pg8::StaticOrder::next(i >> 1, u)) return false; if (i & 1) { u.pm += T / 256; u.pn += D / 256; } return true; }
    DI bool partial(const pg8::Unit& u) const { return u.pm < T / 256; }
};
struct EpiBranchFused {
    static constexpr bool PERM = true, AFTER_DRAIN = false, HAS_MID = true;
    unsigned char* O8; const bf16_t* proj;
    DI void mid(f32x4 (&acc)[2][2][4][2], const pg8::Unit& u, int wr, int wc, int fr, int fq) const {
        const int row0 = u.pm * 256 + wr * 64 + fr, col0 = u.pn * 256 + wc * 32 + 8 * fq;
#pragma unroll
        for (int ai = 0; ai < 2; ++ai)
#pragma unroll
            for (int m = 0; m < 4; ++m) { const size_t row = (size_t)(row0 + ai * 128 + m * 16);
#pragma unroll
                for (int bj = 0; bj < 2; ++bj) {
                    const u32x4 ga = *(const u32x4*)(proj + row * NPROJ + C_GA + col0 + bj * 128), gb = *(const u32x4*)(proj + row * NPROJ + C_GB + col0 + bj * 128);
                    const unsigned gaw[4] = {ga.x, ga.y, ga.z, ga.w}, gbw[4] = {gb.x, gb.y, gb.z, gb.w};
#pragma unroll
                    for (int q = 0; q < 4; ++q) {
                        const float r0 = (1.f + __expf(-bflo(gbw[q]))) * __builtin_amdgcn_rcpf(1.f + __expf(-bflo(gaw[q]))), r1 = (1.f + __expf(-bfhi(gbw[q]))) * __builtin_amdgcn_rcpf(1.f + __expf(-bfhi(gaw[q])));
                        acc[ai][bj][m][q >> 1][2 * (q & 1)] *= r0; acc[ai][bj][m][q >> 1][2 * (q & 1) + 1] *= r1; } } }
    }
    DI void operator()(const f32x4 (&acc)[2][2][4][2], const pg8::Unit& u, int wr, int wc, int fr, int fq) const {
        const int row0 = (u.pm - T / 256) * 256 + wr * 64 + fr, col0 = (u.pn - D / 256) * 256 + wc * 32 + 8 * fq; const float s_ = (float)(1 << F8_SH);
#pragma unroll
        for (int ai = 0; ai < 2; ++ai) {
            u32x4 gbv[4][2];
#pragma unroll
            for (int m = 0; m < 4; ++m)
#pragma unroll
                for (int bj = 0; bj < 2; ++bj) gbv[m][bj] = *(const u32x4*)(proj + (size_t)(row0 + ai * 128 + m * 16) * NPROJ + C_GB + col0 + bj * 128);
#pragma unroll
            for (int m = 0; m < 4; ++m) { const size_t row = (size_t)(row0 + ai * 128 + m * 16);
#pragma unroll
                for (int bj = 0; bj < 2; ++bj) {
                    const u32x4 gb = gbv[m][bj];
                    f32x4 v0 = acc[ai][bj][m][0], v1 = acc[ai][bj][m][1];
                    v0[0] *= sigmoidf_(bflo(gb.x)) * s_; v0[1] *= sigmoidf_(bfhi(gb.x)) * s_; v0[2] *= sigmoidf_(bflo(gb.y)) * s_; v0[3] *= sigmoidf_(bfhi(gb.y)) * s_;
                    v1[0] *= sigmoidf_(bflo(gb.z)) * s_; v1[1] *= sigmoidf_(bfhi(gb.z)) * s_; v1[2] *= sigmoidf_(bflo(gb.w)) * s_; v1[3] *= sigmoidf_(bfhi(gb.w)) * s_;
                    *(u32x2*)(O8 + row * 2048 + col0 + bj * 128) = (u32x2){pk4_fp8(v0[0], v0[1], v0[2], v0[3]), pk4_fp8(v1[0], v1[1], v1[2], v1[3])}; } }
        }
    }
};
template <bool ADD> struct EpiBranch {
    static constexpr bool PERM = true, AFTER_DRAIN = false, HAS_MID = false;
    bf16_t* MA; unsigned char* O8; const bf16_t* proj; int gcol0;
    DI void operator()(const f32x4 (&acc)[2][2][4][2], const pg8::Unit& u, int wr, int wc, int fr, int fq) const {
        const int row0 = u.pm * 256 + wr * 64 + fr, col0 = u.pn * 256 + wc * 32 + 8 * fq;
#pragma unroll
        for (int ai = 0; ai < 2; ++ai) {
            u32x4 gwv[4][2], pwv[4][2];
#pragma unroll
            for (int m = 0; m < 4; ++m)
#pragma unroll
                for (int bj = 0; bj < 2; ++bj) { const size_t row = (size_t)(row0 + ai * 128 + m * 16);
                    gwv[m][bj] = *(const u32x4*)(proj + row * NPROJ + gcol0 + col0 + bj * 128);
                    if (ADD) pwv[m][bj] = *(const u32x4*)(MA + row * 2048 + col0 + bj * 128); }
#pragma unroll
            for (int m = 0; m < 4; ++m) { const size_t row = (size_t)(row0 + ai * 128 + m * 16);
#pragma unroll
                for (int bj = 0; bj < 2; ++bj) {
                    const u32x4 gw = gwv[m][bj];
                    f32x4 v0 = acc[ai][bj][m][0], v1 = acc[ai][bj][m][1];
                    v0[0] *= sigmoidf_(bflo(gw.x)); v0[1] *= sigmoidf_(bfhi(gw.x)); v0[2] *= sigmoidf_(bflo(gw.y)); v0[3] *= sigmoidf_(bfhi(gw.y));
                    v1[0] *= sigmoidf_(bflo(gw.z)); v1[1] *= sigmoidf_(bfhi(gw.z)); v1[2] *= sigmoidf_(bflo(gw.w)); v1[3] *= sigmoidf_(bfhi(gw.w));
                    if (ADD) { const u32x4 pw = pwv[m][bj]; const float s_ = (float)(1 << F8_SH);
                        v0[0] += bflo(pw.x); v0[1] += bfhi(pw.x); v0[2] += bflo(pw.y); v0[3] += bfhi(pw.y);
                        v1[0] += bflo(pw.z); v1[1] += bfhi(pw.z); v1[2] += bflo(pw.w); v1[3] += bfhi(pw.w);
                        *(u32x2*)(O8 + row * 2048 + col0 + bj * 128) = (u32x2){pk4_fp8(v0[0] * s_, v0[1] * s_, v0[2] * s_, v0[3] * s_), pk4_fp8(v1[0] * s_, v1[1] * s_, v1[2] * s_, v1[3] * s_)};
                    } else {
                        u32x4 w; w.x = pg8::cvt_pk_bf16(v0[0], v0[1]); w.y = pg8::cvt_pk_bf16(v0[2], v0[3]); w.z = pg8::cvt_pk_bf16(v1[0], v1[1]); w.w = pg8::cvt_pk_bf16(v1[2], v1[3]);
                        *(u32x4*)(MA + row * 2048 + col0 + bj * 128) = w; } } }
        }
    }
};
struct EpiOut {
    static constexpr bool PERM = false, AFTER_DRAIN = false, HAS_MID = false;
    float* O; const float* X; const float* mod; float* rowss;
    DI void operator()(const f32x4 (&acc)[2][2][4][2], const pg8::Unit& u, int wr, int wc, int fr, int fq) const {
        const int row0 = u.pm * 256 + wr * 64 + fr, col0 = u.pn * 256 + wc * 32 + 4 * fq;
        const float* g1 = mod + (size_t)((u.pm * 256) / SEQ) * 12288 + 4096;
        f32x4 gv[2][2];
#pragma unroll
        for (int bj = 0; bj < 2; ++bj)
#pragma unroll
            for (int n = 0; n < 2; ++n) gv[bj][n] = *(const f32x4*)(g1 + col0 + bj * 128 + n * 16);
#pragma unroll
        for (int ai = 0; ai < 2; ++ai) {
            f32x4 xv[4][2][2];
#pragma unroll
            for (int m = 0; m < 4; ++m)
#pragma unroll
                for (int bj = 0; bj < 2; ++bj)
#pragma unroll
                    for (int n = 0; n < 2; ++n) xv[m][bj][n] = *(const f32x4*)(X + (size_t)(row0 + ai * 128 + m * 16) * 2048 + col0 + bj * 128 + n * 16);
#pragma unroll
            for (int m = 0; m < 4; ++m) { const size_t ro = (size_t)(row0 + ai * 128 + m * 16) * 2048 + col0; float ss = 0.f;
#pragma unroll
                for (int bj = 0; bj < 2; ++bj)
#pragma unroll
                    for (int n = 0; n < 2; ++n) {
                        const f32x4 ov = xv[m][bj][n] + gv[bj][n] * acc[ai][bj][m][n]; ss += (ov[0] * ov[0] + ov[1] * ov[1]) + (ov[2] * ov[2] + ov[3] * ov[3]);
                        *(f32x4*)(O + ro + bj * 128 + n * 16) = ov; }
                ss = sum_x32(sum_x16(ss));
                if (fq == 0) rowss[(size_t)(row0 + ai * 128 + m * 16) * 32 + u.pn * 4 + wc] = ss; }
        }
    }
};
struct EpiGateUp {
    static constexpr bool PERM = true, AFTER_DRAIN = false, HAS_MID = false;
    unsigned char* ACT; const float *bg, *bu;
    DI void operator()(const f32x4 (&acc)[2][2][4][2], const pg8::Unit& u, int wr, int wc, int fr, int fq) const {
        const int e = u.pn >> 4, ct = u.pn & 15;
        const int row0 = u.pm * 256 + wr * 64 + fr, col0 = ct * 128 + wc * 32 + 8 * fq;
        const f32x4 g0 = *(const f32x4*)(bg + e * 2048 + col0), g1 = *(const f32x4*)(bg + e * 2048 + col0 + 4);
        const f32x4 u0 = *(const f32x4*)(bu + e * 2048 + col0), u1 = *(const f32x4*)(bu + e * 2048 + col0 + 4);
#pragma unroll
        for (int ai = 0; ai < 2; ++ai)
#pragma unroll
            for (int m = 0; m < 4; ++m) {
                f32x4 gt0 = acc[ai][0][m][0] + g0, gt1 = acc[ai][0][m][1] + g1, up0 = acc[ai][1][m][0] + u0, up1 = acc[ai][1][m][1] + u1, r0, r1;
#pragma unroll
                for (int k = 0; k < 4; ++k) {
                    float g = fminf(gt0[k], 7.f), p = __builtin_amdgcn_fmed3f(up0[k], -7.f, 7.f); r0[k] = (p + 1.f) * g * __builtin_amdgcn_rcpf(1.f + __builtin_amdgcn_exp2f(g * (-1.702f * 1.4426950408889634f)));
                    g = fminf(gt1[k], 7.f); p = __builtin_amdgcn_fmed3f(up1[k], -7.f, 7.f); r1[k] = (p + 1.f) * g * __builtin_amdgcn_rcpf(1.f + __builtin_amdgcn_exp2f(g * (-1.702f * 1.4426950408889634f))); }
                const float sa = (float)(1 << F8_SA);
                *(u32x2*)(ACT + (size_t)(row0 + ai * 128 + m * 16) * 2048 + col0) = (u32x2){pk4_fp8(r0[0] * sa, r0[1] * sa, r0[2] * sa, r0[3] * sa), pk4_fp8(r1[0] * sa, r1[1] * sa, r1[2] * sa, r1[3] * sa)};
            }
    }
};
struct EpiDown {
    static constexpr bool PERM = true, AFTER_DRAIN = false, HAS_MID = false;
    bf16_t* Y; const float* bd; const float* row_gate;
    DI void operator()(const f32x4 (&acc)[2][2][4][2], const pg8::Unit& u, int wr, int wc, int fr, int fq) const {
        const int e = u.pn >> 3, ct = u.pn & 7;
        const int row0 = u.pm * 256 + wr * 64 + fr, col0 = ct * 256 + wc * 32 + 8 * fq;
        f32x4 bv[2][2]; float gwv[2][4];
#pragma unroll
        for (int bj = 0; bj < 2; ++bj) { bv[bj][0] = *(const f32x4*)(bd + e * 2048 + col0 + bj * 128); bv[bj][1] = *(const f32x4*)(bd + e * 2048 + col0 + bj * 128 + 4); }
#pragma unroll
        for (int ai = 0; ai < 2; ++ai)
#pragma unroll
            for (int m = 0; m < 4; ++m) gwv[ai][m] = row_gate[row0 + ai * 128 + m * 16];
#pragma unroll
        for (int ai = 0; ai < 2; ++ai)
#pragma unroll
            for (int m = 0; m < 4; ++m) { const int row = row0 + ai * 128 + m * 16; const float gw = gwv[ai][m];
#pragma unroll
                for (int bj = 0; bj < 2; ++bj) {
                    const f32x4 b0 = bv[bj][0], b1 = bv[bj][1];
                    const f32x4 v0 = (acc[ai][bj][m][0] + b0) * gw, v1 = (acc[ai][bj][m][1] + b1) * gw;
                    u32x4 w; w.x = pg8::cvt_pk_bf16(v0[0], v0[1]); w.y = pg8::cvt_pk_bf16(v0[2], v0[3]); w.z = pg8::cvt_pk_bf16(v1[0], v1[1]); w.w = pg8::cvt_pk_bf16(v1[2], v1[3]);
                    *(u32x4*)(Y + (size_t)row * 2048 + col0 + bj * 128) = w; } }
    }
};
struct MoeOrder {
    const int* tile_tab; int NCT, G, c; const int* rowtok;
    DI bool next(int i, pg8::Unit& u) const {
        const int n_tiles = tile_tab[0]; const long L = (long)i * G + c;
        const int RB = 256 / NCT;
        const int blk = (int)(L >> 8), l = (int)(L & 255), x = l >> 5, s = l & 31;
        int rt, ct;
        if (NCT == 16) { rt = blk * RB + 4 * (x >> 1) + (s >> 3); ct = 8 * (x & 1) + (s & 7); }
        else { rt = blk * RB + 4 * x + (s >> 3); ct = s & 7; }
        if (G != 256 || NCT * RB != 256) { if (L >= (long)n_tiles * NCT) return false; rt = (int)(L / NCT); ct = (int)(L % NCT); }
        else if (blk * RB >= n_tiles) return false;
        if (rt >= n_tiles) return false;
        u.pm = rt; u.pn = tile_tab[16 + rt] * NCT + ct; return true;
    }
    DI void a_ready(const pg8::Unit&) const {}
    DI void done(const pg8::Unit&) const {}
};
DI void transpose_item(const float* src, int ld_src, int k0, int n0, bf16_t* dst, int ld_dst, size_t drow0, int dcol0, LAS float* scr, int lane) {
#pragma unroll 8
    for (int i = 0; i < 32; ++i) { const int kk = 2 * i + (lane >> 5); scr[kk * 33 + (lane & 31)] = src[(size_t)(k0 + kk) * ld_src + n0 + (lane & 31)]; }
    asm volatile("s_waitcnt lgkmcnt(0)" ::: "memory");
    const int c = lane & 7;
#pragma unroll
    for (int j = 0; j < 4; ++j) { const int n = (lane >> 3) + 8 * j; const LAS float* s = scr + (8 * c) * 33 + n;
        u32x4 o; o.x = pk2(s[0 * 33], s[1 * 33]); o.y = pk2(s[2 * 33], s[3 * 33]); o.z = pk2(s[4 * 33], s[5 * 33]); o.w = pk2(s[6 * 33], s[7 * 33]);
        *(u32x4*)(dst + (drow0 + n) * (size_t)ld_dst + dcol0 + 8 * c) = o; }
    asm volatile("s_waitcnt lgkmcnt(0)" ::: "memory");
}
DI void transpose_item_f8(const float* src, int ld_src, int k0, int n0, unsigned char* dst, int ld_dst, size_t drow0, int dcol0, LAS float* scr, int lane) {
#pragma unroll 8
    for (int i = 0; i < 32; ++i) { const int kk = 2 * i + (lane >> 5); scr[kk * 33 + (lane & 31)] = src[(size_t)(k0 + kk) * ld_src + n0 + (lane & 31)]; }
    asm volatile("s_waitcnt lgkmcnt(0)" ::: "memory");
    const int c = lane & 7; const float sw = (float)(1 << F8_SW);
#pragma unroll
    for (int j = 0; j < 4; ++j) { const int n = (lane >> 3) + 8 * j; const LAS float* s = scr + (8 * c) * 33 + n;
        const u32x2 o = {pk4_fp8(s[0 * 33] * sw, s[1 * 33] * sw, s[2 * 33] * sw, s[3 * 33] * sw), pk4_fp8(s[4 * 33] * sw, s[5 * 33] * sw, s[6 * 33] * sw, s[7 * 33] * sw)};
        *(u32x2*)(dst + (drow0 + n) * (size_t)ld_dst + dcol0 + 8 * c) = o; }
    asm volatile("s_waitcnt lgkmcnt(0)" ::: "memory");
}
DI void transpose64_f8(const float* src, int ld_src, int k0, int n0, unsigned char* dst, int ld_dst, size_t drow0, int dcol0, int lane) {
    const float* s = src + (size_t)k0 * ld_src + n0 + lane; const float sw = (float)(1 << F8_SW);
    float v[64];
#pragma unroll
    for (int k = 0; k < 64; ++k) v[k] = s[(size_t)k * ld_src];
    unsigned char* d = dst + (drow0 + lane) * (size_t)ld_dst + dcol0;
#pragma unroll
    for (int q = 0; q < 4; ++q) { u32x4 o;
        o.x = pk4_fp8(v[16 * q + 0] * sw, v[16 * q + 1] * sw, v[16 * q + 2] * sw, v[16 * q + 3] * sw); o.y = pk4_fp8(v[16 * q + 4] * sw, v[16 * q + 5] * sw, v[16 * q + 6] * sw, v[16 * q + 7] * sw);
        o.z = pk4_fp8(v[16 * q + 8] * sw, v[16 * q + 9] * sw, v[16 * q + 10] * sw, v[16 * q + 11] * sw); o.w = pk4_fp8(v[16 * q + 12] * sw, v[16 * q + 13] * sw, v[16 * q + 14] * sw, v[16 * q + 15] * sw);
        *(u32x4*)(d + 16 * q) = o; }
}
DI void zero_item_f8(unsigned char* dst, int ld_dst, size_t drow0, int dcol0, int lane) {
    const int c = lane & 7;
#pragma unroll
    for (int j = 0; j < 4; ++j) { const int n = (lane >> 3) + 8 * j; *(u32x2*)(dst + (drow0 + n) * (size_t)ld_dst + dcol0 + 8 * c) = (u32x2){0u, 0u}; }
}
DI void zero_item(bf16_t* dst, int ld_dst, size_t drow0, int dcol0, int lane) {
    const int c = lane & 7;
#pragma unroll
    for (int j = 0; j < 4; ++j) { const int n = (lane >> 3) + 8 * j; *(u32x4*)(dst + (drow0 + n) * (size_t)ld_dst + dcol0 + 8 * c) = (u32x4){0u, 0u, 0u, 0u}; }
}
DI void sincos_d(double x, float& s, float& c) {
    const double n = __builtin_rint(x * 0.63661977236758134308);
    const double r = (x - n * 1.5707963267948966192) - n * 6.123233995736766e-17;
    const double r2 = r * r;
    double sp = -7.647163731819816e-13; sp = sp * r2 + 1.605904383682161e-10; sp = sp * r2 - 2.505210838544172e-08; sp = sp * r2 + 2.755731922398589e-06;
    sp = sp * r2 - 1.984126984126984e-04; sp = sp * r2 + 8.333333333333333e-03; sp = sp * r2 - 1.666666666666667e-01; sp = r + r * r2 * sp;
    double cp = 4.779477332387385e-14; cp = cp * r2 - 1.147074559772972e-11; cp = cp * r2 + 2.087675698786810e-09; cp = cp * r2 - 2.755731922398589e-07;
    cp = cp * r2 + 2.480158730158730e-05; cp = cp * r2 - 1.388888888888889e-03; cp = cp * r2 + 4.166666666666666e-02; cp = cp * r2 - 0.5; cp = 1.0 + r2 * cp;
    const int q = ((int)n) & 3;
    const double ss = (q == 0) ? sp : (q == 1) ? cp : (q == 2) ? -sp : -cp;
    const double cc = (q == 0) ? cp : (q == 1) ? -sp : (q == 2) ? -cp : sp;
    s = (float)ss; c = (float)cc;
}
DI void phase_prologue(Ctx& C) {
    const int gw = C.bid * NWAVES + C.wave, NGW = C.G * NWAVES;
    const int gt = C.bid * NTHR + C.tid, NGT = C.G * NTHR;
    {
        LAS float* sc = (LAS float*)(C.lds + 70000);
        LAS float* red = (LAS float*)(C.lds + 90000);
        for (int i = C.tid; i < 4096; i += NTHR) { const float v = C.c()[i]; sc[i] = v / (1.f + __expf(-v)); }
        __syncthreads();
        float* mod = WSP(float, WS_MOD);
        for (int cb = C.bid; cb < 256; cb += C.G) {
            const int j0 = cb * 48;
            if (C.tid < 504) {
                const int cq = C.tid % 12, kg = C.tid / 12;
                f32x4 a0 = (f32x4){0.f, 0.f, 0.f, 0.f}, a1 = a0;
#pragma clang loop unroll(disable)
                for (int kb = 0; kb < 52; kb += 13) {
                    f32x4 wv[13];
#pragma unroll
                    for (int u = 0; u < 13; ++u) { const int kk = kg + 42 * (kb + u), kc = kk < 2048 ? kk : 2047; wv[u] = *(const f32x4*)(C.w_ada() + (size_t)kc * 12288 + j0 + 4 * cq); }
#pragma unroll
                    for (int u = 0; u < 13; ++u) { const int kk = kg + 42 * (kb + u); const bool ok = kk < 2048; const int kc = ok ? kk : 2047; const float c0 = ok ? sc[kc] : 0.f, c1 = ok ? sc[2048 + kc] : 0.f; a0 += wv[u] * c0; a1 += wv[u] * c1; }
                }
                LAS float* r = red + (kg * 12 + cq) * 8;
                r[0] = a0[0]; r[1] = a0[1]; r[2] = a0[2]; r[3] = a0[3]; r[4] = a1[0]; r[5] = a1[1]; r[6] = a1[2]; r[7] = a1[3];
            }
            __syncthreads();
            if (C.tid < 96) { const int b = C.tid / 48, j = C.tid % 48, cq = j >> 2, e = j & 3; float s = 0.f;
                for (int kg = 0; kg < 42; ++kg) s += red[(kg * 12 + cq) * 8 + b * 4 + e];
                mod[b * 12288 + j0 + j] = s + C.b_ada()[j0 + j]; }
            __syncthreads();
        }
    }
    {
        f32x2* rope = WSP(f32x2, WS_ROPE);
        for (int i = gt; i < SEQ * 8; i += NGT) { const int pos = i >> 3, fi = i & 7;
            const float invf = fi == 0 ? 1.0f : fi == 1 ? 0.1939227432012558f : fi == 2 ? 0.03760603070259094f : fi == 3 ? 0.007292664609849453f :
                               fi == 4 ? 0.0014142135623842478f : fi == 5 ? 0.00027424818836152554f : fi == 6 ? 5.3182957344688475e-05f : 1.0313385246263351e-05f;
            const float ang = (float)pos * invf; float s, c; sincos_d((double)ang, s, c); rope[i] = (f32x2){c, s}; }
    }
    {
        bf16_t* bl = WSP(bf16_t, WS_BTLORA);
        for (int i = gt; i < 3072 * 256; i += NGT) { const int n = i >> 8, k = i & 255; float v = 0.f;
            if (n < 1024) { if (k < 96) v = C.w_decay_up()[k * 1024 + n]; }
            else if (n < 2048) { if (k >= 128 && k < 224) v = C.w_aaa_up()[(k - 128) * 1024 + (n - 1024)]; }
            else v = C.w_gate_up()[k * 1024 + (n - 2048)];
            bl[i] = (bf16_t)f2bf(v); }
        bf16_t* wr = WSP(bf16_t, WS_WRT);
        for (int i = gt; i < 32 * 2048; i += NGT) { const int e = i >> 11, k = i & 2047; const float v = C.w_router()[k * 32 + e];
            const unsigned h = f2bf(v); wr[i] = (bf16_t)h; wr[65536 + i] = (bf16_t)f2bf(v - bf2f(h)); }
    }
    {
        LAS float* scr = (LAS float*)(C.lds + C.wave * 8448);
        constexpr int I_IN = 32 * 336, I_GU = 32 * 32 * 32  , I_BR = 16 * 64, I_OUT = 32 * 64;
        constexpr int NITEMS = I_IN + 3 * I_GU + 2 * I_BR + I_OUT;
        unsigned char* wtin = WSP(unsigned char, WS_WTIN); unsigned char* wtgu = WSP(unsigned char, WS_WTGU); unsigned char* wtdn = WSP(unsigned char, WS_WTDN);
        for (int it = gw; it < NITEMS; it += NGW) {
            int r = it;
            if (r < I_IN) { const int kb = r / 336, nb = r % 336;
                if (nb == 110 || nb == 111) zero_item_f8(wtin, 2048, (size_t)nb * 32, kb * 64, C.lane);
                else transpose_item_f8(C.w_in(), 10688, kb * 64, (nb < 110 ? nb : nb - 2) * 32, wtin, 2048, (size_t)nb * 32, kb * 64, scr, C.lane);
                continue; } r -= I_IN;
            if (r < 3 * I_GU) { const int which = r / I_GU; r %= I_GU; const int e = r >> 10, kb = (r >> 5) & 31, nb = r & 31, n0 = nb * 64;
                if (which < 2) transpose64_f8((which ? C.w_exp_up() : C.w_exp_gate()) + (size_t)e * 2048 * 2048, 2048, kb * 64, n0, wtgu, 2048, (size_t)e * 4096 + (n0 >> 7) * 256 + which * 128 + (n0 & 127), kb * 64, C.lane);
                else transpose64_f8(C.w_exp_down() + (size_t)e * 2048 * 2048, 2048, kb * 64, n0, wtdn, 2048, (size_t)e * 2048 + n0, kb * 64, C.lane);
                continue; } r -= 3 * I_GU;
            if (r < I_BR) { transpose_item_f8(C.w_branch_a(), 2048, (r >> 6) * 64, (r & 63) * 32, WSP(unsigned char, WS_WTBA), 1024, (size_t)(r & 63) * 32, (r >> 6) * 64, scr, C.lane); continue; } r -= I_BR;
            if (r < I_BR) { transpose_item_f8(C.w_branch_b(), 2048, (r >> 6) * 64, (r & 63) * 32, WSP(unsigned char, WS_WTBB), 1024, (size_t)(r & 63) * 32, (r >> 6) * 64, scr, C.lane); continue; } r -= I_BR;
            transpose_item_f8(C.w_out(), 2048, (r >> 6) * 64, (r & 63) * 32, WSP(unsigned char, WS_WTOUT), 2048, (size_t)(r & 63) * 32, (r >> 6) * 64, scr, C.lane);
        }
    }
}
DI void phase_norm1(Ctx& C) {
    const int gw = C.bid * NWAVES + C.wave, NGW = C.G * NWAVES;
    const float* mod = WSP(float, WS_MOD);
    if (C.bid == 0) {
        float* gs2 = WSP(float, WS_GS2);
        for (int i = C.tid; i < 4096; i += NTHR) { const int b = i >> 11, k = i & 2047; gs2[i] = C.norm2_gain()[k] * (1.f + mod[b * 12288 + 4 * 2048 + k]); }
    }
    unsigned char* H = WSP(unsigned char, WS_H);
    for (int rb = gw; rb < T / 16; rb += NGW) {
        const int b = (rb * 16) / SEQ;
        f32x4 gs[8], sh[8];
#pragma unroll
        for (int j = 0; j < 8; ++j) { const int k = 4 * C.lane + 256 * j;
            const f32x4 g = *(const f32x4*)(C.norm1_gain() + k), s = *(const f32x4*)(mod + b * 12288 + 2048 + k);
            gs[j] = g * (s + 1.f); sh[j] = *(const f32x4*)(mod + b * 12288 + k); }
        for (int i = 0; i < 16; ++i) {
            const size_t row = (size_t)rb * 16 + i;
            const f32x4* xr = (const f32x4*)(C.x() + row * D) + C.lane;
            f32x4 v[8]; float s = 0.f;
#pragma unroll
            for (int j = 0; j < 8; ++j) { v[j] = xr[64 * j]; s += (v[j][0] * v[j][0] + v[j][1] * v[j][1]) + (v[j][2] * v[j][2] + v[j][3] * v[j][3]); }
            const float rstd = 1.f / sqrtf(wave_sum(s) * (1.f / D) + 1e-6f);
            unsigned* o4 = (unsigned*)(H + row * D) + C.lane; const float sc_ = (float)(1 << F8_SH);
#pragma unroll
            for (int j = 0; j < 8; ++j) { const f32x4 y = (v[j] * rstd * gs[j] + sh[j]) * sc_; o4[64 * j] = pk4_fp8(y[0], y[1], y[2], y[3]); }
        }
    }
}


DI bf16x8 pack_step(const f32x16& x, int s) {
    u32x4 p; p.x = cvtpk(x[8 * s], x[8 * s + 1]); p.y = cvtpk(x[8 * s + 2], x[8 * s + 3]); p.z = cvtpk(x[8 * s + 4], x[8 * s + 5]); p.w = cvtpk(x[8 * s + 6], x[8 * s + 7]);
    return __builtin_bit_cast(bf16x8, p);
}

DI void phase_prep(Ctx& C) {
    const int gw = C.bid * NWAVES + C.wave, NGW = C.G * NWAVES;
    bf16_t* proj = WSP(bf16_t, WS_PROJ); bf16_t* lin = WSP(bf16_t, WS_OB);
    const f32x2* rope = WSP(f32x2, WS_ROPE);
    {   unsigned char* vt = WSP(unsigned char, WS_VT); const float sv = (float)(1 << F8_SV);
        for (int task = gw; task < 16 * 256; task += NGW) {
            const int bh = task >> 8, kt = task & 255; const size_t row0 = (size_t)(bh >> 3) * SEQ + (size_t)kt * 64;
            const bf16_t* vp = proj + row0 * NPROJ + C_VD + (bh & 7) * 128 + 2 * C.lane;
            unsigned kv[64];
#pragma unroll
            for (int k = 0; k < 64; ++k) kv[k] = *(const unsigned*)(vp + (size_t)k * NPROJ);
            u32x4 o0[4], o1[4];
#pragma unroll
            for (int i = 0; i < 16; ++i) { const int k0 = 8 * (i & 3) + 4 * (i >> 3) + 32 * ((i >> 2) & 1);
                const unsigned a = pk4_fp8(bflo(kv[k0]) * sv, bflo(kv[k0 + 1]) * sv, bflo(kv[k0 + 2]) * sv, bflo(kv[k0 + 3]) * sv), b = pk4_fp8(bfhi(kv[k0]) * sv, bfhi(kv[k0 + 1]) * sv, bfhi(kv[k0 + 2]) * sv, bfhi(kv[k0 + 3]) * sv);
                o0[i >> 2][i & 3] = a; o1[i >> 2][i & 3] = b; }
            unsigned char* dst = vt + ((size_t)task * 128 + 2 * C.lane) * 64;
#pragma unroll
            for (int q = 0; q < 4; ++q) { *(u32x4*)(dst + 16 * q) = o0[q]; *(u32x4*)(dst + 64 + 16 * q) = o1[q]; }
        }
    }
    for (int t = gw; t < T; t += NGW) {
        const int pos = t % SEQ;
        const bf16_t* pr = proj + (size_t)t * NPROJ; const bf16_t* pp = pr - NPROJ;
        {
            const int l = C.lane; u32x4 o = {0u, 0u, 0u, 0u}; int j0;
            if (l < 56) {
                const int col = C_WD + 8 * l; const int kind = l < 12 ? 1 : (l < 24 ? 2 : 3);
                j0 = l < 12 ? 8 * l : (l < 24 ? 128 + 8 * (l - 12) : 256 + 8 * (l - 24));
                const u32x4 cw = *(const u32x4*)(pr + col); u32x4 pw = {0u, 0u, 0u, 0u}; if (pos > 0) pw = *(const u32x4*)(pp + col);
                const f32x4 m0 = *(const f32x4*)(C.shift_mu() + col), m1 = *(const f32x4*)(C.shift_mu() + col + 4);
                const float cv[8] = {bflo(cw.x), bfhi(cw.x), bflo(cw.y), bfhi(cw.y), bflo(cw.z), bfhi(cw.z), bflo(cw.w), bfhi(cw.w)};
                const float pv[8] = {bflo(pw.x), bfhi(pw.x), bflo(pw.y), bfhi(pw.y), bflo(pw.z), bfhi(pw.z), bflo(pw.w), bfhi(pw.w)};
                const float mu[8] = {m0[0], m0[1], m0[2], m0[3], m1[0], m1[1], m1[2], m1[3]};
                float r[8];
#pragma unroll
                for (int e = 0; e < 8; ++e) { const float sft = cv[e] + (pv[e] - cv[e]) * mu[e];
                    r[e] = kind == 1 ? (1.f - 2.f * __builtin_amdgcn_rcpf(__expf(2.f * sft) + 1.f)) : (kind == 2 ? sft : sigmoidf_(sft)); }
                o = (u32x4){cvtpk(r[0], r[1]), cvtpk(r[2], r[3]), cvtpk(r[4], r[5]), cvtpk(r[6], r[7])};
            } else { j0 = l < 60 ? 96 + 8 * (l - 56) : 224 + 8 * (l - 60); }
            *(u32x4*)(lin + (j0 < 256 ? (size_t)t * 256 + j0 : (size_t)T * 256 + (size_t)t * 256 + (j0 - 256))) = o;
        }
        {
            const int g = C.lane >> 1, half = C.lane & 1;
            bf16_t* gp = proj + (size_t)t * NPROJ + C_QD + g * 64 + half * 32;
            u32x4 w[4]; float v[32];
#pragma unroll
            for (int i = 0; i < 4; ++i) w[i] = *(const u32x4*)(gp + 8 * i);
            float ss = 0.f;
#pragma unroll
            for (int i = 0; i < 4; ++i) { v[8 * i + 0] = bflo(w[i].x); v[8 * i + 1] = bfhi(w[i].x); v[8 * i + 2] = bflo(w[i].y); v[8 * i + 3] = bfhi(w[i].y);
                v[8 * i + 4] = bflo(w[i].z); v[8 * i + 5] = bfhi(w[i].z); v[8 * i + 6] = bflo(w[i].w); v[8 * i + 7] = bfhi(w[i].w); }
#pragma unroll
            for (int d = 0; d < 32; ++d) ss += v[d] * v[d];
            ss += DPPF(ss, 0xB1);
            const float rstd = 1.f / sqrtf(ss * (1.f / 64.f) + 1e-6f);
            const float* gain = (g < 16 ? C.q_gain() : C.k_gain()) + half * 32;
#pragma unroll
            for (int d = 0; d < 32; ++d) v[d] = v[d] * rstd * gain[d];
            if (half == 0) {
#pragma unroll
                for (int i = 0; i < 8; ++i) { const f32x2 cs = rope[pos * 8 + i]; const float x1 = v[i], x2 = v[i + 8]; v[i] = x1 * cs[0] - x2 * cs[1]; v[i + 8] = x2 * cs[0] + x1 * cs[1]; }
            }
            const float sc = g < 16 ? ATT_C2 * (float)(1 << F8_SQ) : (float)(1 << F8_SK);
            unsigned char* q8 = WSP(unsigned char, WS_QK8) + (size_t)t * 2048 + g * 64 + half * 32;
#pragma unroll
            for (int i = 0; i < 2; ++i) { u32x4 o;
                o.x = pk4_fp8(v[16 * i] * sc, v[16 * i + 1] * sc, v[16 * i + 2] * sc, v[16 * i + 3] * sc); o.y = pk4_fp8(v[16 * i + 4] * sc, v[16 * i + 5] * sc, v[16 * i + 6] * sc, v[16 * i + 7] * sc);
                o.z = pk4_fp8(v[16 * i + 8] * sc, v[16 * i + 9] * sc, v[16 * i + 10] * sc, v[16 * i + 11] * sc); o.w = pk4_fp8(v[16 * i + 12] * sc, v[16 * i + 13] * sc, v[16 * i + 14] * sc, v[16 * i + 15] * sc);
                *(u32x4*)(q8 + 16 * i) = o; }
        }
    }
}

constexpr int RS = 72, MATB = 64 * RS * 2;
constexpr int L_TCA = 0, L_TCR = MATB, L_TCB = 2 * MATB, L_TCK = 3 * MATB, L_CTA = 4 * MATB, L_CTV = 5 * MATB, L_CTBH = 6 * MATB, L_CTKH = 7 * MATB,
              L_AK = 8 * MATB, L_RB = 9 * MATB, L_RK = 10 * MATB, L_T = 11 * MATB, L_F = 12 * MATB, L_GT = L_F + 64 * 68 * 4, L_GL = L_GT + 2048;
constexpr int L_XCT = L_TCA, L_U0CT = L_TCB, L_WCT = L_TCK;
constexpr int L_RAW = L_AK;
constexpr int RAW_RKV = 65 * 128, RAW_LW = 3 * RAW_RKV, RAW_A = RAW_LW + 64 * 128;
static_assert(L_RAW + RAW_A + 64 * 128 <= L_GT, "R1 raw buffer");
static_assert(L_GL + 256 <= RING_BYTES, "R1 LDS map");
DI f32x16 mm_tile(const LAS bf16_t* A, const LAS bf16_t* B, int arow0, int brow0, int r32, int hi, f32x16 acc) {
#pragma unroll
    for (int s = 0; s < 4; ++s) {
        const bf16x8 a = *(const LAS bf16x8*)(A + (arow0 + r32) * RS + 16 * s + 8 * hi);
        const bf16x8 b = *(const LAS bf16x8*)(B + (brow0 + r32) * RS + 16 * s + 8 * hi);
        acc = MFMA32(a, b, acc);
    }
    return acc;
}
DI void store_tile_T(LAS bf16_t* M, const f32x16& c, int row0, int col, int hi) {
#pragma unroll
    for (int g = 0; g < 4; ++g) { const int r = row0 + 8 * g + 4 * hi;
        *(LAS u32x2*)(M + col * RS + r) = (u32x2){cvtpk(c[4 * g], c[4 * g + 1]), cvtpk(c[4 * g + 2], c[4 * g + 3])}; }
}
DI void phase_r1(Ctx& C) {
    const bf16_t* proj = WSP(bf16_t, WS_PROJ);
    const bf16_t* LW = WSP(bf16_t, WS_MERGED); const bf16_t* AA = LW + (size_t)T * 1024;
    float* bonus = WSP(float, WS_BONUS);
    u32x4* mfrag = WSP(u32x4, WS_MFRAG); u32x4* nfrag = WSP(u32x4, WS_NFRAG);
    bf16_t* pbuf = WSP(bf16_t, WS_PBUF); bf16_t* y0buf = WSP(bf16_t, WS_Y0);
    LAS unsigned char* L = C.lds;
    const int lane = C.lane, w = C.wave, r32 = lane & 31, hi = lane >> 5;
    u32x4 raw[6];
#define R1_LOAD(item_) do { const int cg_ = (item_) >> 4, h_ = (item_) & 15; const size_t tk_ = (size_t)cg_ * 64 + (C.tid >> 3); const int cc_ = (C.tid & 7) * 8; \
        const bf16_t* pr_ = proj + tk_ * NPROJ + h_ * 64 + cc_; \
        raw[0] = *(const u32x4*)(pr_ + C_R); raw[1] = *(const u32x4*)(pr_ + C_K); raw[2] = *(const u32x4*)(pr_ + C_V); \
        raw[3] = *(const u32x4*)(LW + tk_ * 1024 + h_ * 64 + cc_); raw[4] = *(const u32x4*)(AA + tk_ * 1024 + h_ * 64 + cc_); \
        raw[5] = (u32x4){0u, 0u, 0u, 0u}; \
        if (C.tid < 24 && (cg_ & 255) != 0) raw[5] = *(const u32x4*)(proj + ((size_t)cg_ * 64 - 1) * NPROJ + (C.tid >> 3) * 1024 + h_ * 64 + cc_); } while (0)
    if (C.bid < 8192) R1_LOAD(C.bid);
    for (int item = C.bid; item < 8192; item += C.G) {
        const int cg = item >> 4, h = item & 15, b = cg >> 8, cidx = cg & 255;
        const int ch = (b * 16 + h) * 256 + cidx; const size_t tok0 = (size_t)cg * 64;
        {
            const int t_ = C.tid >> 3, cb_ = (C.tid & 7) * 16;
            *(LAS u32x4*)(L + L_RAW + 0 * RAW_RKV + (t_ + 1) * 128 + cb_) = raw[0]; *(LAS u32x4*)(L + L_RAW + 1 * RAW_RKV + (t_ + 1) * 128 + cb_) = raw[1];
            *(LAS u32x4*)(L + L_RAW + 2 * RAW_RKV + (t_ + 1) * 128 + cb_) = raw[2];
            *(LAS u32x4*)(L + L_RAW + RAW_LW + t_ * 128 + cb_) = raw[3]; *(LAS u32x4*)(L + L_RAW + RAW_A + t_ * 128 + cb_) = raw[4];
            if (C.tid < 24) *(LAS u32x4*)(L + L_RAW + (C.tid >> 3) * RAW_RKV + cb_) = raw[5];
            LDS_BARRIER();
            if (item + C.G < 8192) R1_LOAD(item + C.G);
        }
        {
            const int c = lane, hc = h * 64 + c;
            const float mur = C.shift_mu()[C_R + hc], muk = C.shift_mu()[C_K + hc], muv = C.shift_mu()[C_V + hc];
            const float kkc = C.k_k()[hc], kac = C.k_a()[hc], rkc = C.r_k()[hc];
            const size_t t0 = tok0 + 8 * w;
            const LAS bf16_t* RW = (const LAS bf16_t*)(L + L_RAW);
            float rp = bf2f(RW[(0 * RAW_RKV) / 2 + (8 * w) * 64 + c]), kp = bf2f(RW[(1 * RAW_RKV) / 2 + (8 * w) * 64 + c]), vp = bf2f(RW[(2 * RAW_RKV) / 2 + (8 * w) * 64 + c]);
            float rs[8], km[8], vs[8], kk[8], av[8], cum[8], lwv[8];
            float run = 0.f;
#pragma unroll
            for (int i = 0; i < 8; ++i) {
                const int tr_ = (8 * w + i + 1) * 64 + c;
                const float r = bf2f(RW[(0 * RAW_RKV) / 2 + tr_]), k = bf2f(RW[(1 * RAW_RKV) / 2 + tr_]), v = bf2f(RW[(2 * RAW_RKV) / 2 + tr_]);
                rs[i] = r + (rp - r) * mur; const float ks = k + (kp - k) * muk; vs[i] = v + (vp - v) * muv; rp = r; kp = k; vp = v;
                lwv[i] = bf2f(RW[RAW_LW / 2 + (8 * w + i) * 64 + c]); av[i] = bf2f(RW[RAW_A / 2 + (8 * w + i) * 64 + c]);
                float q = ks * kkc; const float ss = wave_sum(q * q); q = q * __builtin_amdgcn_rsqf(fmaxf(ss, 1e-24f)); kk[i] = q;
                km[i] = ks * (1.f + (av[i] - 1.f) * kac);
                const float bs = wave_sum(rs[i] * km[i] * rkc);
                if (lane == 0) bonus[(t0 + i) * 16 + h] = bs;
                run += lwv[i]; cum[i] = run;
            }
            LAS float* GT = (LAS float*)(L + L_GT); LAS float* GL = (LAS float*)(L + L_GL);
            GT[w * 64 + c] = run;
            LDS_BARRIER();
            float off = 0.f, tot = 0.f;
#pragma unroll
            for (int g = 0; g < 8; ++g) { const float x = GT[g * 64 + c]; tot += x; off += (g < w) ? x : 0.f; }
            if (w == 0) GL[c] = __expf(tot);
            u32x4 cta, ctv, ctbh, ctkh; unsigned* pa = (unsigned*)&cta; unsigned* pv = (unsigned*)&ctv; unsigned* pb = (unsigned*)&ctbh; unsigned* pk = (unsigned*)&ctkh;
            float at[8], bh[8], kh[8];
            LAS bf16_t* TCA = (LAS bf16_t*)(L + L_TCA); LAS bf16_t* TCR = (LAS bf16_t*)(L + L_TCR); LAS bf16_t* TCB = (LAS bf16_t*)(L + L_TCB); LAS bf16_t* TCK = (LAS bf16_t*)(L + L_TCK);
#pragma unroll
            for (int i = 0; i < 8; ++i) {
                const float cm = off + cum[i];
                const float epos = __expf(cm), eneg = __expf(-cm), eprev = __expf(cm - lwv[i]), ratio = __expf(tot - cm);
                const float ka = kk[i] * av[i];
                at[i] = -kk[i] * eprev; bh[i] = ka * ratio; kh[i] = km[i] * ratio;
                const int t = 8 * w + i;
                TCA[t * RS + c] = (bf16_t)f2bf(at[i]); TCR[t * RS + c] = (bf16_t)f2bf(rs[i] * epos); TCB[t * RS + c] = (bf16_t)f2bf(ka * eneg); TCK[t * RS + c] = (bf16_t)f2bf(km[i] * eneg);
            }
#pragma unroll
            for (int i = 0; i < 4; ++i) { pa[i] = pk2(at[2 * i], at[2 * i + 1]); pv[i] = pk2(vs[2 * i], vs[2 * i + 1]); pb[i] = pk2(bh[2 * i], bh[2 * i + 1]); pk[i] = pk2(kh[2 * i], kh[2 * i + 1]); }
            *(LAS u32x4*)(L + L_CTA + (c * RS + 8 * w) * 2) = cta; *(LAS u32x4*)(L + L_CTV + (c * RS + 8 * w) * 2) = ctv;
            *(LAS u32x4*)(L + L_CTBH + (c * RS + 8 * w) * 2) = ctbh; *(LAS u32x4*)(L + L_CTKH + (c * RS + 8 * w) * 2) = ctkh;
        }
        LDS_BARRIER();
        {
            const int p = w >> 1, it = w & 1;
            const LAS bf16_t* Y = (const LAS bf16_t*)(L + ((p & 1) ? L_TCK : L_TCB));
            const LAS bf16_t* X = (const LAS bf16_t*)(L + ((p & 2) ? L_TCR : L_TCA));
            const int t = 32 * it + r32;
#pragma unroll
            for (int jt = 0; jt < 2; ++jt) {
                f32x16 c = {};
                c = mm_tile(Y, X, 32 * jt, 32 * it, r32, hi, c);
#pragma unroll
                for (int r = 0; r < 16; ++r) { const int j = 32 * jt + crow(r, hi); const bool keep = (p < 2) ? (j < t) : (j <= t); c[r] = keep ? c[r] : 0.f; }
                if (p == 0) {
                    LAS float* F = (LAS float*)(L + L_F);
#pragma unroll
                    for (int g = 0; g < 4; ++g) *(LAS f32x4*)(F + t * 68 + 32 * jt + 8 * g + 4 * hi) = (f32x4){c[4 * g], c[4 * g + 1], c[4 * g + 2], c[4 * g + 3]};
                } else {
                    LAS bf16_t* Mo = (LAS bf16_t*)(L + (p == 1 ? L_AK : (p == 2 ? L_RB : L_RK)));
                    store_tile_T(Mo, c, 32 * jt, t, hi);
                }
            }
        }
        LDS_BARRIER();
        {
            const int blk = C.tid >> 8, j = (C.tid >> 3) & 31, p = C.tid & 7, o = 32 * blk;
            const LAS float* F = (const LAS float*)(L + L_F);
            float Tr[4];
#pragma unroll
            for (int q = 0; q < 4; ++q) Tr[q] = 0.f;
#pragma unroll
            for (int tq = 0; tq < 4; ++tq) {
#pragma unroll
                for (int tp = 0; tp < 8; ++tp) {
                    const int t = 8 * tq + tp; float part = 0.f;
#pragma unroll
                    for (int q = 0; q <= tq; ++q) part += F[(o + t) * 68 + o + 8 * q + p] * Tr[q];
                    part = sum8_dpp(part);
                    const float val = part + ((t == j) ? 1.f : 0.f);
                    if (p == tp) Tr[tq] = val;
                }
            }
            LAS bf16_t* Tm = (LAS bf16_t*)(L + L_T); LAS bf16_t* TT = (LAS bf16_t*)(L + L_TCA); LAS bf16_t* Abf = (LAS bf16_t*)(L + L_TCB);
#pragma unroll
            for (int q = 0; q < 4; ++q) { const bf16_t tv = (bf16_t)f2bf(Tr[q]);
                Tm[(o + 8 * q + p) * RS + o + j] = tv; TT[(o + j) * RS + o + 8 * q + p] = tv;
                if (blk == 0) Tm[(8 * q + p) * RS + 32 + j] = 0; }
            { const int t = 32 + (C.tid >> 4), k = 2 * (C.tid & 15);
              *(LAS unsigned*)(Abf + t * RS + k) = cvtpk(F[t * 68 + k], F[t * 68 + k + 1]); }
        }
        LDS_BARRIER();
        if (w == 0) {
            LAS bf16_t* Tm = (LAS bf16_t*)(L + L_T); const LAS bf16_t* TT = (const LAS bf16_t*)(L + L_TCA); const LAS bf16_t* Abf = (const LAS bf16_t*)(L + L_TCB); LAS bf16_t* XT = (LAS bf16_t*)(L + L_TCK);
            f32x16 c = {};
#pragma unroll
            for (int s = 0; s < 2; ++s) c = MFMA32(*(const LAS bf16x8*)(Abf + (32 + r32) * RS + 16 * s + 8 * hi), *(const LAS bf16x8*)(TT + r32 * RS + 16 * s + 8 * hi), c);
            store_tile_T(XT, c, 32, r32, hi);
            asm volatile("s_waitcnt lgkmcnt(0)" ::: "memory");
            f32x16 d = {};
#pragma unroll
            for (int s = 2; s < 4; ++s) d = MFMA32(*(const LAS bf16x8*)(Tm + (32 + r32) * RS + 16 * s + 8 * hi), *(const LAS bf16x8*)(XT + r32 * RS + 16 * s + 8 * hi), d);
#pragma unroll
            for (int r = 0; r < 16; ++r) Tm[(32 + crow(r, hi)) * RS + r32] = (bf16_t)f2bf(d[r]);
        }
        LDS_BARRIER();
        {
            const int prod = w >> 2, tt = (w >> 1) & 1, ct = w & 1;
            const LAS bf16_t* A = (const LAS bf16_t*)(L + (prod ? L_AK : L_T));
            const LAS bf16_t* B = (const LAS bf16_t*)(L + (prod ? L_CTV : L_CTA));
            f32x16 c = {}; c = mm_tile(A, B, 32 * tt, 32 * ct, r32, hi, c);
            store_tile_T((LAS bf16_t*)(L + (prod ? L_XCT : L_WCT)), c, 32 * tt, 32 * ct + r32, hi);
        }
        LDS_BARRIER();
        if (w < 4) {
            const int tt = w >> 1, vt = w & 1;
            f32x16 c = {}; c = mm_tile((const LAS bf16_t*)(L + L_T), (const LAS bf16_t*)(L + L_XCT), 32 * tt, 32 * vt, r32, hi, c);
            store_tile_T((LAS bf16_t*)(L + L_U0CT), c, 32 * tt, 32 * vt + r32, hi);
        } else {
            const int kt = (w >> 1) & 1, it = w & 1;
            f32x16 c = {}; c = mm_tile((const LAS bf16_t*)(L + L_WCT), (const LAS bf16_t*)(L + L_CTBH), 32 * kt, 32 * it, r32, hi, c);
            const float gl = ((const LAS float*)(L + L_GL))[32 * it + r32];
#pragma unroll
            for (int r = 0; r < 16; ++r) if (32 * kt + crow(r, hi) == 32 * it + r32) c[r] += gl;
            u32x4* dst = mfrag + ((size_t)(ch * 4 + kt * 2 + it) * 2) * 64 + lane;
            dst[0] = __builtin_bit_cast(u32x4, pack_step(c, 0)); dst[64] = __builtin_bit_cast(u32x4, pack_step(c, 1));
        }
        LDS_BARRIER();
        if (w < 4) {
            {   const int it = w >> 1, vt = w & 1;
                f32x16 c = {};
                c = mm_tile((const LAS bf16_t*)(L + L_CTBH), (const LAS bf16_t*)(L + L_U0CT), 32 * it, 32 * vt, r32, hi, c);
                c = mm_tile((const LAS bf16_t*)(L + L_CTKH), (const LAS bf16_t*)(L + L_CTV), 32 * it, 32 * vt, r32, hi, c);
                u32x4* dst = nfrag + ((size_t)(ch * 4 + it * 2 + vt) * 2) * 64 + lane;
                dst[0] = __builtin_bit_cast(u32x4, pack_step(c, 0)); dst[64] = __builtin_bit_cast(u32x4, pack_step(c, 1)); }
            {   const int kt = w >> 1, tt = w & 1, t = 32 * tt + r32;
                f32x16 c = {};
                c = mm_tile((const LAS bf16_t*)(L + L_WCT), (const LAS bf16_t*)(L + L_RB), 32 * kt, 32 * tt, r32, hi, c);
                const LAS bf16_t* TCR = (const LAS bf16_t*)(L + L_TCR);
#pragma unroll
                for (int g = 0; g < 4; ++g) { const int k0 = 32 * kt + 8 * g + 4 * hi; const u32x2 rr = *(const LAS u32x2*)(TCR + t * RS + k0);
                    const u32x2 o = {cvtpk(c[4 * g] + bflo(rr.x), c[4 * g + 1] + bfhi(rr.x)), cvtpk(c[4 * g + 2] + bflo(rr.y), c[4 * g + 3] + bfhi(rr.y))};
                    *(u32x2*)(pbuf + (size_t)ch * 4096 + ((tt * 4 + 2 * kt + (g >> 1)) * 64 + r32 + 32 * (g & 1)) * 8 + 4 * hi) = o; } }
        } else {
            const int vt = (w >> 1) & 1, tt = w & 1, t = 32 * tt + r32;
            f32x16 c = {};
            c = mm_tile((const LAS bf16_t*)(L + L_U0CT), (const LAS bf16_t*)(L + L_RB), 32 * vt, 32 * tt, r32, hi, c);
            c = mm_tile((const LAS bf16_t*)(L + L_CTV), (const LAS bf16_t*)(L + L_RK), 32 * vt, 32 * tt, r32, hi, c);
            const LAS bf16_t* CTV = (const LAS bf16_t*)(L + L_CTV); bf16_t* vsc = WSP(bf16_t, WS_VSC);
#pragma unroll
            for (int g = 0; g < 4; ++g) { const int v0 = 32 * vt + 8 * g + 4 * hi; const size_t di = (size_t)ch * 4096 + ((((tt * 2 + vt) * 4 + g) * 64) + lane) * 4;
                *(u32x2*)(y0buf + di) = (u32x2){cvtpk(c[4 * g], c[4 * g + 1]), cvtpk(c[4 * g + 2], c[4 * g + 3])};
                *(u32x2*)(vsc + di) = (u32x2){(unsigned)CTV[(v0 + 0) * RS + t] | ((unsigned)CTV[(v0 + 1) * RS + t] << 16), (unsigned)CTV[(v0 + 2) * RS + t] | ((unsigned)CTV[(v0 + 3) * RS + t] << 16)}; }
        }
        LDS_BARRIER();
    }
}

DI void r2_wave(Ctx& C, int wi) {
    const int bh = wi >> 1, vt = wi & 1, lane = C.lane, r32 = lane & 31, hi = lane >> 5;
    const u32x4* mfrag = WSP(u32x4, WS_MFRAG); const u32x4* nfrag = WSP(u32x4, WS_NFRAG);
    bf16_t* sbuf = WSP(bf16_t, WS_SBUF);
    f32x16 X[2]; X[0] = f32x16{}; X[1] = f32x16{};
    u32x4 mA[8], nA[4], mB[8], nB[4], mC[8], nC[4];
#define R2_LOAD(M_, N_, cidx) do { const size_t ch_ = (size_t)bh * 256 + (cidx); \
        _Pragma("unroll") for (int q_ = 0; q_ < 8; ++q_) M_[q_] = mfrag[((ch_ * 4 + (q_ >> 1)) * 2 + (q_ & 1)) * 64 + lane];            \
        _Pragma("unroll") for (int q_ = 0; q_ < 4; ++q_) N_[q_] = nfrag[((ch_ * 4 + (q_ >> 1) * 2 + vt) * 2 + (q_ & 1)) * 64 + lane]; } while (0)
#define R2_STEP(M_, N_, cidx) do { const size_t ch_ = (size_t)bh * 256 + (cidx); \
          \
        _Pragma("unroll") for (int kt = 0; kt < 2; ++kt) _Pragma("unroll") for (int g = 0; g < 4; ++g) \
            *(u32x2*)(sbuf + ch_ * 4096 + ((vt * 4 + 2 * kt + (g >> 1)) * 64 + r32 + 32 * (g & 1)) * 8 + 4 * hi) = (u32x2){cvtpk(X[kt][4 * g], X[kt][4 * g + 1]), cvtpk(X[kt][4 * g + 2], X[kt][4 * g + 3])}; \
        f32x16 acc[2]; \
        _Pragma("unroll") for (int it = 0; it < 2; ++it) _Pragma("unroll") for (int s = 0; s < 2; ++s) { const u32x4 q = N_[it * 2 + s]; \
            acc[it][8 * s + 0] = bflo(q.x); acc[it][8 * s + 1] = bfhi(q.x); acc[it][8 * s + 2] = bflo(q.y); acc[it][8 * s + 3] = bfhi(q.y); \
            acc[it][8 * s + 4] = bflo(q.z); acc[it][8 * s + 5] = bfhi(q.z); acc[it][8 * s + 6] = bflo(q.w); acc[it][8 * s + 7] = bfhi(q.w); } \
        _Pragma("unroll") for (int kt = 0; kt < 2; ++kt) _Pragma("unroll") for (int s = 0; s < 2; ++s) { const bf16x8 xb = pack_step(X[kt], s); \
            _Pragma("unroll") for (int it = 0; it < 2; ++it) acc[it] = MFMA32(__builtin_bit_cast(bf16x8, M_[(kt * 2 + it) * 2 + s]), xb, acc[it]); } \
        X[0] = acc[0]; X[1] = acc[1]; \
        if ((cidx) + 3 < 256) R2_LOAD(M_, N_, (cidx) + 3); } while (0)
    R2_LOAD(mA, nA, 0); R2_LOAD(mB, nB, 1); R2_LOAD(mC, nC, 2);
    for (int cidx = 0; cidx < 255; cidx += 3) { R2_STEP(mA, nA, cidx); R2_STEP(mB, nB, cidx + 1); R2_STEP(mC, nC, cidx + 2); }
    R2_STEP(mA, nA, 255);
#undef R2_LOAD
#undef R2_STEP
}

constexpr int A_STG = 16384, A_NSTG = 8;
constexpr int A_WS = RING_BYTES + 4096;
constexpr int A_O2 = 0;
constexpr int A_IDX = A_WS + 8 * 256;
constexpr int A_ONES = A_IDX + 64;
static_assert(A_NSTG * A_STG <= RING_BYTES && A_ONES + 32 <= LDS_BYTES && A_WS >= RING_BYTES + 1024, "attention LDS map");
typedef short v4i16_t __attribute__((ext_vector_type(4)));
DI s16x4 vtr(const LAS unsigned char* p) { return __builtin_bit_cast(s16x4, __builtin_amdgcn_ds_read_tr16_b64_v4i16((LAS v4i16_t*)p)); }
DI void attn_unit(Ctx& C, int b, int h, int u, float lam) {
    int lane_ = C.lane; asm volatile("" : "+v"(lane_));
    const int lane = lane_, w = C.wave, tid = w * 64 + lane, r32 = lane & 31, hi = lane >> 5, rg = w & 3, mp = w >> 2; (void)tid;
    LAS unsigned char* L = C.lds;
    const bf16_t* proj = WSP(bf16_t, WS_PROJ);
    const size_t rowbase = (size_t)b * SEQ;
    const int q0 = u * 128 + rg * 32;
    const int my_chunk = q0 >> 6, NT = 2 * u + 2;
    const unsigned char* qk8 = WSP(unsigned char, WS_QK8);
    pg8::v8i_t qf;
    {   const unsigned char* qp = qk8 + (rowbase + q0 + r32) * 2048 + h * 128 + mp * 64 + 32 * hi;
        qf = __builtin_shufflevector(*(const pg8::v4i_t*)(qp), *(const pg8::v4i_t*)(qp + 16), 0, 1, 2, 3, 4, 5, 6, 7); }
    const unsigned lds0 = (unsigned)(size_t)L;
    const unsigned char* ktb = qk8 + rowbase * 2048 + 1024 + h * 128;
    const unsigned koff = (unsigned)((8 * w + (lane >> 3)) * 2048 + (((lane & 7) ^ (((8 * w + (lane >> 3)) >> 1) & 7)) << 4));
    const unsigned char* vtb = WSP(unsigned char, WS_VT) + (size_t)((b * 8 + h) * 256) * 8192;
    const unsigned voff = (unsigned)((16 * w + (lane >> 2)) * 64 + (((lane & 3) ^ (((16 * w + (lane >> 2)) >> 2) & 3)) << 4));
#define A_GLDS(gsrc, ldsdst) do { unsigned keep_; asm volatile("s_mov_b32 %0, m0\n\ts_mov_b32 m0, %2\n\ts_nop 0\n\tglobal_load_lds_dwordx4 %1, off\n\ts_mov_b32 m0, %0" : "=&s"(keep_) : "v"(gsrc), "s"(ldsdst) : "memory"); } while (0)
#define A_DMA(kt, st) do { const unsigned lb_ = (unsigned)__builtin_amdgcn_readfirstlane((int)(lds0 + (st) * A_STG + w * 1024)); \
        A_GLDS(ktb + (size_t)(kt) * 64 * 2048 + koff, lb_); A_GLDS(vtb + (size_t)(kt) * 8192 + voff, lb_ + 8192); } while (0)
#define A_WAITBAR() asm volatile("s_waitcnt vmcnt(0) lgkmcnt(0)\n\ts_barrier" ::: "memory")
#define A_WAITBAR_N(n) asm volatile("s_waitcnt vmcnt(" #n ") lgkmcnt(0)\n\ts_barrier" ::: "memory")
    const int ksw = (r32 >> 1) & 7, kofa = r32 * 128 + (((mp * 4 + 2 * hi) ^ ksw) << 4);
    const int vsw = (r32 >> 2) & 3, vofa = 8192 + r32 * 64 + (((2 * hi) ^ vsw) << 4);
    f32x16 o[4]; o[0] = f32x16{}; o[1] = f32x16{}; o[2] = f32x16{}; o[3] = f32x16{};
    f32x16 negm = f32x16{};
    f32x16 osum = f32x16{};
    LAS float* wsf = (LAS float*)(L + A_WS) + w * 64;
    A_DMA(0, 0); A_DMA(1, 1); if (NT > 2) A_DMA(2, 2); if (NT > 3) A_DMA(3, 3); if (NT > 4) A_DMA(4, 4);
    A_WAITBAR();
    f32x16 pA0, pA1, pB0, pB1; float rmc;
#define A_ROWMAX2(dst, P0, P1) do { float rm_ = P0[0]; _Pragma("unroll") for (int r = 0; r < 16; ++r) { rm_ = fmaxf(rm_, P0[r]); rm_ = fmaxf(rm_, P1[r]); } \
        auto rr_ = __builtin_amdgcn_permlane32_swap(__float_as_uint(rm_), __float_as_uint(rm_), false, false); dst = fmaxf(__uint_as_float(rr_[0]), __uint_as_float(rr_[1])); } while (0)
#define A_QK8(DST, st, kb) do { const LAS unsigned char* kp_ = L + (st) * A_STG + (kb) * 4096; \
        const pg8::v8i_t kf_ = __builtin_shufflevector(__builtin_bit_cast(pg8::v4i_t, *(const LAS bf16x8*)(kp_ + kofa)), __builtin_bit_cast(pg8::v4i_t, *(const LAS bf16x8*)(kp_ + (kofa ^ 16))), 0, 1, 2, 3, 4, 5, 6, 7); \
        asm volatile("v_mfma_scale_f32_32x32x64_f8f6f4 %0, %1, %2, %5, %3, %4 op_sel_hi:[0,0,0]" : "=&v"(DST) : "v"(kf_), "v"(qf), "v"((127 - F8_SK) * 0x01010101), "v"((127 - F8_SQ) * 0x01010101), "v"(negm)); } while (0)
#define A_KF(st, kb) __builtin_shufflevector(__builtin_bit_cast(pg8::v4i_t, *(const LAS bf16x8*)(L + (st) * A_STG + (kb) * 4096 + kofa)), __builtin_bit_cast(pg8::v4i_t, *(const LAS bf16x8*)(L + (st) * A_STG + (kb) * 4096 + (kofa ^ 16))), 0, 1, 2, 3, 4, 5, 6, 7)
#define A_QKM(DST, KF) asm volatile("v_mfma_scale_f32_32x32x64_f8f6f4 %0, %1, %2, %5, %3, %4 op_sel_hi:[0,0,0]" : "=&v"(DST) : "v"(KF), "v"(qf), "v"((127 - F8_SK) * 0x01010101), "v"((127 - F8_SQ) * 0x01010101), "v"(negm))
    A_QK8(pA0, 0, 0); A_QK8(pA1, 0, 1);
    asm volatile("s_nop 15\n\ts_nop 15\n\ts_nop 15\n\ts_nop 15" : "+v"(pA0), "+v"(pA1));
    A_ROWMAX2(rmc, pA0, pA1);
    pB0 = f32x16{}; pB1 = f32x16{};
#define A_SM4(g, C0, C1, PW) do { const int r0 = 4 * ((g) & 3); float e0, e1, e2, e3; \
        if ((g) < 4) { e0 = C0[r0]; e1 = C0[r0 + 1]; e2 = C0[r0 + 2]; e3 = C0[r0 + 3]; } else { e0 = C1[r0]; e1 = C1[r0 + 1]; e2 = C1[r0 + 2]; e3 = C1[r0 + 3]; } \
        e0 = __builtin_amdgcn_exp2f(e0); e1 = __builtin_amdgcn_exp2f(e1); e2 = __builtin_amdgcn_exp2f(e2); e3 = __builtin_amdgcn_exp2f(e3); \
        { int q_ = PW[g]; q_ = __builtin_amdgcn_cvt_pk_fp8_f32(e0, e1, q_, false); q_ = __builtin_amdgcn_cvt_pk_fp8_f32(e2, e3, q_, true);     asm volatile("" : "+v"(q_)); PW[g] = q_; } } while (0)
#define A_VF(stv, d0) __builtin_shufflevector(__builtin_bit_cast(pg8::v4i_t, *(const LAS bf16x8*)(L + (stv) * A_STG + vofa + (d0) * 2048)), __builtin_bit_cast(pg8::v4i_t, *(const LAS bf16x8*)(L + (stv) * A_STG + (vofa ^ 16) + (d0) * 2048)), 0, 1, 2, 3, 4, 5, 6, 7)
#define A_PVM(d0, PA, VB) asm volatile("v_mfma_scale_f32_32x32x64_f8f6f4 %0, %1, %2, %0, %3, %4 op_sel_hi:[0,0,0]" : "+v"(o[d0]) : "v"(PA), "v"(VB), "v"(0x7f7f7f7f), "v"((127 - F8_SV) * 0x01010101))
#define A_ONESF() __builtin_shufflevector(__builtin_bit_cast(pg8::v4i_t, *(const LAS bf16x8*)(L + A_ONES)), __builtin_bit_cast(pg8::v4i_t, *(const LAS bf16x8*)(L + A_ONES + 16)), 0, 1, 2, 3, 4, 5, 6, 7)
#define A_OSM(PA, ON) asm volatile("v_mfma_scale_f32_32x32x64_f8f6f4 %0, %1, %2, %0, %3, %3 op_sel_hi:[0,0,0]" : "+v"(osum) : "v"(PA), "v"(ON), "v"(0x7f7f7f7f))
#define A_SB() __builtin_amdgcn_sched_barrier(0)
#define A_STEP(kt, C0, C1, N0, N1, PWC, PWP, SVP_, KF0, KF1, PRE_, SKP_, NKF0, NKF1) do { const int svp_ = (SVP_); \
        bool resc = false; \
        if ((kt) <= my_chunk && ((kt) == 0 || __any(rmc > 8.f))) {      \
            const float dl = (kt) == 0 ? rmc : fmaxf(rmc, 0.f); resc = true; \
            _Pragma("unroll") for (int r = 0; r < 16; ++r) { C0[r] -= dl; C1[r] -= dl; negm[r] -= dl; } \
            if (hi == 0) wsf[r32] = __builtin_amdgcn_exp2f(-dl); } \
          \
        { pg8::v8i_t vb0, vb1; \
            A_QKM(N0, KF0); vb0 = A_VF(svp_, 0); A_SM4(0, C0, C1, PWC); A_SB(); \
            A_QKM(N1, KF1); vb1 = A_VF(svp_, 1); A_SM4(1, C0, C1, PWC); A_SB(); \
            A_PVM(0, PWP, vb0);  A_SM4(2, C0, C1, PWC); A_SB(); vb0 = A_VF(svp_, 2); \
            A_PVM(1, PWP, vb1);  A_SM4(3, C0, C1, PWC); A_SB(); vb1 = A_VF(svp_, 3); \
            A_PVM(2, PWP, vb0);  A_SM4(4, C0, C1, PWC); A_SB(); vb0 = A_ONESF(); \
            A_PVM(3, PWP, vb1);  A_SM4(5, C0, C1, PWC); A_SB(); \
            A_OSM(PWP, vb0);     A_SM4(6, C0, C1, PWC); A_SB(); if (PRE_) { NKF0 = A_KF(SKP_, 0); NKF1 = A_KF(SKP_, 1); } \
            A_SM4(7, C0, C1, PWC); A_SB(); } \
        if (resc) {                                           \
            asm volatile("s_waitcnt lgkmcnt(0)\n\ts_nop 15\n\ts_nop 15\n\ts_nop 15\n\ts_nop 15" ::: "memory");     \
            _Pragma("unroll") for (int r = 0; r < 16; ++r) { const float fr_ = wsf[crow(r, hi)]; osum[r] *= fr_; \
                _Pragma("unroll") for (int d0 = 0; d0 < 4; ++d0) o[d0][r] *= fr_; } } \
        A_ROWMAX2(rmc, N0, N1); \
        } while (0)
    pg8::v8i_t pwX = {0, 0, 0, 0, 0, 0, 0, 0}, pwY = {0, 0, 0, 0, 0, 0, 0, 0};
    int sb = 0;
#define A_SG(d) ((sb + (d)) >= A_NSTG ? (sb + (d)) - A_NSTG : (sb + (d)))
    for (int kt = 0; kt < NT; kt += 2) {
        if (kt > 0) { if (kt + 4 < NT) A_WAITBAR_N(4); else if (kt + 3 < NT) A_WAITBAR_N(2); else A_WAITBAR(); }
        if (kt + 5 < NT) A_DMA(kt + 5, A_SG(5));
        if (kt + 6 < NT) A_DMA(kt + 6, A_SG(6));
        { const int s0 = A_SG(0), sm1 = kt == 0 ? s0 : A_SG(7), s1 = A_SG(1), s2 = A_SG(2);
          pg8::v8i_t ka0 = A_KF(s1, 0), ka1 = A_KF(s1, 1), kb0, kb1;
          A_STEP(kt, pA0, pA1, pB0, pB1, pwX, pwY, sm1, ka0, ka1, true, s2, kb0, kb1);
          A_STEP(kt + 1, pB0, pB1, pA0, pA1, pwY, pwX, s0, kb0, kb1, false, s2, ka0, ka1); }
        sb = A_SG(2);
    }
    if (my_chunk == NT - 1) {
        const int svp_ = A_SG(7);
        const pg8::v8i_t vb0 = A_VF(svp_, 0), vb1 = A_VF(svp_, 1), vb2 = A_VF(svp_, 2), vb3 = A_VF(svp_, 3);
        const pg8::v8i_t on_ = A_ONESF();
        A_PVM(0, pwY, vb0); A_PVM(1, pwY, vb1); A_PVM(2, pwY, vb2); A_PVM(3, pwY, vb3); A_OSM(pwY, on_);
    }
#undef A_SG
#undef A_SM4
#undef A_VF
#undef A_PVM
#undef A_ONESF
#undef A_OSM
#undef A_SB
    asm volatile("s_nop 15\n\ts_nop 15\n\ts_nop 15\n\ts_nop 15" ::: "memory");
#undef A_STEP
#undef A_QK8
#undef A_KF
#undef A_QKM
#undef A_ROWMAX2
#undef A_DMA
#undef A_GLDS
#undef A_WAITBAR
#undef A_WAITBAR_N
#pragma unroll
    for (int r = 0; r < 16; ++r) { const float il = __builtin_amdgcn_rcpf(fmaxf(osum[r], 1e-30f));
#pragma unroll
        for (int d0 = 0; d0 < 4; ++d0) o[d0][r] *= il; }
    LDS_BARRIER();
    LAS float* O2 = (LAS float*)(L + A_O2) + rg * 4096;
    if (mp == 1) {
#pragma unroll
        for (int d0 = 0; d0 < 4; ++d0)
#pragma unroll
            for (int r = 0; r < 16; ++r) O2[(d0 * 16 + r) * 64 + lane] = o[d0][r];
    }
    LDS_BARRIER();
    if (mp == 0) {
        unsigned char* ob = WSP(unsigned char, WS_OB8);
        float sg[4];
#pragma unroll
        for (int d0 = 0; d0 < 4; ++d0) sg[d0] = C.subln_gain()[32 * d0 + r32] * (1.f - LAMBDA_INIT);
#pragma unroll
        for (int r = 0; r < 16; ++r) {
            float dv[4], ss = 0.f;
#pragma unroll
            for (int d0 = 0; d0 < 4; ++d0) { dv[d0] = o[d0][r] - lam * O2[(d0 * 16 + r) * 64 + lane]; ss += dv[d0] * dv[d0]; }
            ss = sum32_dpp(ss);
            const float rstd = __builtin_amdgcn_rsqf(ss * (1.f / 128.f) + 1e-6f);
            unsigned char* orow = ob + (rowbase + q0 + crow(r, hi)) * 1024 + h * 128 + r32;
#pragma unroll
            for (int d0 = 0; d0 < 4; ++d0) orow[32 * d0] = (unsigned char)(pk4_fp8(dv[d0] * rstd * sg[d0] * (float)(1 << F8_SH), 0.f, 0.f, 0.f) & 0xffu);
        }
    }
    LDS_BARRIER();
}
DI void phase_r2_attn(Ctx& C, int qword) {
    unsigned* ctl = WSP(unsigned, WS_CTL);
#ifndef R2_PROBE
#define R2_PROBE 0
#endif
    if (C.bid < 8) { r2_wave(C, C.bid * 8 + C.wave); if (R2_PROBE) r2_wave(C, C.bid * 8 + C.wave); }
    float s1 = C.lam_q1()[C.lane] * C.lam_k1()[C.lane], s2 = C.lam_q2()[C.lane] * C.lam_k2()[C.lane];
    s1 = wave_sum(s1); s2 = wave_sum(s2);
    const float lam = __expf(s1) - __expf(s2) + LAMBDA_INIT;
    LAS int* idxp = (LAS int*)(C.lds + A_IDX);
    if (C.tid < 8) ((LAS unsigned*)(C.lds + A_ONES))[C.tid] = 0x38383838u;
    __syncthreads();
    const int myq = (int)(xb_xcc_id() & 7u);
    for (int qo = 0; qo < 8; ++qo) {
        const int j = (myq + qo) & 7;
        for (;;) {
            if (C.tid == 0) *idxp = (int)__hip_atomic_fetch_add(ctl + qword + 64 * j, 1u, __ATOMIC_RELAXED, __HIP_MEMORY_SCOPE_AGENT);
            LDS_BARRIER();
            const int q = *idxp;
            LDS_BARRIER();
            if (q >= 256) break;
            const int pair = 2 * j + (q & 1);
            attn_unit(C, pair >> 3, pair & 7, 127 - (q >> 1), lam);
        }
    }
}

DI void phase_r3(Ctx& C) {
    const int lane = C.lane, w = C.wave, r32 = lane & 31, hi = lane >> 5, tt = w & 1, chi = w >> 1;
    const bf16_t* proj = WSP(bf16_t, WS_PROJ); const bf16_t* sbuf = WSP(bf16_t, WS_SBUF); const bf16_t* pbuf = WSP(bf16_t, WS_PBUF); const bf16_t* y0buf = WSP(bf16_t, WS_Y0);
    const float* bonus = WSP(float, WS_BONUS); const bf16_t* vsc = WSP(bf16_t, WS_VSC); const bf16_t* oa = WSP(bf16_t, WS_OA); unsigned char* oa8 = WSP(unsigned char, WS_OA8);
    for (int item = C.bid; item < 2048; item += C.G) {
        const int cg = item >> 2, h = (item & 3) * 4 + chi, b = cg >> 8, cidx = cg & 255;
        const size_t ch = (size_t)(b * 16 + h) * 256 + cidx, tok = (size_t)cg * 64 + 32 * tt + r32;
        f32x16 acc[2]; acc[0] = f32x16{}; acc[1] = f32x16{};
#pragma unroll
        for (int s = 0; s < 4; ++s) {
            const bf16x8 pb = *(const bf16x8*)(pbuf + ch * 4096 + ((tt * 4 + s) * 64 + lane) * 8);
#pragma unroll
            for (int vt = 0; vt < 2; ++vt) { const bf16x8 sa = *(const bf16x8*)(sbuf + ch * 4096 + ((vt * 4 + s) * 64 + lane) * 8); acc[vt] = MFMA32(sa, pb, acc[vt]); }
        }
        u32x2 yy[8], vc[8], gg[8]; f32x4 gw[8], gb[8];
        const float bs = bonus[tok * 16 + h];
#pragma unroll
        for (int q = 0; q < 8; ++q) { const int vt = q >> 2, g = q & 3, v0 = h * 64 + 32 * vt + 8 * g + 4 * hi; const size_t fi = ch * 4096 + ((((tt * 2 + vt) * 4 + g) * 64) + lane) * 4;
            yy[q] = *(const u32x2*)(y0buf + fi); vc[q] = *(const u32x2*)(vsc + fi); gg[q] = *(const u32x2*)(oa + tok * 1024 + v0);
            gw[q] = *(const f32x4*)(C.gn_w() + v0); gb[q] = *(const f32x4*)(C.gn_b() + v0); }
        float y[32]; float sum = 0.f;
#pragma unroll
        for (int q = 0; q < 8; ++q) { const int vt = q >> 2, g = q & 3;
            y[4 * q + 0] = acc[vt][4 * g + 0] + bflo(yy[q].x); y[4 * q + 1] = acc[vt][4 * g + 1] + bfhi(yy[q].x); y[4 * q + 2] = acc[vt][4 * g + 2] + bflo(yy[q].y); y[4 * q + 3] = acc[vt][4 * g + 3] + bfhi(yy[q].y); }
#pragma unroll
        for (int i = 0; i < 32; ++i) sum += y[i];
        sum = sum_x32(sum);
        const float mean = sum * (1.f / 64.f); float vs = 0.f;
#pragma unroll
        for (int i = 0; i < 32; ++i) { const float d = y[i] - mean; vs += d * d; }
        vs = sum_x32(vs);
        const float rstd = __builtin_amdgcn_rsqf(vs * (1.f / 64.f) + 64e-5f);
        unsigned ow[8];
#pragma unroll
        for (int q = 0; q < 8; ++q) {
            const f32x4 vcur = {bflo(vc[q].x), bfhi(vc[q].x), bflo(vc[q].y), bfhi(vc[q].y)}, gv = {bflo(gg[q].x), bfhi(gg[q].x), bflo(gg[q].y), bfhi(gg[q].y)};
            f32x4 ov;
#pragma unroll
            for (int e = 0; e < 4; ++e) { const float yn = (y[4 * q + e] - mean) * rstd * gw[q][e] + gb[q][e]; ov[e] = (yn + bs * vcur[e]) * gv[e] * (float)(1 << F8_SH); }
            ow[q] = pk4_fp8(ov[0], ov[1], ov[2], ov[3]);
        }
#pragma unroll
        for (int q = 0; q < 8; ++q) { const int vt = q >> 2, g = q & 3, v0 = h * 64 + 32 * vt + 8 * g + 4 * hi; *(unsigned*)(oa8 + tok * 1024 + v0) = ow[q]; }
    }
}
DI void phase_norm2_router(Ctx& C) {
    const int lane = C.lane, w = C.wave, fr = lane & 15, fq = lane >> 4;
    const float* mod = WSP(float, WS_MOD); const float* gs2 = WSP(float, WS_GS2);
    const bf16_t* wr = WSP(bf16_t, WS_WRT);
    unsigned char* H2 = WSP(unsigned char, WS_H);
    int* topidx = WSP(int, WS_TOPIDX); float* topw = WSP(float, WS_TOPW); int* wgcnt = WSP(int, WS_WGCNT);
    LAS float* lgp = (LAS float*)(C.lds);
    LAS float* rst = (LAS float*)(C.lds + RING_BYTES);
    for (int tb = C.bid; tb < 256; tb += C.G) {
        const size_t rowb = (size_t)tb * 128; const int b = (int)(rowb / SEQ);
        LAS float* rstd_l = (LAS float*)(C.lds + RING_BYTES + 1024);
        LAS int* hist = (LAS int*)(C.lds + RING_BYTES + 1536);
        (void)rst;
        if (C.tid < 32) hist[C.tid] = 0;
        {
            const float* rs = WSP(float, WS_ROWSS) + (rowb + 16 * w) * 32; float pv[16];
#pragma unroll
            for (int i = 0; i < 16; ++i) pv[i] = (lane < 32) ? rs[i * 32 + lane] : 0.f;
#pragma unroll
            for (int i = 0; i < 16; ++i) { const float r = __builtin_amdgcn_rsqf(wave_sum(pv[i]) * (1.f / D) + 1e-6f); if (lane == 0) rstd_l[16 * w + i] = r; } }
        __syncthreads();
        const int k0 = 256 * w + 8 * fq;
        const float* gsb = gs2 + b * 2048 + k0; const float* shb = mod + b * 12288 + 3 * 2048 + k0;
        const bf16_t* wb = wr + fr * 2048 + k0;
        const float* xb = C.out + (rowb + fr) * D + k0; unsigned char* hb = H2 + (rowb + fr) * D + k0;
        float rs8[8];
#pragma unroll
        for (int gi = 0; gi < 8; ++gi) rs8[gi] = rstd_l[16 * gi + fr];
        f32x4 acc[8][2];
#pragma unroll
        for (int gi = 0; gi < 8; ++gi) { acc[gi][0] = (f32x4){0.f, 0.f, 0.f, 0.f}; acc[gi][1] = acc[gi][0]; }
        for (int ks = 0; ks < 8; ++ks) {
            f32x4 xv[8][2];
#pragma unroll
            for (int gi = 0; gi < 8; ++gi) { xv[gi][0] = *(const f32x4*)(xb + (size_t)gi * 16 * D + 32 * ks); xv[gi][1] = *(const f32x4*)(xb + (size_t)gi * 16 * D + 32 * ks + 4); }
            const f32x4 g0 = *(const f32x4*)(gsb + 32 * ks), g1 = *(const f32x4*)(gsb + 32 * ks + 4), s0 = *(const f32x4*)(shb + 32 * ks), s1 = *(const f32x4*)(shb + 32 * ks + 4);
            const bf16x8 bh0 = *(const bf16x8*)(wb + 32 * ks), bl0 = *(const bf16x8*)(wb + 65536 + 32 * ks), bh1 = *(const bf16x8*)(wb + 16 * 2048 + 32 * ks), bl1 = *(const bf16x8*)(wb + 65536 + 16 * 2048 + 32 * ks);
#pragma unroll
            for (int gi = 0; gi < 8; ++gi) {
                const f32x4 y0 = xv[gi][0] * rs8[gi] * g0 + s0, y1 = xv[gi][1] * rs8[gi] * g1 + s1;
                u32x4 ah, al;
                { const unsigned h0 = f2bf(y0[0]), h1 = f2bf(y0[1]), h2 = f2bf(y0[2]), h3 = f2bf(y0[3]), h4 = f2bf(y1[0]), h5 = f2bf(y1[1]), h6 = f2bf(y1[2]), h7 = f2bf(y1[3]);
                  ah = (u32x4){h0 | (h1 << 16), h2 | (h3 << 16), h4 | (h5 << 16), h6 | (h7 << 16)};
                  al = (u32x4){pk2(y0[0] - bf2f(h0), y0[1] - bf2f(h1)), pk2(y0[2] - bf2f(h2), y0[3] - bf2f(h3)), pk2(y1[0] - bf2f(h4), y1[1] - bf2f(h5)), pk2(y1[2] - bf2f(h6), y1[3] - bf2f(h7))}; }
                { const float sh_ = (float)(1 << F8_SH); *(u32x2*)(hb + (size_t)gi * 16 * D + 32 * ks) = (u32x2){pk4_fp8(y0[0] * sh_, y0[1] * sh_, y0[2] * sh_, y0[3] * sh_), pk4_fp8(y1[0] * sh_, y1[1] * sh_, y1[2] * sh_, y1[3] * sh_)}; }
                const bf16x8 A_h = __builtin_bit_cast(bf16x8, ah), A_l = __builtin_bit_cast(bf16x8, al);
                acc[gi][0] = MFMA16(A_h, bh0, acc[gi][0]); acc[gi][0] = MFMA16(A_h, bl0, acc[gi][0]); acc[gi][0] = MFMA16(A_l, bh0, acc[gi][0]);
                acc[gi][1] = MFMA16(A_h, bh1, acc[gi][1]); acc[gi][1] = MFMA16(A_h, bl1, acc[gi][1]); acc[gi][1] = MFMA16(A_l, bh1, acc[gi][1]);
            }
        }
#pragma unroll
        for (int gi = 0; gi < 8; ++gi)
#pragma unroll
            for (int nt = 0; nt < 2; ++nt)
#pragma unroll
                for (int i = 0; i < 4; ++i) lgp[(w * 128 + 16 * gi + 4 * fq + i) * 32 + 16 * nt + fr] = acc[gi][nt][i];
        LDS_BARRIER();
        {   const int row = C.tid >> 2, e0 = 8 * (C.tid & 3); float s[8];
#pragma unroll
            for (int e = 0; e < 8; ++e) s[e] = C.b_router()[e0 + e];
#pragma unroll
            for (int ww = 0; ww < 8; ++ww) { const f32x4 a = *(const LAS f32x4*)(lgp + (ww * 128 + row) * 32 + e0), c = *(const LAS f32x4*)(lgp + (ww * 128 + row) * 32 + e0 + 4);
                s[0] += a[0]; s[1] += a[1]; s[2] += a[2]; s[3] += a[3]; s[4] += c[0]; s[5] += c[1]; s[6] += c[2]; s[7] += c[3]; }
            LDS_BARRIER();
            *(LAS f32x4*)(lgp + row * 32 + e0) = (f32x4){s[0], s[1], s[2], s[3]}; *(LAS f32x4*)(lgp + row * 32 + e0 + 4) = (f32x4){s[4], s[5], s[6], s[7]}; }
        LDS_BARRIER();
        if (C.tid < 128) {
            float v0 = -INFINITY, v1 = -INFINITY, v2 = -INFINITY, v3 = -INFINITY; int i0 = 0, i1 = 0, i2 = 0, i3 = 0;
            for (int e = 0; e < 32; ++e) { const float v = lgp[C.tid * 32 + ((e + C.tid) & 31) * 0 + e];
                if (v > v0) { v3 = v2; i3 = i2; v2 = v1; i2 = i1; v1 = v0; i1 = i0; v0 = v; i0 = e; }
                else if (v > v1) { v3 = v2; i3 = i2; v2 = v1; i2 = i1; v1 = v; i1 = e; }
                else if (v > v2) { v3 = v2; i3 = i2; v2 = v; i2 = e; }
                else if (v > v3) { v3 = v; i3 = e; } }
            const float e1 = __expf(v1 - v0), e2 = __expf(v2 - v0), e3 = __expf(v3 - v0), inv = 1.f / (1.f + e1 + e2 + e3);
            const size_t tkn = rowb + C.tid;
            *(int4*)(topidx + tkn * 4) = make_int4(i0, i1, i2, i3);
            *(f32x4*)(topw + tkn * 4) = (f32x4){inv, e1 * inv, e2 * inv, e3 * inv};
            atomicAdd((int*)&hist[i0], 1); atomicAdd((int*)&hist[i1], 1); atomicAdd((int*)&hist[i2], 1); atomicAdd((int*)&hist[i3], 1);
        }
        __syncthreads();
        if (C.tid < 32) wgcnt[tb * 32 + C.tid] = hist[C.tid];
        __syncthreads();
    }
}

DI void phase_route(Ctx& C) {
    const int lane = C.lane, w = C.wave, tid = C.tid;
    const int* wgcnt = WSP(int, WS_WGCNT); const int* topidx = WSP(int, WS_TOPIDX); const float* topw = WSP(float, WS_TOPW);
    int* slotpos = WSP(int, WS_SLOTPOS); int* rowtok = WSP(int, WS_ROWTOK); float* rowgate = WSP(float, WS_ROWGATE); int* tiletab = WSP(int, WS_TILEEXP);
    LAS int* part = (LAS int*)(C.lds);
    LAS int* tot = part + 512;
    LAS int* pstart = tot + 32;
    LAS int* pre = pstart + 40;
    LAS int* wcnt = pre + 32;
    LAS int* spos = wcnt + 256;
    { const int e = tid & 31, j = tid >> 5; int s = 0; for (int i = 0; i < 16; ++i) s += wgcnt[(16 * j + i) * 32 + e]; part[j * 32 + e] = s; }
    __syncthreads();
    if (tid < 32) { int s = 0; for (int j = 0; j < 16; ++j) s += part[j * 32 + tid]; tot[tid] = s; }
    __syncthreads();
    if (tid == 0) { int run = 0; for (int e = 0; e < 32; ++e) { pstart[e] = run; run += ((tot[e] + 255) >> 8) << 8; } pstart[32] = run; }
    __syncthreads();
    if (C.bid == 0) {
        if (tid == 0) tiletab[0] = pstart[32] >> 8;
        for (int e = 0; e < 32; ++e) { const int t0 = pstart[e] >> 8, t1 = pstart[e + 1] >> 8; for (int t = t0 + tid; t < t1; t += NTHR) tiletab[16 + t] = e; }
    }
    for (int e = C.bid; e < 32; e += C.G) {
        const int p0 = pstart[e] + tot[e], p1 = pstart[e + 1];
        for (int p = p0 + tid; p < p1; p += NTHR) { rowtok[p] = -1; rowgate[p] = 0.f; }
    }
    for (int tb = C.bid; tb < 256; tb += C.G) {
        if (tid < 32) { int s = 0; for (int j = 0; j < (tb >> 4); ++j) s += part[j * 32 + tid]; for (int t2 = (tb >> 4) << 4; t2 < tb; ++t2) s += wgcnt[t2 * 32 + tid]; pre[tid] = s; }
        const int slot = tb * 512 + tid;
        const int my_e = topidx[slot]; int my_rank = 0;
        for (int e = 0; e < 32; ++e) { const unsigned long long m = __ballot(my_e == e);
            if (my_e == e) my_rank = __popcll(m & ((1ull << lane) - 1ull));
            if (lane == 0) wcnt[w * 32 + e] = __popcll(m); }
        __syncthreads();
        int base = pstart[my_e] + pre[my_e];
        for (int w2 = 0; w2 < w; ++w2) base += wcnt[w2 * 32 + my_e];
        const int pos = base + my_rank;
        slotpos[slot] = pos; rowtok[pos] = slot >> 2; rowgate[pos] = topw[slot]; spos[tid] = pos;
        __syncthreads();
        __syncthreads();
    }
}

DI void phase_combine(Ctx& C) {
    const int gw = C.bid * NWAVES + C.wave, NGW = C.G * NWAVES, lane = C.lane;
    const float* mod = WSP(float, WS_MOD); const int* slotpos = WSP(int, WS_SLOTPOS); const bf16_t* Y = WSP(bf16_t, WS_YR);
    for (int tp = gw; tp < T / 2; tp += NGW) {
        const int t0 = 2 * tp; const int b = t0 / SEQ; const float* g2 = mod + b * 12288 + 5 * 2048;
        const int4 spa = *(const int4*)(slotpos + (size_t)t0 * 4), spb = *(const int4*)(slotpos + (size_t)t0 * 4 + 4);
        const int pp[8] = {spa.x, spa.y, spa.z, spa.w, spb.x, spb.y, spb.z, spb.w};
#pragma unroll
        for (int j = 0; j < 4; ++j) {
            const int c0 = 8 * lane + 512 * j;
            u32x4 yv[8]; f32x4 xa[2][2];
#pragma unroll
            for (int k = 0; k < 8; ++k) yv[k] = *(const u32x4*)(Y + (size_t)pp[k] * 2048 + c0);
#pragma unroll
            for (int u = 0; u < 2; ++u) { xa[u][0] = *(const f32x4*)(C.out + (size_t)(t0 + u) * D + c0); xa[u][1] = *(const f32x4*)(C.out + (size_t)(t0 + u) * D + c0 + 4); }
            const f32x4 ga = *(const f32x4*)(g2 + c0), gb = *(const f32x4*)(g2 + c0 + 4);
#pragma unroll
            for (int u = 0; u < 2; ++u) { float s[8] = {0.f, 0.f, 0.f, 0.f, 0.f, 0.f, 0.f, 0.f};
#pragma unroll
                for (int k = 0; k < 4; ++k) { const u32x4 y = yv[4 * u + k];
                    s[0] += bflo(y.x); s[1] += bfhi(y.x); s[2] += bflo(y.y); s[3] += bfhi(y.y); s[4] += bflo(y.z); s[5] += bfhi(y.z); s[6] += bflo(y.w); s[7] += bfhi(y.w); }
                float* orow = C.out + (size_t)(t0 + u) * D + c0;
                *(f32x4*)(orow) = xa[u][0] + ga * (f32x4){s[0], s[1], s[2], s[3]}; *(f32x4*)(orow + 4) = xa[u][1] + gb * (f32x4){s[4], s[5], s[6], s[7]}; }
        }
    }
}


DI bool refresh(Ctx& C) { int t = threadIdx.x; asm volatile("" : "+v"(t)); C.tid = t; C.lane = t & 63; return true; }
DI void phase_gemm_proj(Ctx& C, PG8_LAS unsigned char* ring) {
    pg8::Gemm g{WSP(bf16_t, WS_H), WSP(bf16_t, WS_WTIN), T, NPROJ, D / 2, F8_SC_GU}; pg8::StaticOrder S; S.init(T, NPROJ, C.G, C.bid);
    EpiPlainBf16 E{WSP(bf16_t, WS_PROJ), NPROJ};
    pg8::gemm_phase<EpiPlainBf16, pg8::StaticOrder, true, true, true>(ring, g, S, E);
}
DI void phase_gemm_lora(Ctx& C, PG8_LAS unsigned char* ring) {

        static_assert(WS_MERGED == WS_OA + (size_t)T * 1024 * 2, "g | lw | a contiguous");
        int Kl = 256; asm volatile("" : "+s"(Kl));
        pg8::Gemm g{WSP(bf16_t, WS_OB), WSP(bf16_t, WS_BTLORA), 2 * T, 3072, Kl, 0}; LoraOrder S; S.init(T, 3072, C.G, C.bid);
        EpiLora E{WSP(bf16_t, WS_OA), C.w0(), C.a0()};
        pg8::gemm_phase<EpiLora, LoraOrder, true, true>(ring, g, S, E);
    }
DI void phase_gemm_gateup(Ctx& C, PG8_LAS unsigned char* ring) {
    pg8::Gemm g{WSP(bf16_t, WS_H), WSP(bf16_t, WS_WTGU), P_MAX, 32 * 4096, D / 2, F8_SC_GU}; MoeOrder S{WSP(int, WS_TILEEXP), 16, C.G, (C.G % 8 == 0) ? (C.bid % 8) * (C.G / 8) + C.bid / 8 : C.bid, WSP(int, WS_ROWTOK)};
    EpiGateUp E{WSP(unsigned char, WS_ACT), C.b_exp_gate(), C.b_exp_up()};
    pg8::gemm_phase<EpiGateUp, MoeOrder, true, true, true, true>(ring, g, S, E);
}
constexpr int N_PHASES = 16;
__global__ void __launch_bounds__(NTHR, 2) fwd(Args args) {
    extern __shared__ __attribute__((aligned(16))) unsigned char lds_raw[];
    Ctx C{args};
    C.lds = (LAS unsigned char*)lds_raw;
    C.tid = threadIdx.x; C.lane = C.tid & 63; C.wave = __builtin_amdgcn_readfirstlane(C.tid >> 6); C.G = gridDim.x; C.bid = blockIdx.x;
    C.out = args.out; C.ws = args.ws;
    volatile LAS unsigned* MISC = (volatile LAS unsigned*)(C.lds + MISC_OFF);
    for (int u = C.tid; u < (LDS_BYTES - RING_BYTES) / 4; u += NTHR) ((LAS unsigned*)(C.lds + RING_BYTES))[u] = 0u;
    __syncthreads();
    const int lo = args.ph_lo, hi = args.ph_hi;
    XcdBarrier bar; bar.bar = WSP(unsigned, WS_CTL) + CW_BAR; bar.x = 0; bar.st = nullptr;
    if (hi - lo > 1) bar = xcd_barrier_post(WSP(unsigned, WS_CTL) + CW_BAR, MISC + 8);
#define IN(k) (lo <= (k) && (k) < hi && refresh(C))
#define SEAM(k) do { if (IN(k) && IN((k) + 1)) xcd_barrier(bar); } while (0)
#ifndef REP_MASK
#define REP_MASK 0
#endif
#define REPQ(k) (((REP_MASK) >> (k)) & 1)
#define REPLOOP(k) _Pragma("nounroll") for (int rep_ = 0; rep_ <= REPQ(k); ++rep_)
    PG8_LAS unsigned char* ring = (PG8_LAS unsigned char*)C.lds;

    if (IN(0)) { REPLOOP(0) { if (rep_) xcd_barrier(bar); phase_prologue(C); } } SEAM(0);
    if (IN(1)) { REPLOOP(1) { if (rep_) xcd_barrier(bar); phase_norm1(C); } } SEAM(1);
    if (IN(2)) { REPLOOP(2) { if (rep_) xcd_barrier(bar); phase_gemm_proj(C, ring); } } SEAM(2);
    if (IN(3)) { REPLOOP(3) { if (rep_) xcd_barrier(bar); phase_prep(C); } } SEAM(3);
    if (IN(4)) { REPLOOP(4) { if (rep_) xcd_barrier(bar); phase_gemm_lora(C, ring); } } SEAM(4);
    if (IN(5)) { REPLOOP(5) { if (rep_) xcd_barrier(bar); phase_r1(C); } } SEAM(5);
    if (IN(6)) { REPLOOP(6) { if (rep_) xcd_barrier(bar); phase_r2_attn(C, CW_QUEUE + 512 * rep_); } } SEAM(6);
    if (IN(7)) { REPLOOP(7) { if (rep_) xcd_barrier(bar); phase_r3(C); } } SEAM(7);
    if (IN(8)) {
        static_assert(WS_OB8 == WS_OA8 + (size_t)T * 1024 && WS_WTBB == WS_WTBA + (size_t)D * 1024, "o_a | o_b and w_branch_a | w_branch_b are stacked");
        pg8::Gemm g{WSP(bf16_t, WS_OA8), WSP(bf16_t, WS_WTBA), 2 * T, 2 * D, 512, F8_SC_GU}; BranchOrder S; S.init(T, D, C.G, C.bid);
        EpiBranchFused E{WSP(unsigned char, WS_MERGED8), WSP(bf16_t, WS_PROJ)};
        pg8::gemm_phase<EpiBranchFused, BranchOrder, true, true, true>(ring, g, S, E);
    } SEAM(8);
    if (IN(10)) {
        pg8::Gemm g{WSP(bf16_t, WS_MERGED8), WSP(bf16_t, WS_WTOUT), T, D, D / 2, F8_SC_GU}; pg8::StaticOrder S; S.init(T, D, C.G, C.bid);
        EpiOut E{C.out, C.x(), WSP(float, WS_MOD), WSP(float, WS_ROWSS)};
        pg8::gemm_phase<EpiOut, pg8::StaticOrder, true, true, true>(ring, g, S, E);
    } SEAM(10);
    if (IN(11)) { REPLOOP(11) { if (rep_) xcd_barrier(bar); phase_norm2_router(C); } } SEAM(11);
    if (IN(12)) { REPLOOP(12) { if (rep_) xcd_barrier(bar); phase_route(C); } } SEAM(12);
    if (IN(13)) { REPLOOP(13) { if (rep_) xcd_barrier(bar); phase_gemm_gateup(C, ring); } } SEAM(13);
    if (IN(14)) {
        pg8::Gemm g{WSP(bf16_t, WS_ACT), WSP(bf16_t, WS_WTDN), P_MAX, 32 * 2048, D / 2, F8_SC_DN}; MoeOrder S{WSP(int, WS_TILEEXP), 8, C.G, (C.G % 8 == 0) ? (C.bid % 8) * (C.G / 8) + C.bid / 8 : C.bid, WSP(int, WS_ROWTOK)};
        EpiDown E{WSP(bf16_t, WS_YR), C.b_exp_down(), WSP(float, WS_ROWGATE)};
        pg8::gemm_phase<EpiDown, MoeOrder, true, true, true>(ring, g, S, E);
    } SEAM(14);
    if (IN(15)) { phase_combine(C); }
#undef IN
#undef SEAM
}

#ifndef N_LAUNCH_MODE
#define N_LAUNCH_MODE 1
#endif
extern "C" void kernel_launch(void* const* d_in, const int* in_sizes, int n_in, void* d_out, int out_size, void* d_ws, size_t ws_size, hipStream_t stream) {
    static int grid = 0;
    if (grid == 0) {
        if (n_in != 36 || out_size != T * D || ws_size < WS_END) { fprintf(stderr, "kernel_launch: unexpected shapes (n_in %d out %d ws %zu)\n", n_in, out_size, ws_size); grid = -1; return; }
        int dev = 0, cus = 0, per_cu = 0;
        if (hipGetDevice(&dev) != hipSuccess || hipDeviceGetAttribute(&cus, hipDeviceAttributeMultiprocessorCount, dev) != hipSuccess) { grid = -1; return; }
        if (hipFuncSetAttribute((const void*)fwd, hipFuncAttributeMaxDynamicSharedMemorySize, LDS_BYTES) != hipSuccess) { fprintf(stderr, "kernel_launch: hipFuncSetAttribute failed\n"); grid = -1; return; }
        if (hipOccupancyMaxActiveBlocksPerMultiprocessor(&per_cu, (const void*)fwd, NTHR, LDS_BYTES) != hipSuccess || per_cu < 1) { fprintf(stderr, "kernel_launch: occupancy query says %d\n", per_cu); }
        (void)hipGetLastError();
        grid = cus;
    }
    if (grid < 0) return;
    (void)hipMemsetAsync((char*)d_ws + WS_CTL, 0, CTL_ZERO_BYTES, stream);
    Args a{};
    for (int i = 0; i < 36; ++i) a.in[i] = (const float*)d_in[i];
    a.out = (float*)d_out; a.ws = (unsigned char*)d_ws;
#if N_LAUNCH_MODE == 1
    a.ph_lo = 0; a.ph_hi = N_PHASES;
    hipLaunchKernelGGL(fwd, dim3(grid), dim3(NTHR), LDS_BYTES, stream, a);
#else
    for (int p = 0; p < N_PHASES; ++p) { a.ph_lo = p; a.ph_hi = p + 1; hipLaunchKernelGGL(fwd, dim3(grid), dim3(NTHR), LDS_BYTES, stream, a); }
#endif
}
```
